# Optimizing an MI355X kernel written in HIP

```python
import jax, jax.numpy as jnp
from jax import lax
import numpy as np

D_MODEL = 2048
BATCH = 8
SEQ = 2048
DEPTH = 2

HEAD_DIM = 128
RET_WIDTH = D_MODEL // 2
N_RET_HEADS = RET_WIDTH // HEAD_DIM
FOX_WIDTH = D_MODEL // 2
N_FOX_HEADS = FOX_WIDTH // HEAD_DIM
POOL_WIDTH = D_MODEL // 2
POOL_WINDOWS = (2, 4, 8, 16)
N_POOL_GROUPS = len(POOL_WINDOWS)
POOL_GROUP_DIM = POOL_WIDTH // N_POOL_GROUPS
N_BRANCH = 3
RET_CHUNK = 128
Q_BLOCK = 128
ROPE_THETA = 10000.0
EPS = 1e-6
NEG_INF = -1e30
C_IN = 4 * RET_WIDTH + 4 * FOX_WIDTH + N_FOX_HEADS + 2 * POOL_WIDTH + N_BRANCH * D_MODEL

kernel_name = 'retention_fox_pool_gated_hybrid'


def rms_norm(x, g):
    xf = x.astype(jnp.float32)
    y = xf * lax.rsqrt(jnp.mean(xf * xf, axis=-1, keepdims=True) + EPS)
    return (y * g.astype(jnp.float32)).astype(x.dtype)


def rotary(t, pos):
    half = t.shape[-1] // 2
    inv = ROPE_THETA ** (-jnp.arange(half, dtype=jnp.float32) / half)
    ang = pos.astype(jnp.float32)[:, None] * inv[None, :]
    cos = jnp.cos(ang)[None, :, None, :]
    sin = jnp.sin(ang)[None, :, None, :]
    t1, t2 = t[..., :half], t[..., half:]
    return jnp.concatenate([t1 * cos - t2 * sin, t1 * sin + t2 * cos], axis=-1)


def retention(q, k, v):
    bsz, s, h, dk = q.shape
    dv = v.shape[-1]
    n = s // RET_CHUNK
    pos = jnp.arange(s)
    q = rotary(q, pos)
    k = rotary(k, pos) * (dk ** -0.5)
    log_g = jnp.log1p(-jnp.exp2(-5.0 - jnp.arange(h, dtype=jnp.float32)))
    idx = jnp.arange(RET_CHUNK, dtype=jnp.float32)
    diff = idx[:, None] - idx[None, :]
    decay = jnp.where(diff >= 0, jnp.exp(log_g[:, None, None] * jnp.maximum(diff, 0.0)), 0.0)
    xi = jnp.exp(log_g[:, None] * (idx + 1.0))[None, :, :, None]
    zeta = jnp.exp(log_g[:, None] * (RET_CHUNK - 1.0 - idx))[None, :, :, None]
    g_chunk = jnp.exp(log_g * RET_CHUNK)[None, :, None, None]

    def chunks(t):
        return t.reshape(bsz, n, RET_CHUNK, h, t.shape[-1]).transpose(1, 0, 3, 2, 4)

    def step(state, qkv):
        qc, kc, vc = qkv
        inner = jnp.einsum('bhqd,bhkd->bhqk', qc, kc) * decay
        out = (jnp.einsum('bhqk,bhkv->bhqv', inner, vc)
               + jnp.einsum('bhqd,bhdv->bhqv', qc, state) * xi)
        state = g_chunk * state + jnp.einsum('bhkd,bhkv->bhdv', kc * zeta, vc)
        return state, out

    state0 = jnp.zeros((bsz, h, dk, dv), jnp.float32)
    _, outs = lax.scan(step, state0, (chunks(q), chunks(k), chunks(v)))
    return outs.transpose(1, 0, 3, 2, 4).reshape(bsz, s, h, dv)


def head_group_norm(y, g):
    mu = jnp.mean(y, axis=-1, keepdims=True)
    var = jnp.mean(jnp.square(y - mu), axis=-1, keepdims=True)
    yn = (y - mu) * lax.rsqrt(var + EPS)
    return yn * g.astype(jnp.float32).reshape(y.shape[-2], y.shape[-1])


def forgetting_attention(q, k, v, f_logit):
    bsz, s, h, d = q.shape
    n = s // Q_BLOCK
    scale = d ** -0.5
    c = jnp.cumsum(jax.nn.log_sigmoid(f_logit), axis=1).transpose(0, 2, 1)
    qh = q.transpose(0, 2, 1, 3)
    kh = k.transpose(0, 2, 1, 3)
    vh = v.transpose(0, 2, 1, 3)
    qb = qh.reshape(bsz, h, n, Q_BLOCK, d).transpose(2, 0, 1, 3, 4)
    cb = c.reshape(bsz, h, n, Q_BLOCK).transpose(2, 0, 1, 3)
    qpos = jnp.arange(s).reshape(n, Q_BLOCK)
    kpos = jnp.arange(s)

    def block(args):
        qi, ci, pi = args
        logits = (jnp.einsum('bhqd,bhkd->bhqk', qi, kh) * scale
                  + ci[..., None] - c[:, :, None, :])
        logits = jnp.where(pi[:, None] >= kpos[None, :], logits, NEG_INF)
        p = jax.nn.softmax(logits, axis=-1)
        return jnp.einsum('bhqk,bhkd->bhqd', p, vh)

    out = lax.map(block, (qb, cb, qpos))
    return out.transpose(1, 0, 3, 2, 4).reshape(bsz, s, h, d)


def pool_mixer(u, w_pool, pool_scale):
    bsz, s, p = u.shape
    cs = jnp.cumsum(u, axis=1)
    t = jnp.arange(s, dtype=jnp.float32) + 1.0
    groups = []
    for gi, w in enumerate(POOL_WINDOWS):
        sl = slice(gi * POOL_GROUP_DIM, (gi + 1) * POOL_GROUP_DIM)
        csg = cs[..., sl]
        prev = jnp.pad(csg, ((0, 0), (w, 0), (0, 0)))[:, :s]
        mean = (csg - prev) / jnp.minimum(t, float(w))[None, :, None]
        groups.append(mean - u[..., sl])
    pooled = jnp.stack(groups, axis=2)
    mixed = jnp.einsum('bsgc,gcd->bsgd', pooled, w_pool.astype(jnp.float32)).reshape(bsz, s, p)
    return mixed * pool_scale.astype(jnp.float32)


def hybrid_layer(x, norm_g, w_in, ret_gn_g, fox_b_f, pool_w, pool_scale,
                 w_ret_branch, w_fox_branch, w_pool_branch, w_out):
    bsz, s, _ = x.shape
    h = rms_norm(x, norm_g)
    proj = jnp.matmul(h, w_in).astype(jnp.float32)
    sizes = [RET_WIDTH] * 4 + [FOX_WIDTH] * 4 + [N_FOX_HEADS] + [POOL_WIDTH] * 2 + [D_MODEL] * N_BRANCH
    cuts = np.cumsum(sizes)[:-1].tolist()
    (rq, rk, rv, rz, fq, fk, fv, fz, ff, pu, pz, ga, gb, gc) = jnp.split(proj, cuts, axis=-1)

    hs = (bsz, s, N_RET_HEADS, HEAD_DIM)
    y_ret = retention(rq.reshape(hs), rk.reshape(hs), rv.reshape(hs))
    y_ret = head_group_norm(y_ret, ret_gn_g).reshape(bsz, s, RET_WIDTH) * jax.nn.silu(rz)

    hs = (bsz, s, N_FOX_HEADS, HEAD_DIM)
    f_logit = ff + fox_b_f.astype(jnp.float32)
    y_fox = forgetting_attention(fq.reshape(hs), fk.reshape(hs), fv.reshape(hs), f_logit)
    y_fox = y_fox.reshape(bsz, s, FOX_WIDTH) * jax.nn.silu(fz)

    y_pool = pool_mixer(pu, pool_w, pool_scale) * jax.nn.silu(pz)

    merged = (jax.nn.sigmoid(ga) * jnp.matmul(y_ret, w_ret_branch.astype(jnp.float32))
              + jax.nn.sigmoid(gb) * jnp.matmul(y_fox, w_fox_branch.astype(jnp.float32))
              + jax.nn.sigmoid(gc) * jnp.matmul(y_pool, w_pool_branch.astype(jnp.float32)))
    out = jnp.matmul(merged, w_out.astype(jnp.float32))
    return x + out.astype(x.dtype)


def setup_inputs(seed: int = 0) -> dict:
    key = jax.random.key(seed)
    ks = jax.random.split(key, 13)
    f32 = jnp.float32
    x = jax.random.normal(ks[0], (BATCH, SEQ, D_MODEL), f32)
    norm_g = 1.0 + 0.02 * jax.random.normal(ks[1], (DEPTH, D_MODEL), f32)
    w_in = jax.random.normal(ks[2], (DEPTH, D_MODEL, C_IN), f32) * (D_MODEL ** -0.5)
    ret_gn_g = 1.0 + 0.02 * jax.random.normal(ks[3], (DEPTH, RET_WIDTH), f32)
    fox_b_f = 2.0 + 0.5 * jax.random.normal(ks[4], (DEPTH, N_FOX_HEADS), f32)
    pool_w = jax.random.normal(ks[5], (DEPTH, N_POOL_GROUPS, POOL_GROUP_DIM, POOL_GROUP_DIM), f32) * (POOL_GROUP_DIM ** -0.5)
    pool_scale = 1.0 + 0.02 * jax.random.normal(ks[6], (DEPTH, POOL_WIDTH), f32)
    w_ret_branch = jax.random.normal(ks[7], (DEPTH, RET_WIDTH, D_MODEL), f32) * (RET_WIDTH ** -0.5)
    w_fox_branch = jax.random.normal(ks[8], (DEPTH, FOX_WIDTH, D_MODEL), f32) * (FOX_WIDTH ** -0.5)
    w_pool_branch = jax.random.normal(ks[9], (DEPTH, POOL_WIDTH, D_MODEL), f32) * (POOL_WIDTH ** -0.5)
    w_out = jax.random.normal(ks[10], (DEPTH, D_MODEL, D_MODEL), f32) * (D_MODEL ** -0.5)
    final_g = 1.0 + 0.02 * jax.random.normal(ks[11], (D_MODEL,), f32)
    return {'x': x, 'norm_g': norm_g, 'w_in': w_in, 'ret_gn_g': ret_gn_g, 'fox_b_f': fox_b_f,
            'pool_w': pool_w, 'pool_scale': pool_scale, 'w_ret_branch': w_ret_branch,
            'w_fox_branch': w_fox_branch, 'w_pool_branch': w_pool_branch, 'w_out': w_out,
            'final_g': final_g}


def reference(x, norm_g, w_in, ret_gn_g, fox_b_f, pool_w, pool_scale,
              w_ret_branch, w_fox_branch, w_pool_branch, w_out, final_g):
    for layer in range(DEPTH):
        x = hybrid_layer(x, norm_g[layer], w_in[layer], ret_gn_g[layer], fox_b_f[layer],
                         pool_w[layer], pool_scale[layer], w_ret_branch[layer],
                         w_fox_branch[layer], w_pool_branch[layer], w_out[layer])
    return rms_norm(x, final_g)
```

```cpp
#include <hip/hip_runtime.h>
#include <hip/hip_cooperative_groups.h>
#include <cstdio>
#include <cstdint>
namespace cg = cooperative_groups;
#ifndef PHM
#define PHM 255
#endif
#ifndef PHC2
#define PHC2 7
#endif
#ifndef REPM
#define REPM 0
#endif

#define LAS __attribute__((address_space(3)))
typedef unsigned short bf16_t;
typedef short bf16x8 __attribute__((ext_vector_type(8)));
typedef float f32x4 __attribute__((ext_vector_type(4)));
typedef float f32x16 __attribute__((ext_vector_type(16)));
typedef unsigned u32x4 __attribute__((ext_vector_type(4)));
typedef unsigned u32x2 __attribute__((ext_vector_type(2)));

constexpr int BATCH = 8, SEQ = 2048, DM = 2048, M = BATCH * SEQ, NH = 8, CIN = 16392, NP = 16384, DEPTH = 2;
constexpr int COL_RQ = 0, COL_RK = 1024, COL_RV = 2048, COL_RZ = 3072, COL_FQ = 4096, COL_FK = 5120, COL_FV = 6144, COL_FZ = 7168,
              COL_PU = 8192, COL_PZ = 9216, COL_GA = 10240, COL_GB = 12288, COL_GC = 14336;
constexpr float EPS = 1e-6f, LOG2E = 1.4426950408889634f;
constexpr int NWAVES = 8, NTHREADS = 512;
constexpr int LDS_BYTES = 147456;
constexpr int LDS_BARST = LDS_BYTES - 64;

constexpr size_t MiB = 1u << 20;
constexpr size_t WS_LSIG = 0;
constexpr size_t WS_CUM = MiB / 2;
constexpr size_t WS_ROPE = 1 * MiB;
constexpr size_t WS_WPOOL = 2 * MiB;
constexpr size_t WS_BAR = 3 * MiB;
constexpr size_t WS_WOUT = 4 * MiB;
constexpr size_t WS_WBR = 12 * MiB;
constexpr size_t WS_WIN = 24 * MiB;
constexpr size_t WS_H = 88 * MiB;
constexpr size_t WS_PROJ = 152 * MiB;
constexpr size_t WS_Y = 664 * MiB;
constexpr size_t WS_STATE = 760 * MiB;
constexpr size_t WS_STATEC = 824 * MiB;
constexpr size_t WS_POOLED = 856 * MiB;
constexpr size_t WS_VTF = 888 * MiB;
constexpr size_t WS_VTR = 920 * MiB;
constexpr size_t WS_END = 952 * MiB;

__device__ __forceinline__ unsigned f2bf(float f) { unsigned u = __builtin_bit_cast(unsigned, f); return (u + 0x7fffu + ((u >> 16) & 1u)) >> 16; }
typedef float f32x2 __attribute__((ext_vector_type(2)));
typedef __bf16 hwbf16x2 __attribute__((ext_vector_type(2)));
__device__ __forceinline__ unsigned pk2(float lo, float hi) { const f32x2 v = {lo, hi}; const hwbf16x2 b = __builtin_convertvector(v, hwbf16x2); return __builtin_bit_cast(unsigned, b); }
__device__ __forceinline__ float bflo(unsigned w) { return __builtin_bit_cast(float, w << 16); }
__device__ __forceinline__ float bfhi(unsigned w) { return __builtin_bit_cast(float, w & 0xffff0000u); }
__device__ __forceinline__ float wave_sum(float v) {
#pragma unroll
    for (int o = 1; o < 64; o <<= 1) v += __shfl_xor(v, o);
    return v;
}
__device__ __forceinline__ float fast_sigmoid(float x) { return __builtin_amdgcn_rcpf(1.0f + __builtin_amdgcn_exp2f(-x * LOG2E)); }
__device__ __forceinline__ float fast_silu(float x) { return x * fast_sigmoid(x); }
#define LDS_WAIT() asm volatile("s_waitcnt lgkmcnt(0)" ::: "memory")
__device__ __forceinline__ int tid_l() { int t = threadIdx.x; asm volatile("" : "+v"(t)); return t; }

namespace pg8 {
constexpr int BM = 256, BK = 64, HALF = 128, HTB = HALF * BK * 2, STAGE_BYTES = 8 * HTB, NXCD = 8, WGM = 8;
__device__ __forceinline__ int lds_byte(int r, int c) { const int st = (r >> 4) * 2 + (c >> 5), rr = r & 15, cc = c & 31, ob = rr * 64 + cc * 2; return st * 1024 + (ob ^ (((ob >> 9) & 1) << 5)); }
__device__ __forceinline__ void stage_rc(int b, int& R, int& C) { const int st = b / 1024, sb = b % 1024, swz = sb ^ (((sb >> 9) & 1) << 5); R = (st >> 1) * 16 + swz / 64; C = (st & 1) * 32 + (swz % 64) / 2; }
__device__ __forceinline__ int perm32(int rho) { const int n = rho >> 4, i = rho & 15; return 8 * (i >> 2) + 4 * n + (i & 3); }

struct Unit { int pm, pn, aux; };

__device__ __forceinline__ void tile_of(int L, int nM, int nN, int& pm, int& pn) {
    const int nwg = nM * nN; int wgid = L;
    { const int q = nwg / NXCD, r = nwg % NXCD, xcd = wgid % NXCD, off = wgid / NXCD; wgid = (xcd < r ? xcd * (q + 1) : r * (q + 1) + (xcd - r) * q) + off; }
    const int nig = WGM * nN, gid = wgid / nig, fm = gid * WGM, gsz = (nM - fm) < WGM ? (nM - fm) : WGM;
    pm = fm + ((wgid % nig) % gsz); pn = (wgid % nig) / gsz;
}

template <class Epi, class Sched>
__device__ __forceinline__ void gemm_phase(LAS unsigned char* lds, const int K, const int lda, const int ldb, const Sched& S, const Epi& E) {
    const int tid = tid_l(), wid = __builtin_amdgcn_readfirstlane(tid >> 6), lane = tid & 63, wr = wid >> 2, wc = wid & 3, fr = lane & 15, fq = lane >> 4;
    const int nt = K / BK;
    unsigned voffA[2], voffB[2];
#pragma unroll
    for (int i = 0; i < 2; ++i) { int R, C; stage_rc(tid * 16 + i * 8192, R, C); const int Rb = Epi::PERM ? ((R & ~31) + perm32(R & 31)) : R;
        voffA[i] = (unsigned)(R * lda + C) * 2u; voffB[i] = (unsigned)(Rb * ldb + C) * 2u; }
    const size_t kstep = (size_t)(BK * 2);
    const size_t hstepA = (size_t)HALF * lda * 2, hstepB = (size_t)HALF * ldb * 2;
    const unsigned ldsw = (unsigned)wid * 1024u;
    const int aoff = lds_byte(wr * 64 + fr, fq * 8), boff = lds_byte(wc * 32 + fr, fq * 8);
#define PG8_SA(b, h) (((b) * 2 + (h)) * HTB)
#define PG8_SB(b, h) ((4 + (b) * 2 + (h)) * HTB)
#define PG8_STAGE(bufoff, gbase, voff) do { _Pragma("unroll") for (int _i = 0; _i < 2; ++_i) \
        __builtin_amdgcn_global_load_lds((const unsigned*)((const char*)(gbase) + (voff)[_i]), (LAS unsigned*)(lds + (bufoff) + ldsw + _i * 8192), 16, 0, 0); } while (0)
#define PG8_LDA(dst, b, h) do { _Pragma("unroll") for (int m = 0; m < 4; ++m) _Pragma("unroll") for (int k = 0; k < 2; ++k) dst[m][k] = *(const LAS bf16x8*)(lds + PG8_SA(b, h) + aoff + m * 2048 + k * 1024); } while (0)
#define PG8_LDB(dst, b, h) do { _Pragma("unroll") for (int n = 0; n < 2; ++n) _Pragma("unroll") for (int k = 0; k < 2; ++k) dst[n][k] = *(const LAS bf16x8*)(lds + PG8_SB(b, h) + boff + n * 2048 + k * 1024); } while (0)
#define PG8_MMA(ai, bj, At, Bt) do { __builtin_amdgcn_s_setprio(1); _Pragma("unroll") for (int m = 0; m < 4; ++m) _Pragma("unroll") for (int n = 0; n < 2; ++n) _Pragma("unroll") for (int k = 0; k < 2; ++k) \
        acc[ai][bj][m][n] = __builtin_amdgcn_mfma_f32_16x16x32_bf16(Bt[n][k], At[m][k], acc[ai][bj][m][n], 0, 0, 0); __builtin_amdgcn_s_setprio(0); } while (0)
#define PG8_WAIT_V(n) asm volatile("s_waitcnt vmcnt(" #n ")" ::: "memory")
#define PG8_WAIT_L(n) asm volatile("s_waitcnt lgkmcnt(" #n ")" ::: "memory")
#define PG8_BAR __builtin_amdgcn_s_barrier()
#define PG8_SCHED __builtin_amdgcn_sched_barrier(0)
    Unit cur, nxt; int ui = 0;
    if (!S.next(0, cur)) return;
    f32x4 acc[2][2][4][2];
#pragma unroll
    for (int a = 0; a < 2; ++a)
#pragma unroll
        for (int b = 0; b < 2; ++b)
#pragma unroll
            for (int m = 0; m < 4; ++m)
#pragma unroll
                for (int n = 0; n < 2; ++n) acc[a][b][m][n] = (f32x4){0.f, 0.f, 0.f, 0.f};
    bf16x8 At[4][2], B0[2][2], B1[2][2];
    const char* cA = S.a_ptr(cur); const char* cB = S.b_ptr(cur);
    PG8_STAGE(PG8_SB(0, 0), cB, voffB); PG8_STAGE(PG8_SB(0, 1), cB + hstepB, voffB); PG8_STAGE(PG8_SA(0, 0), cA, voffA); PG8_STAGE(PG8_SA(0, 1), cA + hstepA, voffA);
    if (wr == 1) PG8_BAR;
    PG8_WAIT_V(2); PG8_BAR;
    PG8_STAGE(PG8_SB(1, 0), cB + kstep, voffB); PG8_STAGE(PG8_SA(1, 0), cA + kstep, voffA); PG8_STAGE(PG8_SB(1, 1), cB + hstepB + kstep, voffB);
    PG8_WAIT_V(6); PG8_BAR;
    for (;;) {
        const bool has_next = S.next(ui + 1, nxt);
        const char* nA = has_next ? S.a_ptr(nxt) : cA; const char* nB = has_next ? S.b_ptr(nxt) : cB;
        for (int t = 0; t < nt; t += 2) {
            const bool last = (t == nt - 2);
            const char* a1 = cA + (size_t)(t + 1) * kstep;
            const char* a2 = last ? nA : cA + (size_t)(t + 2) * kstep; const char* b2 = last ? nB : cB + (size_t)(t + 2) * kstep;
            const char* a3 = a2 + kstep; const char* b3 = b2 + kstep;
            PG8_LDB(B0, 0, 0); PG8_LDB(B1, 0, 1); PG8_SCHED; PG8_LDA(At, 0, 0); PG8_STAGE(PG8_SA(1, 1), a1 + hstepA, voffA);
            PG8_WAIT_V(8); PG8_WAIT_L(0); PG8_BAR; PG8_MMA(0, 0, At, B0); PG8_MMA(0, 1, At, B1); PG8_BAR; PG8_SCHED;
            PG8_LDA(At, 0, 1); PG8_STAGE(PG8_SB(0, 0), b2, voffB); PG8_STAGE(PG8_SB(0, 1), b2 + hstepB, voffB); PG8_STAGE(PG8_SA(0, 0), a2, voffA);
            PG8_WAIT_V(8); PG8_WAIT_L(0); PG8_BAR; PG8_MMA(1, 0, At, B0); PG8_MMA(1, 1, At, B1); PG8_BAR; PG8_SCHED;
            PG8_LDB(B0, 1, 0); PG8_LDB(B1, 1, 1); PG8_SCHED; PG8_LDA(At, 1, 0); PG8_STAGE(PG8_SA(0, 1), a2 + hstepA, voffA);
            PG8_WAIT_V(8); PG8_WAIT_L(0); PG8_BAR; PG8_MMA(0, 0, At, B0); PG8_MMA(0, 1, At, B1); PG8_BAR; PG8_SCHED;
            PG8_LDA(At, 1, 1); PG8_STAGE(PG8_SB(1, 0), b3, voffB); PG8_STAGE(PG8_SB(1, 1), b3 + hstepB, voffB); PG8_STAGE(PG8_SA(1, 0), a3, voffA);
            PG8_WAIT_V(8); PG8_WAIT_L(0); PG8_BAR; PG8_MMA(1, 0, At, B0); PG8_MMA(1, 1, At, B1); PG8_BAR; PG8_SCHED;
        }
        if (wr == 0) PG8_BAR;
        const bool zero = E(acc, cur, wr, wc, fr, fq);
        if (!has_next) break;
        if (zero) {
#pragma unroll
            for (int a = 0; a < 2; ++a)
#pragma unroll
                for (int b = 0; b < 2; ++b)
#pragma unroll
                    for (int m = 0; m < 4; ++m)
#pragma unroll
                        for (int n = 0; n < 2; ++n) acc[a][b][m][n] = (f32x4){0.f, 0.f, 0.f, 0.f};
        }
        cur = nxt; cA = nA; cB = nB; ++ui;
        if (wr == 1) PG8_BAR;
    }
    PG8_WAIT_V(0);
    PG8_BAR;
#undef PG8_SA
#undef PG8_SB
#undef PG8_STAGE
#undef PG8_LDA
#undef PG8_LDB
#undef PG8_MMA
#undef PG8_WAIT_V
#undef PG8_WAIT_L
#undef PG8_BAR
#undef PG8_SCHED
}
}
using pg8::Unit;

struct SchedPlain {
    const bf16_t* A; const bf16_t* Bt; int lda, ldb, nM, nN, G, c;
    __device__ __forceinline__ bool next(int i, Unit& u) const { const int L = i * G + c; if (L >= nM * nN) return false; pg8::tile_of(L, nM, nN, u.pm, u.pn); u.aux = 0; return true; }
    __device__ __forceinline__ const char* a_ptr(const Unit& u) const { return (const char*)(A + (size_t)u.pm * 256 * lda); }
    __device__ __forceinline__ const char* b_ptr(const Unit& u) const { return (const char*)(Bt + (size_t)u.pn * 256 * ldb); }
};
struct SchedProj {
    const bf16_t* A; const bf16_t* Bt; int lda, ldb, nM, nN, G, c;
    __device__ __forceinline__ bool next(int i, Unit& u) const {
        if (G != 256) { const int L = i * G + c; if (L >= nM * nN) return false; pg8::tile_of(L, nM, nN, u.pm, u.pn); u.aux = 0; return true; }
        if (i >= 16) return false;
        const int x = c & 7; u.pm = 8 * x + ((c >> 3) & 7); u.pn = 4 * ((i + 2 * x) & 15) + (c >> 6); u.aux = 0; return true; }
    __device__ __forceinline__ const char* a_ptr(const Unit& u) const { return (const char*)(A + (size_t)u.pm * 256 * lda); }
    __device__ __forceinline__ const char* b_ptr(const Unit& u) const { return (const char*)(Bt + (size_t)u.pn * 256 * ldb); }
};
struct SchedMerge {
    const bf16_t* Y; const bf16_t* W; int G, c;
    __device__ __forceinline__ bool next(int i, Unit& u) const { const int j = i / 3, br = i - 3 * j; const int L = j * G + c; if (L >= 512) return false; pg8::tile_of(L, 64, 8, u.pm, u.pn); u.aux = br; return true; }
    __device__ __forceinline__ const char* a_ptr(const Unit& u) const { return (const char*)(Y + (size_t)u.pm * 256 * 3072 + u.aux * 1024); }
    __device__ __forceinline__ const char* b_ptr(const Unit& u) const { return (const char*)(W + (size_t)u.aux * 2048 * 1024 + (size_t)u.pn * 256 * 1024); }
};
struct SchedPool {
    const bf16_t* P; const bf16_t* W; int G, c;
    __device__ __forceinline__ bool next(int i, Unit& u) const { const int L = i * G + c; if (L >= 256) return false; u.pm = L >> 2; u.pn = L & 3; u.aux = 0; return true; }
    __device__ __forceinline__ const char* a_ptr(const Unit& u) const { return (const char*)(P + (size_t)u.pm * 256 * 1024 + u.pn * 256); }
    __device__ __forceinline__ const char* b_ptr(const Unit& u) const { return (const char*)(W + (size_t)u.pn * 65536); }
};

struct EpiProj {
    static constexpr bool PERM = true;
    bf16_t* P; const float* rope;
    __device__ __forceinline__ bool operator()(f32x4 (&acc)[2][2][4][2], const Unit& u, int wr, int wc, int fr, int fq) const {
        asm volatile("" : "+v"(fr), "+v"(fq));
        const int row0 = u.pm * 256 + wr * 64 + fr, col0 = u.pn * 256 + wc * 32 + 8 * fq;
        const int pn = u.pn;
        int mode;
        if (pn < 4) mode = 3; else if (pn < 8) mode = 4; else if (pn < 12) mode = 0; else if (pn < 16) mode = 1; else if (pn < 20) mode = 5; else if (pn < 28) mode = 0;
        else if (pn < 32) mode = 1; else if (pn < 36) mode = 0; else if (pn < 40) mode = 1; else mode = 2;
        const int j0 = wc * 16 + 4 * fq;
#pragma unroll
        for (int ai = 0; ai < 2; ++ai) {
            f32x4 csa[4], csb[4];
#pragma unroll
            for (int m = 0; m < 4; ++m) { csa[m] = (f32x4){1.f, 0.f, 1.f, 0.f}; csb[m] = csa[m]; }
            if (mode == 3 || mode == 4) {
#pragma unroll
                for (int m = 0; m < 4; ++m) { const float* tp = rope + ((size_t)((row0 + ai * 128 + m * 16) & (SEQ - 1)) * 64 + j0) * 2; csa[m] = *(const f32x4*)tp; csb[m] = *(const f32x4*)(tp + 4); }
                asm volatile("" : "+v"(csa[0]), "+v"(csa[1]), "+v"(csa[2]), "+v"(csa[3]), "+v"(csb[0]), "+v"(csb[1]), "+v"(csb[2]), "+v"(csb[3]));
            }
#pragma unroll
            for (int m = 0; m < 4; ++m) {
                const int row = row0 + ai * 128 + m * 16;
                bf16_t* rowp = P + (size_t)row * NP + col0;
                const f32x4 cs0 = csa[m], cs1 = csb[m];
#pragma unroll
                for (int bj = 0; bj < 2; ++bj) {
                    f32x4 v0 = acc[ai][bj][m][0], v1 = acc[ai][bj][m][1];
                    if (mode == 1) {
#pragma unroll
                        for (int j = 0; j < 4; ++j) { v0[j] = fast_silu(v0[j]); v1[j] = fast_silu(v1[j]); }
                    } else if (mode == 2) {
#pragma unroll
                        for (int j = 0; j < 4; ++j) { v0[j] = fast_sigmoid(fminf(fmaxf(v0[j], -60.f), 60.f)); v1[j] = fast_sigmoid(fminf(fmaxf(v1[j], -60.f), 60.f)); }
                    } else if (mode == 3 || mode == 4) {
                        const float sc = (mode == 4) ? 0.08838834764831845f : 1.0f;
                        f32x4 o0, o1;
                        o0[0] = (v0[0] * cs0[0] - v0[1] * cs0[1]) * sc; o0[1] = (v0[0] * cs0[1] + v0[1] * cs0[0]) * sc;
                        o0[2] = (v0[2] * cs0[2] - v0[3] * cs0[3]) * sc; o0[3] = (v0[2] * cs0[3] + v0[3] * cs0[2]) * sc;
                        o1[0] = (v1[0] * cs1[0] - v1[1] * cs1[1]) * sc; o1[1] = (v1[0] * cs1[1] + v1[1] * cs1[0]) * sc;
                        o1[2] = (v1[2] * cs1[2] - v1[3] * cs1[3]) * sc; o1[3] = (v1[2] * cs1[3] + v1[3] * cs1[2]) * sc;
                        v0 = o0; v1 = o1;
                    } else if (mode == 5) { v0 = v0 * (0.08838834764831845f * LOG2E); v1 = v1 * (0.08838834764831845f * LOG2E); }
                    u32x4 w; w.x = pk2(v0[0], v0[1]); w.y = pk2(v0[2], v0[3]); w.z = pk2(v1[0], v1[1]); w.w = pk2(v1[2], v1[3]);
                    *(u32x4*)(rowp + bj * 128) = w;
                }
            }
        }
        return true;
    }
};
struct EpiPool {
    static constexpr bool PERM = true;
    const bf16_t* P; bf16_t* Y; const float* scale;
    __device__ __forceinline__ bool operator()(f32x4 (&acc)[2][2][4][2], const Unit& u, int wr, int wc, int fr, int fq) const {
        asm volatile("" : "+v"(fr), "+v"(fq));
        const int row0 = u.pm * 256 + wr * 64 + fr, col0 = u.pn * 256 + wc * 32 + 8 * fq;
        f32x4 sc[2][2];
#pragma unroll
        for (int bj = 0; bj < 2; ++bj) { sc[bj][0] = *(const f32x4*)(scale + col0 + bj * 128); sc[bj][1] = *(const f32x4*)(scale + col0 + bj * 128 + 4); }
#pragma unroll
        for (int ai = 0; ai < 2; ++ai) {
            u32x4 z[4][2];
#pragma unroll
            for (int m = 0; m < 4; ++m)
#pragma unroll
                for (int bj = 0; bj < 2; ++bj) z[m][bj] = *(const u32x4*)((const char*)P + (unsigned)(((row0 + ai * 128 + m * 16) * NP + COL_PZ + col0 + bj * 128) * 2));
            asm volatile("" : "+v"(z[0][0]), "+v"(z[0][1]), "+v"(z[1][0]), "+v"(z[1][1]), "+v"(z[2][0]), "+v"(z[2][1]), "+v"(z[3][0]), "+v"(z[3][1]));
#pragma unroll
            for (int m = 0; m < 4; ++m)
#pragma unroll
                for (int bj = 0; bj < 2; ++bj) {
                    const u32x4 zz = z[m][bj];
                    const f32x4 v0 = acc[ai][bj][m][0] * sc[bj][0], v1 = acc[ai][bj][m][1] * sc[bj][1];
                    u32x4 w; w.x = pk2(v0[0] * bflo(zz.x), v0[1] * bfhi(zz.x)); w.y = pk2(v0[2] * bflo(zz.y), v0[3] * bfhi(zz.y));
                    w.z = pk2(v1[0] * bflo(zz.z), v1[1] * bfhi(zz.z)); w.w = pk2(v1[2] * bflo(zz.w), v1[3] * bfhi(zz.w));
                    *(u32x4*)((char*)Y + (unsigned)(((row0 + ai * 128 + m * 16) * 3072 + 2048 + col0 + bj * 128) * 2)) = w;
                }
        }
        return true;
    }
};
struct EpiMerge {
    static constexpr bool PERM = true;
    const bf16_t* P; bf16_t* O;
    __device__ __forceinline__ bool operator()(f32x4 (&acc)[2][2][4][2], const Unit& u, int wr, int wc, int fr, int fq) const {
        asm volatile("" : "+v"(fr), "+v"(fq));
        const int row0 = u.pm * 256 + wr * 64 + fr, col0 = u.pn * 256 + wc * 32 + 8 * fq;
        const int br = u.aux;
        const int cnum = (br == 0) ? COL_GA : (br == 1) ? COL_GB : COL_GC;
        const int cden = (br == 0) ? COL_GB : COL_GC;
#pragma unroll
        for (int ai = 0; ai < 2; ++ai)
#pragma unroll
            for (int mp = 0; mp < 2; ++mp) {
                u32x4 gn[2][2], gd[2][2];
#pragma unroll
                for (int mm = 0; mm < 2; ++mm)
#pragma unroll
                    for (int bj = 0; bj < 2; ++bj) { const bf16_t* prow = P + (size_t)(row0 + ai * 128 + (2 * mp + mm) * 16) * NP + col0 + bj * 128;
                        gn[mm][bj] = *(const u32x4*)(prow + cnum); gd[mm][bj] = *(const u32x4*)(prow + cden); }
                asm volatile("" : "+v"(gn[0][0]), "+v"(gn[0][1]), "+v"(gn[1][0]), "+v"(gn[1][1]), "+v"(gd[0][0]), "+v"(gd[0][1]), "+v"(gd[1][0]), "+v"(gd[1][1]));
#pragma unroll
                for (int mm = 0; mm < 2; ++mm)
#pragma unroll
                    for (int bj = 0; bj < 2; ++bj) {
                        const int m = 2 * mp + mm; const u32x4 g = gn[mm][bj], d = gd[mm][bj];
                        f32x4 f0 = (f32x4){bflo(g.x), bfhi(g.x), bflo(g.y), bfhi(g.y)}, f1 = (f32x4){bflo(g.z), bfhi(g.z), bflo(g.w), bfhi(g.w)};
                        if (br < 2) {
                            f0[0] *= __builtin_amdgcn_rcpf(bflo(d.x)); f0[1] *= __builtin_amdgcn_rcpf(bfhi(d.x)); f0[2] *= __builtin_amdgcn_rcpf(bflo(d.y)); f0[3] *= __builtin_amdgcn_rcpf(bfhi(d.y));
                            f1[0] *= __builtin_amdgcn_rcpf(bflo(d.z)); f1[1] *= __builtin_amdgcn_rcpf(bfhi(d.z)); f1[2] *= __builtin_amdgcn_rcpf(bflo(d.w)); f1[3] *= __builtin_amdgcn_rcpf(bfhi(d.w));
                        }
                        acc[ai][bj][m][0] = acc[ai][bj][m][0] * f0; acc[ai][bj][m][1] = acc[ai][bj][m][1] * f1;
                        if (br == 2) {
                            const f32x4 v0 = acc[ai][bj][m][0], v1 = acc[ai][bj][m][1];
                            u32x4 w; w.x = pk2(v0[0], v0[1]); w.y = pk2(v0[2], v0[3]); w.z = pk2(v1[0], v1[1]); w.w = pk2(v1[2], v1[3]);
                            *(u32x4*)(O + (size_t)(row0 + ai * 128 + m * 16) * DM + col0 + bj * 128) = w;
                        }
                    }
            }
        return br == 2;
    }
};
struct EpiOut {
    static constexpr bool PERM = false;
    const float* xin; float* xout;
    __device__ __forceinline__ bool operator()(f32x4 (&acc)[2][2][4][2], const Unit& u, int wr, int wc, int fr, int fq) const {
        asm volatile("" : "+v"(fr), "+v"(fq));
        const int row0 = u.pm * 256 + wr * 64 + fr, col0 = u.pn * 256 + wc * 32 + 4 * fq;
#pragma unroll
        for (int ai = 0; ai < 2; ++ai)
#pragma unroll
            for (int mp = 0; mp < 2; ++mp) {
                f32x4 xo[2][2][2];
#pragma unroll
                for (int mm = 0; mm < 2; ++mm)
#pragma unroll
                    for (int bj = 0; bj < 2; ++bj)
#pragma unroll
                        for (int n = 0; n < 2; ++n) xo[mm][bj][n] = *(const f32x4*)(xin + (size_t)(row0 + ai * 128 + (2 * mp + mm) * 16) * DM + col0 + bj * 128 + n * 16);
                asm volatile("" : "+v"(xo[0][0][0]), "+v"(xo[0][0][1]), "+v"(xo[0][1][0]), "+v"(xo[0][1][1]), "+v"(xo[1][0][0]), "+v"(xo[1][0][1]), "+v"(xo[1][1][0]), "+v"(xo[1][1][1]));
#pragma unroll
                for (int mm = 0; mm < 2; ++mm)
#pragma unroll
                    for (int bj = 0; bj < 2; ++bj)
#pragma unroll
                        for (int n = 0; n < 2; ++n) *(f32x4*)(xout + (size_t)(row0 + ai * 128 + (2 * mp + mm) * 16) * DM + col0 + bj * 128 + n * 16) = xo[mm][bj][n] + acc[ai][bj][2 * mp + mm][n];
            }
        return true;
    }
};

struct Params {
    const float* x; const float* norm_g; const float* w_in; const float* ret_gn_g; const float* fox_b_f; const float* pool_w; const float* pool_scale;
    const float* w_ret; const float* w_fox; const float* w_pool; const float* w_out; const float* final_g;
    float* out; unsigned char* ws;
};

#define XB_TMO      128
#define XB_XCNT(j)  (256  + 64 * (j))
#define XB_XSUB(j)  (1280 + 64 * (j))
#define XB_XGEN(j)  (2304 + 64 * (j))
#define XB_TOP      3328
#define XB_TOPGEN   3392
#define XCD_BAR_WORDS 3456
#define XB_SPIN_CAP (1u << 18)

__device__ __forceinline__ unsigned xb_ld(unsigned* p)              { return __hip_atomic_load(p, __ATOMIC_RELAXED, __HIP_MEMORY_SCOPE_AGENT); }
__device__ __forceinline__ unsigned xb_add(unsigned* p, unsigned v) { return __hip_atomic_fetch_add(p, v, __ATOMIC_RELAXED, __HIP_MEMORY_SCOPE_AGENT); }
__device__ __forceinline__ unsigned xb_xcc_id() { return (unsigned)__builtin_amdgcn_s_getreg((3 << 11) | 20) & 0xFu; }
#define XB_SPIN(cond, bar) do { unsigned _sp = 0; while (cond) { __builtin_amdgcn_s_sleep(1); \
    if ((++_sp & 255u) == 0u) { if (xb_ld(&(bar)[XB_TMO])) break; if (_sp > XB_SPIN_CAP) { atomicAdd(&(bar)[XB_TMO], 1u); break; } } } } while (0)

struct XcdBarrier {
    unsigned* bar; unsigned x;
    volatile LAS unsigned* st;
};

__device__ __forceinline__ XcdBarrier xcd_barrier_post(unsigned* bar, volatile LAS unsigned* st) {
    XcdBarrier b; b.bar = bar; b.x = xb_xcc_id(); b.st = st;
    if (threadIdx.x == 0) (void)xb_add(&bar[XB_XCNT(b.x)], 1u);
    return b;
}
__device__ __forceinline__ void xcd_barrier_complete(unsigned* bar, unsigned x, unsigned& nloc, unsigned& nx) {
    const unsigned G = gridDim.x * gridDim.y * gridDim.z;
    unsigned sum, cnt, mine, sp = 0u;
    for (;;) {
        sum = 0u; cnt = 0u; mine = 0u;
#pragma unroll
        for (unsigned j = 0; j < 16; ++j) { const unsigned c = xb_ld(&bar[XB_XCNT(j)]); sum += c; cnt += (c > 0u) ? 1u : 0u; mine = (j == x) ? c : mine; }
        if (sum == G) break;
        __builtin_amdgcn_s_sleep(1);
        if ((++sp & 255u) == 0u) { if (xb_ld(&bar[XB_TMO])) break; if (sp > XB_SPIN_CAP) { atomicAdd(&bar[XB_TMO], 1u); break; } }
    }
    nloc = mine > 0u ? mine : 1u; nx = cnt > 0u ? cnt : 1u;
}

__device__ __forceinline__ void xcd_barrier(const XcdBarrier& b) {
    asm volatile("s_waitcnt vmcnt(0)" ::: "memory");
    __syncthreads();
    if (threadIdx.x == 0) {
        unsigned* bar = b.bar;
        __builtin_amdgcn_s_waitcnt(0);
        unsigned nloc = b.st[0], nx = b.st[1];
        if (nloc == 0u) { xcd_barrier_complete(bar, b.x, nloc, nx); b.st[0] = nloc; b.st[1] = nx; }
        const unsigned old = xb_add(&bar[XB_XSUB(b.x)], 1u);
        const unsigned gen = old / nloc;
        if (old + 1u == (gen + 1u) * nloc) {
            __builtin_amdgcn_fence(__ATOMIC_RELEASE, "agent");
            asm volatile("s_waitcnt vmcnt(0)" ::: "memory");
            const unsigned og = xb_add(&bar[XB_TOP], 1u);
            const unsigned tg = og / nx;
            if (og + 1u == (tg + 1u) * nx) xb_add(&bar[XB_TOPGEN], 1u);
            else XB_SPIN(xb_ld(&bar[XB_TOPGEN]) == tg, bar);
            __builtin_amdgcn_fence(__ATOMIC_ACQUIRE, "agent");
            xb_add(&bar[XB_XGEN(b.x)], 1u);
            asm volatile("s_waitcnt vmcnt(0)" ::: "memory");
        } else {
            XB_SPIN(xb_ld(&bar[XB_XGEN(b.x)]) == gen, bar);
            __builtin_amdgcn_fence(__ATOMIC_ACQUIRE, "agent");
            asm volatile("s_waitcnt vmcnt(0)" ::: "memory");
        }
    }
    __syncthreads();
}


typedef const Params __attribute__((address_space(4))) CParams;
__device__ __forceinline__ Params loadp() {
    const CParams* pp = (const CParams*)__builtin_amdgcn_kernarg_segment_ptr();
    asm volatile("" : "+s"(pp));
    Params p;
    p.x = pp->x; p.norm_g = pp->norm_g; p.w_in = pp->w_in; p.ret_gn_g = pp->ret_gn_g; p.fox_b_f = pp->fox_b_f; p.pool_w = pp->pool_w; p.pool_scale = pp->pool_scale;
    p.w_ret = pp->w_ret; p.w_fox = pp->w_fox; p.w_pool = pp->w_pool; p.w_out = pp->w_out; p.final_g = pp->final_g; p.out = pp->out; p.ws = pp->ws;
    return p;
}
__device__ __forceinline__ int launder_s(int v) { asm volatile("" : "+s"(v)); return v; }
__device__ __forceinline__ void geom(int& G, int& bx, int& vcu) { G = launder_s((int)gridDim.x); bx = launder_s((int)blockIdx.x); vcu = (G % 8 == 0) ? (bx % 8) * (G / 8) + bx / 8 : bx; }
__device__ __forceinline__ const float* sel_ptr(const float* a, const float* b, int useb) { const uintptr_t m = (uintptr_t)0 - (uintptr_t)(useb != 0); return (const float*)(((uintptr_t)a & ~m) | ((uintptr_t)b & m)); }

__device__ __forceinline__ int win_dest(int n) {
    if (n < 2048) { const int head = n >> 7, w = n & 127; return head * 128 + 2 * (w & 63) + (w >> 6); }
    if (n < 8192) return n;
    if (n < 8200) return -1;
    return n - 8;
}
struct TrItem { const float* W; bf16_t* WT; int ldw, ncols, K, item; bool winmap; };
__device__ __forceinline__ void tr_load(const TrItem& t, f32x4 (&ld)[8], int lane) {
    const int nblk = (t.ncols + 31) >> 5, kb = t.item / nblk, nb = t.item - kb * nblk, k0 = 64 * kb, n0 = 32 * nb;
    const int c4 = lane & 7, kr = lane >> 3; const bool okc = (n0 + 4 * c4) < t.ncols;
#pragma unroll
    for (int i = 0; i < 8; ++i) ld[i] = okc ? *(const f32x4*)(t.W + (size_t)(k0 + 8 * i + kr) * t.ldw + n0 + 4 * c4) : (f32x4){0.f, 0.f, 0.f, 0.f};
}
__device__ __forceinline__ void tr_finish(const TrItem& t, const f32x4 (&ld)[8], LAS float* scr, int lane) {
    const int nblk = (t.ncols + 31) >> 5, kb = t.item / nblk, nb = t.item - kb * nblk, k0 = 64 * kb, n0 = 32 * nb;
    const int c4 = lane & 7, kr = lane >> 3;
#pragma unroll
    for (int i = 0; i < 8; ++i) { LAS float* d = scr + (8 * i + kr) * 33 + 4 * c4; d[0] = ld[i].x; d[1] = ld[i].y; d[2] = ld[i].z; d[3] = ld[i].w; }
    LDS_WAIT(); asm volatile("" ::: "memory");
    const int c = lane & 7;
#pragma unroll
    for (int j = 0; j < 4; ++j) { const int n = (lane >> 3) + 8 * j; const int ns = n0 + n; const int dest = (ns < t.ncols) ? (t.winmap ? win_dest(ns) : ns) : -1;
        const LAS float* sp = scr + (8 * c) * 33 + n;
        u32x4 o; o.x = pk2(sp[0 * 33], sp[1 * 33]); o.y = pk2(sp[2 * 33], sp[3 * 33]); o.z = pk2(sp[4 * 33], sp[5 * 33]); o.w = pk2(sp[6 * 33], sp[7 * 33]);
        if (dest >= 0) *(u32x4*)(t.WT + (size_t)dest * t.K + k0 + 8 * c) = o; }
    LDS_WAIT(); asm volatile("" ::: "memory");
}

__device__ __forceinline__ void phase_a(LAS unsigned char* lds, int layer) {
    const Params p = loadp(); int G, bx, vcu; geom(G, bx, vcu); layer = launder_s(layer);
    const int tid = tid_l(), lane = tid & 63, wave = __builtin_amdgcn_readfirstlane(tid >> 6);
    unsigned char* ws = p.ws;
    const float* w_in = p.w_in + (size_t)layer * DM * CIN;
    LAS float* wff = (LAS float*)lds;
    for (int k = tid; k < DM; k += NTHREADS) {
        const float* src = w_in + (size_t)k * CIN + 8192;
        const f32x4 a = *(const f32x4*)src, b = *(const f32x4*)(src + 4);
        const int j = k >> 8, l = (k >> 2) & 63, i = k & 3;
        LAS float* d = wff + ((j * 4 + i) * 64 + l) * 8;
        *(LAS f32x4*)d = a; *(LAS f32x4*)(d + 4) = b;
    }
    __syncthreads();
    LAS float* scr = (LAS float*)(lds + 65536 + wave * 8448);
    const int gw = vcu * NWAVES + wave, NGW = G * NWAVES;
    constexpr int I_IN = 32 * 513, I_BR = 16 * 64, I_OUT = 32 * 64, I_PW = 4 * 8;
    constexpr int NITEMS = I_IN + 3 * I_BR + I_OUT + 4 * I_PW;
    auto decode = [&](int it) -> TrItem {
        TrItem t; int r = it; unsigned char* wsb = ws;
        if (r < I_IN) { t.W = w_in; t.WT = (bf16_t*)(wsb + WS_WIN); t.ldw = CIN; t.ncols = CIN; t.K = DM; t.item = r; t.winmap = true; return t; } r -= I_IN;
        t.winmap = false;
        if (r < 3 * I_BR) { const int q = r / I_BR; r -= q * I_BR; const float* wb = (q == 0) ? p.w_ret : (q == 1) ? p.w_fox : p.w_pool;
            t.W = wb + (size_t)layer * 1024 * DM; t.WT = (bf16_t*)(wsb + WS_WBR) + (size_t)q * 2048 * 1024; t.ldw = DM; t.ncols = DM; t.K = 1024; t.item = r; return t; } r -= 3 * I_BR;
        if (r < I_OUT) { t.W = p.w_out + (size_t)layer * DM * DM; t.WT = (bf16_t*)(wsb + WS_WOUT); t.ldw = DM; t.ncols = DM; t.K = DM; t.item = r; return t; } r -= I_OUT;
        { const int g = r / I_PW; t.W = p.pool_w + (size_t)layer * 4 * 65536 + (size_t)g * 65536; t.WT = (bf16_t*)(wsb + WS_WPOOL) + (size_t)g * 65536; t.ldw = 256; t.ncols = 256; t.K = 256; t.item = r - g * I_PW; return t; }
    };
    {
        int it = gw;
        if (it < NITEMS) {
            TrItem cur = decode(it); f32x4 lda[8], ldb[8];
            tr_load(cur, lda, lane);
            for (;;) {
                const int nit = it + NGW; const bool hn = nit < NITEMS;
                TrItem nxt = cur; if (hn) { nxt = decode(nit); tr_load(nxt, ldb, lane); }
                tr_finish(cur, lda, scr, lane);
                if (!hn) break;
#pragma unroll
                for (int i = 0; i < 8; ++i) lda[i] = ldb[i];
                cur = nxt; it = nit;
            }
        }
    }
    if (layer == 0) {
        float* rope = (float*)(ws + WS_ROPE);
        for (int idx = (vcu * NTHREADS + tid); idx < SEQ * 64; idx += G * NTHREADS) {
            const int pos = idx >> 6, j = idx & 63;
            const float inv = exp2f(-(float)j * (13.287712379549449f / 64.0f));
            const float ang = (float)pos * inv;
            double rev = (double)ang * 0.15915494309189535; rev -= floor(rev);
            const float rf = (float)rev;
            rope[2 * idx] = __builtin_amdgcn_cosf(rf); rope[2 * idx + 1] = __builtin_amdgcn_sinf(rf);
        }
    }
    const float* xin = sel_ptr(p.x, p.out, layer);
    const float* g = p.norm_g + (size_t)layer * DM;
    bf16_t* H = (bf16_t*)(ws + WS_H);
    float* lsig = (float*)(ws + WS_LSIG);
    const float* bf = p.fox_b_f + layer * 8;
    f32x4 gv[8];
#pragma unroll
    for (int j = 0; j < 8; ++j) gv[j] = *((const f32x4*)g + lane + 64 * j);
    f32x4 vn[8];
    if (gw < M) {
#pragma unroll
        for (int j = 0; j < 8; ++j) vn[j] = *((const f32x4*)(xin + (size_t)gw * DM) + lane + 64 * j);
    }
    for (int m = gw; m < M; m += NGW) {
        f32x4 v[8]; float ss = 0.f;
#pragma unroll
        for (int j = 0; j < 8; ++j) { v[j] = vn[j]; ss += (v[j].x * v[j].x + v[j].y * v[j].y) + (v[j].z * v[j].z + v[j].w * v[j].w); }
        if (m + NGW < M) {
#pragma unroll
            for (int j = 0; j < 8; ++j) vn[j] = *((const f32x4*)(xin + (size_t)(m + NGW) * DM) + lane + 64 * j);
        }
        const float rstd = 1.0f / sqrtf(wave_sum(ss) * (1.0f / DM) + EPS);
        float fa[8];
#pragma unroll
        for (int o = 0; o < 8; ++o) fa[o] = 0.f;
        u32x2* o8 = (u32x2*)(H + (size_t)m * DM) + lane;
#pragma unroll
        for (int j = 0; j < 8; ++j) {
            const f32x4 hv = v[j] * rstd * gv[j];
            u32x2 w; w.x = pk2(hv.x, hv.y); w.y = pk2(hv.z, hv.w); o8[64 * j] = w;
#pragma unroll
            for (int i = 0; i < 4; ++i) {
                const LAS float* wp = wff + ((j * 4 + i) * 64 + lane) * 8;
                const f32x4 wa = *(const LAS f32x4*)wp, wb = *(const LAS f32x4*)(wp + 4);
                const float hh = hv[i];
                fa[0] += hh * wa.x; fa[1] += hh * wa.y; fa[2] += hh * wa.z; fa[3] += hh * wa.w;
                fa[4] += hh * wb.x; fa[5] += hh * wb.y; fa[6] += hh * wb.z; fa[7] += hh * wb.w;
            }
            asm volatile("" ::: "memory");
        }
        float mine = 0.f;
#pragma unroll
        for (int o = 0; o < 8; ++o) { const float t = wave_sum(fa[o]); mine = (lane == o) ? t : mine; }
        if (lane < 8) { const float xl = mine + bf[lane]; lsig[(size_t)m * 8 + lane] = fminf(xl, 0.f) - log1pf(__expf(-fabsf(xl))); }
    }
    __syncthreads();
}

__device__ __forceinline__ int swap23(int t) { return (t & ~12) | ((t & 4) << 1) | ((t & 8) >> 1); }
__device__ __forceinline__ int tswz(int row) { return ((row >> 3) ^ (row & 7)) & 15; }
__device__ __forceinline__ int timg(int row, int pos) { return row * 256 + ((((pos >> 3) ^ tswz(row)) << 4) | ((pos & 7) << 1)); }

template <bool RET>
__device__ __forceinline__ void c1_chunk_unit(const Params& p, LAS unsigned char* lds, int layer, int unit) {
    const int tid = tid_l(), lane = tid & 63, wave = __builtin_amdgcn_readfirstlane(tid >> 6);
    const int bh = unit >> 4, c = unit & 15, b = bh >> 3, h = bh & 7;
    const bf16_t* PROJ = (const bf16_t*)(p.ws + WS_PROJ);
    const size_t tok0 = (size_t)b * SEQ + c * 128;
    LAS unsigned char* VtL = lds; LAS unsigned char* KtL = lds + 32768;
    const float lg2 = log1pf(-exp2f(-5.0f - (float)h)) * LOG2E;
    {
        const int T = tid >> 4, ch = tid & 15, pos0 = swap23(4 * T);
        const bf16_t* src = PROJ + (tok0 + 4 * T) * NP + h * 128 + ch * 8;
        u32x4 vv[4], kv[4];
#pragma unroll
        for (int j = 0; j < 4; ++j) { vv[j] = *(const u32x4*)(src + (size_t)j * NP + (RET ? COL_RV : COL_FV)); if (RET) kv[j] = *(const u32x4*)(src + (size_t)j * NP + COL_RK); }
#pragma unroll
        for (int e = 0; e < 4; ++e) {
            const unsigned w0 = vv[0][e], w1 = vv[1][e], w2 = vv[2][e], w3 = vv[3][e];
            u32x2 lo, hi; lo.x = (w0 & 0xffffu) | (w1 << 16); lo.y = (w2 & 0xffffu) | (w3 << 16); hi.x = (w0 >> 16) | (w1 & 0xffff0000u); hi.y = (w2 >> 16) | (w3 & 0xffff0000u);
            *(LAS u32x2*)(VtL + timg(ch * 8 + 2 * e, pos0)) = lo;
            *(LAS u32x2*)(VtL + timg(ch * 8 + 2 * e + 1, pos0)) = hi;
        }
        if (RET) {
            float z[4];
#pragma unroll
            for (int j = 0; j < 4; ++j) z[j] = __builtin_amdgcn_exp2f(lg2 * (float)(127 - (4 * T + j)));
#pragma unroll
            for (int e = 0; e < 4; ++e) {
                const unsigned w0 = kv[0][e], w1 = kv[1][e], w2 = kv[2][e], w3 = kv[3][e];
                u32x2 lo, hi; lo.x = pk2(bflo(w0) * z[0], bflo(w1) * z[1]); lo.y = pk2(bflo(w2) * z[2], bflo(w3) * z[3]);
                hi.x = pk2(bfhi(w0) * z[0], bfhi(w1) * z[1]); hi.y = pk2(bfhi(w2) * z[2], bfhi(w3) * z[3]);
                *(LAS u32x2*)(KtL + timg(ch * 8 + 2 * e, pos0)) = lo;
                *(LAS u32x2*)(KtL + timg(ch * 8 + 2 * e + 1, pos0)) = hi;
            }
        }
    }
    __syncthreads();
    bf16_t* VT = (bf16_t*)(p.ws + (RET ? WS_VTR : WS_VTF));
#pragma unroll
    for (int i = 0; i < 4; ++i) {
        const int pc = tid + 512 * i, d = pc >> 4, ch = pc & 15;
        const u32x4 w = *(const LAS u32x4*)(VtL + d * 256 + ((ch ^ tswz(d)) << 4));
        *(u32x4*)(VT + ((size_t)bh * 128 + d) * SEQ + c * 128 + ch * 8) = w;
    }
    if (RET) {
        const int l31 = lane & 31, hh = lane >> 5;
        const int bv = wave >> 1, bk0 = 2 * (wave & 1);
        f32x16 a0 = {}, a1 = {};
        const int rv = 32 * bv + l31, rk0 = 32 * bk0 + l31, rk1 = rk0 + 32;
#pragma unroll
        for (int s = 0; s < 8; ++s) {
            const int chunk = 2 * s + hh;
            const bf16x8 A = *(const LAS bf16x8*)(VtL + rv * 256 + ((chunk ^ tswz(rv)) << 4));
            const bf16x8 B0 = *(const LAS bf16x8*)(KtL + rk0 * 256 + ((chunk ^ tswz(rk0)) << 4));
            const bf16x8 B1 = *(const LAS bf16x8*)(KtL + rk1 * 256 + ((chunk ^ tswz(rk1)) << 4));
            a0 = __builtin_amdgcn_mfma_f32_32x32x16_bf16(A, B0, a0, 0, 0, 0);
            a1 = __builtin_amdgcn_mfma_f32_32x32x16_bf16(A, B1, a1, 0, 0, 0);
        }
        float* ST = (float*)(p.ws + WS_STATE) + (size_t)unit * 16384;
#pragma unroll
        for (int r = 0; r < 16; ++r) {
            const int dv = 32 * bv + (r & 3) + 8 * (r >> 2) + 4 * hh;
            ST[dv * 128 + 32 * bk0 + l31] = a0[r];
            ST[dv * 128 + 32 * bk0 + 32 + l31] = a1[r];
        }
    }
    __syncthreads();
}

template <int W>
__device__ __forceinline__ void pooled_rows(const bf16_t* PROJ, bf16_t* PO, int r0, int col) {
    constexpr int NL = 8 + W - 1;
    const int t0 = r0 & (SEQ - 1);
    u32x4 L[NL];
#pragma unroll
    for (int j = 0; j < NL; ++j) { const int dt = j - (W - 1); L[j] = (t0 + dt >= 0) ? *(const u32x4*)(PROJ + (size_t)(r0 + dt) * NP + COL_PU + col) : (u32x4){0u, 0u, 0u, 0u}; }
    float s[8];
#pragma unroll
    for (int e = 0; e < 8; ++e) s[e] = 0.f;
#pragma unroll
    for (int j = 0; j < W - 1; ++j) { s[0] += bflo(L[j].x); s[1] += bfhi(L[j].x); s[2] += bflo(L[j].y); s[3] += bfhi(L[j].y); s[4] += bflo(L[j].z); s[5] += bfhi(L[j].z); s[6] += bflo(L[j].w); s[7] += bfhi(L[j].w); }
#pragma unroll
    for (int k = 0; k < 8; ++k) {
        const u32x4 nw = L[k + W - 1];
        s[0] += bflo(nw.x); s[1] += bfhi(nw.x); s[2] += bflo(nw.y); s[3] += bfhi(nw.y); s[4] += bflo(nw.z); s[5] += bfhi(nw.z); s[6] += bflo(nw.w); s[7] += bfhi(nw.w);
        const int n = (t0 + k + 1 < W) ? (t0 + k + 1) : W;
        const float inv = 1.0f / (float)n;
        u32x4 o;
        o.x = pk2(s[0] * inv - bflo(nw.x), s[1] * inv - bfhi(nw.x)); o.y = pk2(s[2] * inv - bflo(nw.y), s[3] * inv - bfhi(nw.y));
        o.z = pk2(s[4] * inv - bflo(nw.z), s[5] * inv - bfhi(nw.z)); o.w = pk2(s[6] * inv - bflo(nw.w), s[7] * inv - bfhi(nw.w));
        *(u32x4*)(PO + (size_t)(r0 + k) * 1024 + col) = o;
        const u32x4 od = L[k];
        s[0] -= bflo(od.x); s[1] -= bfhi(od.x); s[2] -= bflo(od.y); s[3] -= bfhi(od.y); s[4] -= bflo(od.z); s[5] -= bfhi(od.z); s[6] -= bflo(od.w); s[7] -= bfhi(od.w);
    }
}
__device__ __forceinline__ void c1_pooled_unit(const Params& p, int unit) {
    const int tid = tid_l(), lane = tid & 63, w8 = __builtin_amdgcn_readfirstlane(tid >> 6);
    const bf16_t* PROJ = (const bf16_t*)(p.ws + WS_PROJ);
    bf16_t* PO = (bf16_t*)(p.ws + WS_POOLED);
    const int g = w8 & 3, col = g * 256 + (lane & 31) * 8;
    const int strip = (w8 >> 2) * 2 + (lane >> 5);
#pragma unroll 1
    for (int pass = 0; pass < 2; ++pass) {
        const int r0 = unit * 64 + strip * 16 + pass * 8;
        if (g == 0) pooled_rows<2>(PROJ, PO, r0, col);
        else if (g == 1) pooled_rows<4>(PROJ, PO, r0, col);
        else if (g == 2) pooled_rows<8>(PROJ, PO, r0, col);
        else pooled_rows<16>(PROJ, PO, r0, col);
    }
}

__device__ __forceinline__ void c1_cumsum_unit(const Params& p, int b) {
    const int tid = tid_l(), lane = tid & 63, h = tid >> 6;
    const float* lsig = (const float*)(p.ws + WS_LSIG) + ((size_t)b * SEQ + lane) * 8 + h;
    float* cum = (float*)(p.ws + WS_CUM) + (size_t)(b * 8 + h) * SEQ + lane;
    float v[32];
#pragma unroll
    for (int i = 0; i < 32; ++i) v[i] = lsig[(size_t)i * 64 * 8];
    float carry = 0.f;
#pragma unroll
    for (int i = 0; i < 32; ++i) {
        float inc = v[i];
#pragma unroll
        for (int o = 1; o < 64; o <<= 1) { const float t = __shfl_up(inc, o); if (lane >= o) inc += t; }
        inc += carry;
        cum[i * 64] = inc * LOG2E;
        carry = __shfl(inc, 63);
    }
}

__device__ __forceinline__ void phase_c1(LAS unsigned char* lds, int layer) {
    const Params p = loadp(); int G, bx, vcu; geom(G, bx, vcu); layer = launder_s(layer);
    constexpr int NU = 1024 + 1024 + 256 + 8;
    for (int u = vcu; u < NU; u += G) {
        if (u < 1024) c1_chunk_unit<true>(p, lds, layer, u);
        else if (u < 2048) c1_chunk_unit<false>(p, lds, layer, u - 1024);
        else if (u < 2304) c1_pooled_unit(p, u - 2048);
        else c1_cumsum_unit(p, u - 2304);
    }
}

__device__ __forceinline__ void phase_c1b() {
    const Params p = loadp(); int G, bx, vcu; geom(G, bx, vcu);
    const float* ST = (const float*)(p.ws + WS_STATE);
    bf16_t* SC = (bf16_t*)(p.ws + WS_STATEC);
    for (int idx = vcu * NTHREADS + tid_l(); idx < 64 * 4096; idx += G * NTHREADS) {
        const int bh = idx >> 12, e4 = idx & 4095, h = bh & 7;
        const float gch = exp2f(log1pf(-exp2f(-5.0f - (float)h)) * LOG2E * 128.0f);
        const size_t off0 = (size_t)bh * 16 * 16384 + e4 * 4;
        f32x4 sv[15];
#pragma unroll
        for (int c = 0; c < 15; ++c) sv[c] = *(const f32x4*)(ST + off0 + (size_t)c * 16384);
        f32x4 run = (f32x4){0.f, 0.f, 0.f, 0.f};
#pragma unroll
        for (int c = 1; c < 16; ++c) {
            run = run * gch + sv[c - 1];
            u32x2 w; w.x = pk2(run.x, run.y); w.y = pk2(run.z, run.w);
            *(u32x2*)(SC + off0 + (size_t)c * 16384) = w;
        }
    }
}

__device__ __forceinline__ bf16x8 pack8(const f32x16& v, int base) {
    u32x4 w; w.x = pk2(v[base + 0], v[base + 1]); w.y = pk2(v[base + 2], v[base + 3]); w.z = pk2(v[base + 4], v[base + 5]); w.w = pk2(v[base + 6], v[base + 7]);
    return __builtin_bit_cast(bf16x8, w);
}

__device__ __forceinline__ void attn_block(const Params& p, LAS unsigned char* lds, int bh, int qb) {
    const int tid = tid_l(), lane = tid & 63, w = __builtin_amdgcn_readfirstlane(tid >> 6), l31 = lane & 31, hh = lane >> 5;
    const int b = bh >> 3, h = bh & 7;
    const bf16_t* PROJ = (const bf16_t*)(p.ws + WS_PROJ);
    const bf16_t* VTF = (const bf16_t*)(p.ws + WS_VTF) + (size_t)bh * 128 * SEQ;
    const float* cum = (const float*)(p.ws + WS_CUM) + (size_t)bh * SEQ;
    bf16_t* Y = (bf16_t*)(p.ws + WS_Y);
    const size_t rowbase = (size_t)b * SEQ;
    const int qrow = 256 * qb + 32 * w + l31;
    bf16x8 Qf[8];
    { const bf16_t* qp = PROJ + (rowbase + qrow) * NP + COL_FQ + h * 128 + 8 * hh;
#pragma unroll
      for (int ks = 0; ks < 8; ++ks) Qf[ks] = *(const bf16x8*)(qp + 16 * ks); }
    bf16x8 Qone;
    { u32x4 o; o.x = hh ? 0u : 0x3F803F80u; o.y = hh ? 0u : 0x00003F80u; o.z = 0u; o.w = 0u; Qone = __builtin_bit_cast(bf16x8, o); }
    const int ntiles = 4 * (qb + 1), wlast = 4 * qb + (w >> 1);
    const bf16_t* ksrc[2]; const bf16_t* vsrc[2];
#pragma unroll
    for (int i = 0; i < 2; ++i) {
        const int krow = (w + 8 * i) * 4 + (lane >> 4), kch = (lane & 15) ^ (krow & 15);
        ksrc[i] = PROJ + (rowbase + krow) * NP + COL_FK + h * 128 + kch * 8;
        const int vrow = (w + 8 * i) * 8 + (lane >> 3), vch = (lane & 7) ^ ((vrow >> 1) & 7);
        vsrc[i] = VTF + (size_t)vrow * SEQ + vch * 8;
    }
#define ATT_ISSUE(tile, bufoff) do { LAS unsigned char* b_ = lds + (bufoff) + w * 1024; \
        _Pragma("unroll") for (int i_ = 0; i_ < 2; ++i_) { \
            __builtin_amdgcn_global_load_lds((const unsigned*)(ksrc[i_] + (size_t)(tile) * 64 * NP), (LAS unsigned*)(b_ + i_ * 8192), 16, 0, 0); \
            __builtin_amdgcn_global_load_lds((const unsigned*)(vsrc[i_] + (tile) * 64), (LAS unsigned*)(b_ + 16384 + i_ * 8192), 16, 0, 0); } } while (0)
    int kaddr[4], vaddr[4];
#pragma unroll
    for (int q = 0; q < 4; ++q) { kaddr[q] = l31 * 256 + (((2 * q + hh) ^ (l31 & 15)) << 4); vaddr[q] = l31 * 128 + (((2 * q + hh) ^ ((l31 >> 1) & 7)) << 4); }
    f32x16 O0 = {}, O1 = {}, O2 = {}, O3 = {};
    float mrun = -1e30f, lrun = 0.f;
    LAS float* cumL = (LAS float*)(lds + 98304);
    *(LAS f32x4*)(cumL + 4 * tid) = *(const f32x4*)(cum + 4 * tid);
    ATT_ISSUE(ntiles - 1, 0);
    if (ntiles > 1) ATT_ISSUE(ntiles - 2, 32768);
    __syncthreads();
    int bcur = 0, bnext2 = 65536;
    for (int it = 0; it < ntiles; ++it) {
        const int kt = ntiles - 1 - it;
        if (it + 1 < ntiles) asm volatile("s_waitcnt vmcnt(4)" ::: "memory"); else asm volatile("s_waitcnt vmcnt(0)" ::: "memory");
        __builtin_amdgcn_s_barrier(); asm volatile("" ::: "memory");
        if (it + 2 < ntiles) ATT_ISSUE(kt - 2, bnext2);
        LAS unsigned char* buf = lds + bcur;
        if (kt <= wlast) {
            const float cb0 = -cumL[64 * kt + l31], cb1 = -cumL[64 * kt + 32 + l31];
            f32x16 S0 = {}, S1 = {};
#define PIN8(X) asm volatile("" : "+v"(X[0]), "+v"(X[1]), "+v"(X[2]), "+v"(X[3]), "+v"(X[4]), "+v"(X[5]), "+v"(X[6]), "+v"(X[7]))
#pragma unroll
            for (int hf = 0; hf < 2; ++hf) {
                bf16x8 Kf[8];
#pragma unroll
                for (int k2 = 0; k2 < 2; ++k2) { const int ks = 2 * hf + k2;
                    LAS unsigned char* kp_ = buf + kaddr[ks]; LAS unsigned char* kq_ = buf + (kaddr[ks] ^ 128);
                    Kf[4 * k2 + 0] = *(const LAS bf16x8*)(kp_); Kf[4 * k2 + 1] = *(const LAS bf16x8*)(kp_ + 8192);
                    Kf[4 * k2 + 2] = *(const LAS bf16x8*)(kq_); Kf[4 * k2 + 3] = *(const LAS bf16x8*)(kq_ + 8192); }
                PIN8(Kf);
#pragma unroll
                for (int k2 = 0; k2 < 2; ++k2) { const int ks = 2 * hf + k2;
                    S0 = __builtin_amdgcn_mfma_f32_32x32x16_bf16(Kf[4 * k2 + 0], Qf[ks], S0, 0, 0, 0);
                    S1 = __builtin_amdgcn_mfma_f32_32x32x16_bf16(Kf[4 * k2 + 1], Qf[ks], S1, 0, 0, 0);
                    S0 = __builtin_amdgcn_mfma_f32_32x32x16_bf16(Kf[4 * k2 + 2], Qf[ks + 4], S0, 0, 0, 0);
                    S1 = __builtin_amdgcn_mfma_f32_32x32x16_bf16(Kf[4 * k2 + 3], Qf[ks + 4], S1, 0, 0, 0); }
            }
            {
                const unsigned h0 = f2bf(cb0); const float r0f = cb0 - bflo(h0); const unsigned m0 = f2bf(r0f); const unsigned l0 = f2bf(r0f - bflo(m0));
                const unsigned h1 = f2bf(cb1); const float r1f = cb1 - bflo(h1); const unsigned m1 = f2bf(r1f); const unsigned l1 = f2bf(r1f - bflo(m1));
                u32x4 a0 = {hh ? 0u : (h0 | (m0 << 16)), hh ? 0u : l0, 0u, 0u}, a1 = {hh ? 0u : (h1 | (m1 << 16)), hh ? 0u : l1, 0u, 0u};
                S0 = __builtin_amdgcn_mfma_f32_32x32x16_bf16(__builtin_bit_cast(bf16x8, a0), Qone, S0, 0, 0, 0);
                S1 = __builtin_amdgcn_mfma_f32_32x32x16_bf16(__builtin_bit_cast(bf16x8, a1), Qone, S1, 0, 0, 0);
            }
            if (kt == wlast) {
                const float NEG = -__builtin_inff();
                const int kb = 64 * kt + 4 * hh;
#pragma unroll
                for (int r = 0; r < 16; ++r) { const int key = kb + (r & 3) + 8 * (r >> 2); if (key > qrow) S0[r] = NEG; if (key + 32 > qrow) S1[r] = NEG; }
            }
            float mx = S0[0];
#pragma unroll
            for (int r = 1; r < 16; ++r) mx = fmaxf(mx, S0[r]);
#pragma unroll
            for (int r = 0; r < 16; ++r) mx = fmaxf(mx, S1[r]);
            { const auto rr_ = __builtin_amdgcn_permlane32_swap(__builtin_bit_cast(unsigned, mx), __builtin_bit_cast(unsigned, mx), false, false);
              mx = fmaxf(__builtin_bit_cast(float, rr_[0]), __builtin_bit_cast(float, rr_[1])); }
            if (!__all(mx - mrun < -160.0f)) {
                if (!__all(mx <= mrun)) {
                    const float mnew = fmaxf(mrun, mx);
                    const float alpha = __builtin_amdgcn_exp2f(mrun - mnew);
                    mrun = mnew; lrun *= alpha;
                    O0 = O0 * alpha; O1 = O1 * alpha; O2 = O2 * alpha; O3 = O3 * alpha;
                }
                float ps = 0.f;
#pragma unroll
                for (int r = 0; r < 16; ++r) { S0[r] = __builtin_amdgcn_exp2f(S0[r] - mrun); S1[r] = __builtin_amdgcn_exp2f(S1[r] - mrun); ps += S0[r] + S1[r]; }
                lrun += ps;
                const bf16x8 P00 = pack8(S0, 0), P01 = pack8(S0, 8), P10 = pack8(S1, 0), P11 = pack8(S1, 8);
                LAS unsigned char* vb = buf + 16384;
#pragma unroll
                for (int hf = 0; hf < 2; ++hf) {
                    bf16x8 Vf[8];
#pragma unroll
                    for (int q2 = 0; q2 < 2; ++q2)
#pragma unroll
                        for (int db = 0; db < 4; ++db) Vf[4 * q2 + db] = *(const LAS bf16x8*)(vb + vaddr[2 * hf + q2] + 4096 * db);
                    PIN8(Vf);
                    const bf16x8 Pa = hf ? P10 : P00, Pb = hf ? P11 : P01;
                    O0 = __builtin_amdgcn_mfma_f32_32x32x16_bf16(Vf[0], Pa, O0, 0, 0, 0); O1 = __builtin_amdgcn_mfma_f32_32x32x16_bf16(Vf[1], Pa, O1, 0, 0, 0);
                    O2 = __builtin_amdgcn_mfma_f32_32x32x16_bf16(Vf[2], Pa, O2, 0, 0, 0); O3 = __builtin_amdgcn_mfma_f32_32x32x16_bf16(Vf[3], Pa, O3, 0, 0, 0);
                    O0 = __builtin_amdgcn_mfma_f32_32x32x16_bf16(Vf[4], Pb, O0, 0, 0, 0); O1 = __builtin_amdgcn_mfma_f32_32x32x16_bf16(Vf[5], Pb, O1, 0, 0, 0);
                    O2 = __builtin_amdgcn_mfma_f32_32x32x16_bf16(Vf[6], Pb, O2, 0, 0, 0); O3 = __builtin_amdgcn_mfma_f32_32x32x16_bf16(Vf[7], Pb, O3, 0, 0, 0);
                }
#undef PIN8
            }
        }
        bnext2 = bcur; bcur = (bcur == 65536) ? 0 : bcur + 32768;
    }
#undef ATT_ISSUE
    const float ltot = lrun + __shfl_xor(lrun, 32);
    const float inv = __builtin_amdgcn_rcpf(ltot);
    const size_t grow = rowbase + qrow;
    const bf16_t* zp = PROJ + grow * NP + COL_FZ + h * 128 + 4 * hh;
    bf16_t* yp = Y + grow * 3072 + 1024 + h * 128 + 4 * hh;
    u32x2 zz[16];
#pragma unroll
    for (int i = 0; i < 16; ++i) zz[i] = *(const u32x2*)(zp + 32 * (i >> 2) + 8 * (i & 3));
    asm volatile("" : "+v"(zz[0]), "+v"(zz[1]), "+v"(zz[2]), "+v"(zz[3]), "+v"(zz[4]), "+v"(zz[5]), "+v"(zz[6]), "+v"(zz[7]));
    asm volatile("" : "+v"(zz[8]), "+v"(zz[9]), "+v"(zz[10]), "+v"(zz[11]), "+v"(zz[12]), "+v"(zz[13]), "+v"(zz[14]), "+v"(zz[15]));
#define ATT_ST(OX, db) do { _Pragma("unroll") for (int g = 0; g < 4; ++g) { const u32x2 z = zz[4 * (db) + g]; u32x2 o; \
        o.x = pk2(OX[4 * g + 0] * inv * bflo(z.x), OX[4 * g + 1] * inv * bfhi(z.x)); o.y = pk2(OX[4 * g + 2] * inv * bflo(z.y), OX[4 * g + 3] * inv * bfhi(z.y)); \
        *(u32x2*)(yp + 32 * (db) + 8 * g) = o; } } while (0)
    ATT_ST(O0, 0); ATT_ST(O1, 1); ATT_ST(O2, 2); ATT_ST(O3, 3);
#undef ATT_ST
    __syncthreads();
}

__device__ __forceinline__ void ret_out_unit(const Params& p, int layer, int unit, int gq) {
    const int lane = tid_l() & 63, l31 = lane & 31, hh = lane >> 5;
    const int bh = unit >> 4, c = unit & 15, b = bh >> 3, h = bh & 7;
    const bf16_t* PROJ = (const bf16_t*)(p.ws + WS_PROJ);
    const bf16_t* VTR = (const bf16_t*)(p.ws + WS_VTR) + (size_t)bh * 128 * SEQ + c * 128;
    const bf16_t* SC = (const bf16_t*)(p.ws + WS_STATEC) + (size_t)unit * 16384;
    bf16_t* Y = (bf16_t*)(p.ws + WS_Y);
    const size_t tok0 = (size_t)b * SEQ + c * 128;
    const int ql = 32 * gq + l31;
    const float lg2 = log1pf(-exp2f(-5.0f - (float)h)) * LOG2E;
    bf16x8 Qf[8];
    { const bf16_t* qp = PROJ + (tok0 + ql) * NP + COL_RQ + h * 128 + 8 * hh;
#pragma unroll
      for (int ks = 0; ks < 8; ++ks) Qf[ks] = *(const bf16x8*)(qp + 16 * ks); }
    f32x16 O0 = {}, O1 = {}, O2 = {}, O3 = {};
#define PIN8(X) asm volatile("" : "+v"(X[0]), "+v"(X[1]), "+v"(X[2]), "+v"(X[3]), "+v"(X[4]), "+v"(X[5]), "+v"(X[6]), "+v"(X[7]))
    if (c > 0) {
        const bf16_t* sp = SC + (size_t)l31 * 128 + 8 * hh;
#pragma unroll
        for (int kh = 0; kh < 2; ++kh) {
            bf16x8 Fa[8], Fb[8];
#pragma unroll
            for (int k4 = 0; k4 < 4; ++k4) { const int ks = 4 * kh + k4;
                Fa[2 * k4] = *(const bf16x8*)(sp + 0 * 4096 + 16 * ks); Fa[2 * k4 + 1] = *(const bf16x8*)(sp + 1 * 4096 + 16 * ks);
                Fb[2 * k4] = *(const bf16x8*)(sp + 2 * 4096 + 16 * ks); Fb[2 * k4 + 1] = *(const bf16x8*)(sp + 3 * 4096 + 16 * ks); }
            PIN8(Fa); PIN8(Fb);
#pragma unroll
            for (int k4 = 0; k4 < 4; ++k4) { const int ks = 4 * kh + k4;
                O0 = __builtin_amdgcn_mfma_f32_32x32x16_bf16(Fa[2 * k4], Qf[ks], O0, 0, 0, 0);
                O1 = __builtin_amdgcn_mfma_f32_32x32x16_bf16(Fa[2 * k4 + 1], Qf[ks], O1, 0, 0, 0);
                O2 = __builtin_amdgcn_mfma_f32_32x32x16_bf16(Fb[2 * k4], Qf[ks], O2, 0, 0, 0);
                O3 = __builtin_amdgcn_mfma_f32_32x32x16_bf16(Fb[2 * k4 + 1], Qf[ks], O3, 0, 0, 0); }
        }
        const float xi = __builtin_amdgcn_exp2f(lg2 * (float)(ql + 1));
        O0 = O0 * xi; O1 = O1 * xi; O2 = O2 * xi; O3 = O3 * xi;
    }
    for (int kb = 0; kb <= gq; ++kb) {
        const bf16_t* kp = PROJ + (tok0 + 32 * kb + l31) * NP + COL_RK + h * 128 + 8 * hh;
        const bf16_t* vp = VTR + (size_t)l31 * SEQ + 32 * kb + 8 * hh;
        bf16x8 Kf[8], Vf[8];
#pragma unroll
        for (int ks = 0; ks < 8; ++ks) Kf[ks] = *(const bf16x8*)(kp + 16 * ks);
#pragma unroll
        for (int db = 0; db < 4; ++db) { Vf[2 * db] = *(const bf16x8*)(vp + (size_t)(32 * db) * SEQ); Vf[2 * db + 1] = *(const bf16x8*)(vp + (size_t)(32 * db) * SEQ + 16); }
        PIN8(Kf);
        f32x16 S = {};
#pragma unroll
        for (int ks = 0; ks < 8; ++ks) S = __builtin_amdgcn_mfma_f32_32x32x16_bf16(Kf[ks], Qf[ks], S, 0, 0, 0);
#pragma unroll
        for (int r = 0; r < 16; ++r) { const int key = 32 * kb + (r & 3) + 8 * (r >> 2) + 4 * hh; const int d = ql - key; S[r] = (d >= 0) ? S[r] * __builtin_amdgcn_exp2f(lg2 * (float)d) : 0.f; }
        const bf16x8 P0 = pack8(S, 0), P1 = pack8(S, 8);
        PIN8(Vf);
        O0 = __builtin_amdgcn_mfma_f32_32x32x16_bf16(Vf[0], P0, O0, 0, 0, 0); O1 = __builtin_amdgcn_mfma_f32_32x32x16_bf16(Vf[2], P0, O1, 0, 0, 0);
        O2 = __builtin_amdgcn_mfma_f32_32x32x16_bf16(Vf[4], P0, O2, 0, 0, 0); O3 = __builtin_amdgcn_mfma_f32_32x32x16_bf16(Vf[6], P0, O3, 0, 0, 0);
        O0 = __builtin_amdgcn_mfma_f32_32x32x16_bf16(Vf[1], P1, O0, 0, 0, 0); O1 = __builtin_amdgcn_mfma_f32_32x32x16_bf16(Vf[3], P1, O1, 0, 0, 0);
        O2 = __builtin_amdgcn_mfma_f32_32x32x16_bf16(Vf[5], P1, O2, 0, 0, 0); O3 = __builtin_amdgcn_mfma_f32_32x32x16_bf16(Vf[7], P1, O3, 0, 0, 0);
    }
#undef PIN8
    float s1 = 0.f;
#pragma unroll
    for (int r = 0; r < 16; ++r) s1 += (O0[r] + O1[r]) + (O2[r] + O3[r]);
    s1 += __shfl_xor(s1, 32);
    const float mean = s1 * (1.0f / 128.0f);
    float s2 = 0.f;
#pragma unroll
    for (int r = 0; r < 16; ++r) { const float a = O0[r] - mean, bq = O1[r] - mean, cq = O2[r] - mean, dq = O3[r] - mean; s2 += (a * a + bq * bq) + (cq * cq + dq * dq); }
    s2 += __shfl_xor(s2, 32);
    const float rstd = 1.0f / sqrtf(s2 * (1.0f / 128.0f) + EPS);
    const float* gn = p.ret_gn_g + (size_t)layer * 1024 + h * 128 + 4 * hh;
    const size_t grow = tok0 + ql;
    const bf16_t* zp = PROJ + grow * NP + COL_RZ + h * 128 + 4 * hh;
    bf16_t* yp = Y + grow * 3072 + h * 128 + 4 * hh;
    u32x2 zz[16];
#pragma unroll
    for (int i = 0; i < 16; ++i) zz[i] = *(const u32x2*)(zp + 32 * (i >> 2) + 8 * (i & 3));
    f32x4 gg[8];
#pragma unroll
    for (int i = 0; i < 8; ++i) gg[i] = *(const f32x4*)(gn + 32 * (i >> 2) + 8 * (i & 3));
    asm volatile("" : "+v"(zz[0]), "+v"(zz[1]), "+v"(zz[2]), "+v"(zz[3]), "+v"(zz[4]), "+v"(zz[5]), "+v"(zz[6]), "+v"(zz[7]));
    asm volatile("" : "+v"(zz[8]), "+v"(zz[9]), "+v"(zz[10]), "+v"(zz[11]), "+v"(zz[12]), "+v"(zz[13]), "+v"(zz[14]), "+v"(zz[15]));
    asm volatile("" : "+v"(gg[0]), "+v"(gg[1]), "+v"(gg[2]), "+v"(gg[3]), "+v"(gg[4]), "+v"(gg[5]), "+v"(gg[6]), "+v"(gg[7]));
#define RET_ST(OX, db, GG) do { _Pragma("unroll") for (int g = 0; g < 4; ++g) { const u32x2 z = zz[4 * (db) + g]; const f32x4 gq_ = GG[4 * ((db) & 1) + g]; u32x2 o; \
        o.x = pk2((OX[4 * g + 0] - mean) * rstd * gq_.x * bflo(z.x), (OX[4 * g + 1] - mean) * rstd * gq_.y * bfhi(z.x)); \
        o.y = pk2((OX[4 * g + 2] - mean) * rstd * gq_.z * bflo(z.y), (OX[4 * g + 3] - mean) * rstd * gq_.w * bfhi(z.y)); \
        *(u32x2*)(yp + 32 * (db) + 8 * g) = o; } } while (0)
    RET_ST(O0, 0, gg); RET_ST(O1, 1, gg);
#pragma unroll
    for (int i = 0; i < 8; ++i) gg[i] = *(const f32x4*)(gn + 64 + 32 * (i >> 2) + 8 * (i & 3));
    asm volatile("" : "+v"(gg[0]), "+v"(gg[1]), "+v"(gg[2]), "+v"(gg[3]), "+v"(gg[4]), "+v"(gg[5]), "+v"(gg[6]), "+v"(gg[7]));
    RET_ST(O2, 2, gg); RET_ST(O3, 3, gg);
#undef RET_ST
}

__device__ __forceinline__ void phase_c2(LAS unsigned char* lds, int layer) {
#if PHC2 & 1
    { const Params p = loadp(); int G, bx, vcu; geom(G, bx, vcu);
      for (int it = vcu; it < 256; it += G) { const int bh = it >> 2, i = it & 3; for (int k2 = 0; k2 < 2; ++k2) attn_block(p, lds, bh, k2 ? i : 7 - i); } }
#endif
#if PHC2 & 2
    { const Params p = loadp(); int G, bx, vcu; geom(G, bx, vcu); const int ly = launder_s(layer);
      const int wave = __builtin_amdgcn_readfirstlane(tid_l() >> 6);
      for (int it = vcu; it < 512; it += G) ret_out_unit(p, ly, 2 * it + (wave >> 2), wave & 3); }
#endif
    __syncthreads();
#if PHC2 & 4
    { const Params p = loadp(); int G, bx, vcu; geom(G, bx, vcu); const int ly = launder_s(layer);
      SchedPool S{(const bf16_t*)(p.ws + WS_POOLED), (const bf16_t*)(p.ws + WS_WPOOL), G, bx};
      EpiPool E{(const bf16_t*)(p.ws + WS_PROJ), (bf16_t*)(p.ws + WS_Y), p.pool_scale + (size_t)ly * 1024};
      pg8::gemm_phase<EpiPool, SchedPool>(lds, launder_s(256), 1024, 256, S, E); }
#endif
}

__device__ __forceinline__ void phase_final() {
    const Params p = loadp(); int G, bx, vcu; geom(G, bx, vcu);
    const int tid = tid_l(), lane = tid & 63, wave = tid >> 6;
    const int gw = vcu * NWAVES + wave, NGW = G * NWAVES;
    f32x4 gfin[8];
#pragma unroll
    for (int j = 0; j < 8; ++j) gfin[j] = *((const f32x4*)p.final_g + lane + 64 * j);
    f32x4 vn[8];
    if (gw < M) {
#pragma unroll
        for (int j = 0; j < 8; ++j) vn[j] = *((const f32x4*)(p.out + (size_t)gw * DM) + lane + 64 * j);
    }
    for (int m = gw; m < M; m += NGW) {
        f32x4* xr = (f32x4*)(p.out + (size_t)m * DM) + lane;
        f32x4 v[8]; float ss = 0.f;
#pragma unroll
        for (int j = 0; j < 8; ++j) { v[j] = vn[j]; ss += (v[j].x * v[j].x + v[j].y * v[j].y) + (v[j].z * v[j].z + v[j].w * v[j].w); }
        if (m + NGW < M) {
#pragma unroll
            for (int j = 0; j < 8; ++j) vn[j] = *((const f32x4*)(p.out + (size_t)(m + NGW) * DM) + lane + 64 * j);
        }
        const float rstd = 1.0f / sqrtf(wave_sum(ss) * (1.0f / DM) + EPS);
#pragma unroll
        for (int j = 0; j < 8; ++j) xr[64 * j] = v[j] * rstd * gfin[j];
    }
}

__global__ void __launch_bounds__(NTHREADS, 2) hybrid_fwd(Params p_unused) {
    extern __shared__ __attribute__((aligned(16))) unsigned char lds_raw[];
    LAS unsigned char* lds = (LAS unsigned char*)lds_raw;
    cg::grid_group grid = cg::this_grid();
    if (gridDim.y == 0x7fffffffu) grid.sync();
    if (threadIdx.x < 16) ((volatile LAS unsigned*)(lds + LDS_BARST))[threadIdx.x] = 0u;
    __syncthreads();
    (void)xcd_barrier_post((unsigned*)(loadp().ws + WS_BAR), (volatile LAS unsigned*)(lds + LDS_BARST));
#define GSYNC() do { XcdBarrier b_; b_.bar = (unsigned*)(loadp().ws + WS_BAR); b_.x = xb_xcc_id(); b_.st = (volatile LAS unsigned*)(lds + LDS_BARST); xcd_barrier(b_); } while (0)
#pragma unroll 1
    for (int layer = 0; layer < DEPTH; ++layer) {
#if PHM & 1
        phase_a(lds, layer);
#if REPM & 1
        GSYNC(); phase_a(lds, layer);
#endif
#endif
        GSYNC();
#if PHM & 2
        {
            const Params p = loadp(); int G, bx, vcu; geom(G, bx, vcu);
            SchedProj S{(const bf16_t*)(p.ws + WS_H), (const bf16_t*)(p.ws + WS_WIN), DM, DM, 64, 64, G, bx};
            EpiProj E{(bf16_t*)(p.ws + WS_PROJ), (const float*)(p.ws + WS_ROPE)};
            pg8::gemm_phase<EpiProj, SchedProj>(lds, DM, DM, DM, S, E);
        }
#endif
        GSYNC();
#if PHM & 4
        phase_c1(lds, layer);
#if REPM & 4
        GSYNC(); phase_c1(lds, layer);
#endif
#endif
        GSYNC();
#if PHM & 8
        phase_c1b();
#endif
        GSYNC();
#if PHM & 16
        phase_c2(lds, layer);
#if REPM & 16
        GSYNC(); phase_c2(lds, layer);
#endif
#endif
        GSYNC();
#if PHM & 32
        {
            const Params p = loadp(); int G, bx, vcu; geom(G, bx, vcu);
            SchedMerge S{(const bf16_t*)(p.ws + WS_Y), (const bf16_t*)(p.ws + WS_WBR), G, bx};
            EpiMerge E{(const bf16_t*)(p.ws + WS_PROJ), (bf16_t*)(p.ws + WS_H)};
            pg8::gemm_phase<EpiMerge, SchedMerge>(lds, 1024, 3072, 1024, S, E);
        }
#endif
        GSYNC();
#if PHM & 64
        {
            const Params p = loadp(); int G, bx, vcu; geom(G, bx, vcu); const int ly = launder_s(layer);
            SchedPlain S{(const bf16_t*)(p.ws + WS_H), (const bf16_t*)(p.ws + WS_WOUT), DM, DM, 64, 8, G, bx};
            EpiOut E{sel_ptr(p.x, p.out, ly), p.out};
            pg8::gemm_phase<EpiOut, SchedPlain>(lds, DM, DM, DM, S, E);
        }
#endif
        GSYNC();
    }
#if PHM & 128
    phase_final();
#endif
}

extern "C" void kernel_launch(void* const* d_in, const int* in_sizes, int n_in, void* d_out, int out_size, void* d_ws, size_t ws_size, hipStream_t stream) {
    static int grid_blocks = 0;
    if (!grid_blocks) {
        int dev = 0, cus = 0, per_cu = 0;
        hipGetDevice(&dev);
        hipDeviceGetAttribute(&cus, hipDeviceAttributeMultiprocessorCount, dev);
        hipFuncSetAttribute((const void*)hybrid_fwd, hipFuncAttributeMaxDynamicSharedMemorySize, LDS_BYTES);
        hipOccupancyMaxActiveBlocksPerMultiprocessor(&per_cu, (const void*)hybrid_fwd, NTHREADS, LDS_BYTES);
        if (per_cu < 1) per_cu = 1;
        grid_blocks = cus * 1;
        if (ws_size < WS_END) fprintf(stderr, "kernel_launch: workspace too small: %zu < %zu\n", ws_size, (size_t)WS_END);
    }
    Params p{};
    p.x = (const float*)d_in[0]; p.norm_g = (const float*)d_in[1]; p.w_in = (const float*)d_in[2]; p.ret_gn_g = (const float*)d_in[3]; p.fox_b_f = (const float*)d_in[4];
    p.pool_w = (const float*)d_in[5]; p.pool_scale = (const float*)d_in[6]; p.w_ret = (const float*)d_in[7]; p.w_fox = (const float*)d_in[8]; p.w_pool = (const float*)d_in[9];
    p.w_out = (const float*)d_in[10]; p.final_g = (const float*)d_in[11];
    p.out = (float*)d_out; p.ws = (unsigned char*)d_ws;
    (void)hipMemsetAsync((char*)d_ws + WS_BAR, 0, XCD_BAR_WORDS * sizeof(unsigned), stream);
    void* args[] = {&p};
    hipError_t e = hipLaunchCooperativeKernel((const void*)hybrid_fwd, dim3(grid_blocks), dim3(NTHREADS), args, LDS_BYTES, stream);
    if (e != hipSuccess) fprintf(stderr, "cooperative launch failed: %s (grid %d)\n", hipGetErrorString(e), grid_blocks);
}
```

```cpp
#include <hip/hip_runtime.h>
#include <hip/hip_cooperative_groups.h>
#include <cstdio>
#include <cstdint>
namespace cg = cooperative_groups;
#ifndef PHM
#define PHM 255
#endif
#ifndef PHC2
#define PHC2 7
#endif
#ifndef REPM
#define REPM 0
#endif

#define LAS __attribute__((address_space(3)))
typedef unsigned short bf16_t;
typedef short bf16x8 __attribute__((ext_vector_type(8)));
typedef float f32x4 __attribute__((ext_vector_type(4)));
typedef float f32x16 __attribute__((ext_vector_type(16)));
typedef unsigned u32x4 __attribute__((ext_vector_type(4)));
typedef unsigned u32x2 __attribute__((ext_vector_type(2)));

constexpr int BATCH = 8, SEQ = 2048, DM = 2048, M = BATCH * SEQ, NH = 8, CIN = 16392, NP = 16384, DEPTH = 2;
constexpr int COL_RQ = 0, COL_RK = 1024, COL_RV = 2048, COL_RZ = 3072, COL_FQ = 4096, COL_FK = 5120, COL_FV = 6144, COL_FZ = 7168,
              COL_PU = 8192, COL_PZ = 9216, COL_GA = 10240, COL_GB = 12288, COL_GC = 14336;
constexpr float EPS = 1e-6f, LOG2E = 1.4426950408889634f;
constexpr int NWAVES = 8, NTHREADS = 512;
constexpr int LDS_BYTES = 147456;
constexpr int LDS_BARST = LDS_BYTES - 64;

constexpr size_t MiB = 1u << 20;
constexpr size_t WS_LSIG = 0;
constexpr size_t WS_CUM = MiB / 2;
constexpr size_t WS_ROPE = 1 * MiB;
constexpr size_t WS_WPOOL = 2 * MiB;
constexpr size_t WS_BAR = 3 * MiB;
constexpr size_t WS_WOUT = 4 * MiB;
constexpr size_t WS_WBR = 12 * MiB;
constexpr size_t WS_WIN = 24 * MiB;
constexpr size_t WS_H = 88 * MiB;
constexpr size_t WS_PROJ = 152 * MiB;
constexpr size_t WS_Y = 664 * MiB;
constexpr size_t WS_STATE = 760 * MiB;
constexpr size_t WS_STATEC = 824 * MiB;
constexpr size_t WS_POOLED = 856 * MiB;
constexpr size_t WS_VTF = 888 * MiB;
constexpr size_t WS_VTR = 920 * MiB;
constexpr size_t WS_END = 952 * MiB;

__device__ __forceinline__ unsigned f2bf(float f) { unsigned u = __builtin_bit_cast(unsigned, f); return (u + 0x7fffu + ((u >> 16) & 1u)) >> 16; }
typedef float f32x2 __attribute__((ext_vector_type(2)));
typedef __bf16 hwbf16x2 __attribute__((ext_vector_type(2)));
__device__ __forceinline__ unsigned pk2(float lo, float hi) { const f32x2 v = {lo, hi}; const hwbf16x2 b = __builtin_convertvector(v, hwbf16x2); return __builtin_bit_cast(unsigned, b); }
__device__ __forceinline__ float bflo(unsigned w) { return __builtin_bit_cast(float, w << 16); }
__device__ __forceinline__ float bfhi(unsigned w) { return __builtin_bit_cast(float, w & 0xffff0000u); }
__device__ __forceinline__ float wave_sum(float v) {
#pragma unroll
    for (int o = 1; o < 64; o <<= 1) v += __shfl_xor(v, o);
    return v;
}
__device__ __forceinline__ float fast_sigmoid(float x) { return __builtin_amdgcn_rcpf(1.0f + __builtin_amdgcn_exp2f(-x * LOG2E)); }
__device__ __forceinline__ float fast_silu(float x) { return x * fast_sigmoid(x); }
#define LDS_WAIT() asm volatile("s_waitcnt lgkmcnt(0)" ::: "memory")
__device__ __forceinline__ int tid_l() { int t = threadIdx.x; asm volatile("" : "+v"(t)); return t; }

namespace pg8 {
constexpr int BM = 256, BK = 64, HALF = 128, HTB = HALF * BK * 2, STAGE_BYTES = 8 * HTB, NXCD = 8, WGM = 8;
__device__ __forceinline__ int lds_byte(int r, int c) { const int st = (r >> 4) * 2 + (c >> 5), rr = r & 15, cc = c & 31, ob = rr * 64 + cc * 2; return st * 1024 + (ob ^ (((ob >> 9) & 1) << 5)); }
__device__ __forceinline__ void stage_rc(int b, int& R, int& C) { const int st = b / 1024, sb = b % 1024, swz = sb ^ (((sb >> 9) & 1) << 5); R = (st >> 1) * 16 + swz / 64; C = (st & 1) * 32 + (swz % 64) / 2; }
__device__ __forceinline__ int perm32(int rho) { const int n = rho >> 4, i = rho & 15; return 8 * (i >> 2) + 4 * n + (i & 3); }

struct Unit { int pm, pn, aux; };

__device__ __forceinline__ void tile_of(int L, int nM, int nN, int& pm, int& pn) {
    const int nwg = nM * nN; int wgid = L;
    { const int q = nwg / NXCD, r = nwg % NXCD, xcd = wgid % NXCD, off = wgid / NXCD; wgid = (xcd < r ? xcd * (q + 1) : r * (q + 1) + (xcd - r) * q) + off; }
    const int nig = WGM * nN, gid = wgid / nig, fm = gid * WGM, gsz = (nM - fm) < WGM ? (nM - fm) : WGM;
    pm = fm + ((wgid % nig) % gsz); pn = (wgid % nig) / gsz;
}

template <class Epi, class Sched>
__device__ __forceinline__ void gemm_phase(LAS unsigned char* lds, const int K, const int lda, const int ldb, const Sched& S, const Epi& E) {
    const int tid = tid_l(), wid = __builtin_amdgcn_readfirstlane(tid >> 6), lane = tid & 63, wr = wid >> 2, wc = wid & 3, fr = lane & 15, fq = lane >> 4;
    const int nt = K / BK;
    unsigned voffA[2], voffB[2];
#pragma unroll
    for (int i = 0; i < 2; ++i) { int R, C; stage_rc(tid * 16 + i * 8192, R, C); const int Rb = Epi::PERM ? ((R & ~31) + perm32(R & 31)) : R;
        voffA[i] = (unsigned)(R * lda + C) * 2u; voffB[i] = (unsigned)(Rb * ldb + C) * 2u; }
    const size_t kstep = (size_t)(BK * 2);
    const size_t hstepA = (size_t)HALF * lda * 2, hstepB = (size_t)HALF * ldb * 2;
    const unsigned ldsw = (unsigned)wid * 1024u;
    const int aoff = lds_byte(wr * 64 + fr, fq * 8), boff = lds_byte(wc * 32 + fr, fq * 8);
#define PG8_SA(b, h) (((b) * 2 + (h)) * HTB)
#define PG8_SB(b, h) ((4 + (b) * 2 + (h)) * HTB)
#define PG8_STAGE(bufoff, gbase, voff) do { _Pragma("unroll") for (int _i = 0; _i < 2; ++_i) \
        __builtin_amdgcn_global_load_lds((const unsigned*)((const char*)(gbase) + (voff)[_i]), (LAS unsigned*)(lds + (bufoff) + ldsw + _i * 8192), 16, 0, 0); } while (0)
#define PG8_LDA(dst, b, h) do { _Pragma("unroll") for (int m = 0; m < 4; ++m) _Pragma("unroll") for (int k = 0; k < 2; ++k) dst[m][k] = *(const LAS bf16x8*)(lds + PG8_SA(b, h) + aoff + m * 2048 + k * 1024); } while (0)
#define PG8_LDB(dst, b, h) do { _Pragma("unroll") for (int n = 0; n < 2; ++n) _Pragma("unroll") for (int k = 0; k < 2; ++k) dst[n][k] = *(const LAS bf16x8*)(lds + PG8_SB(b, h) + boff + n * 2048 + k * 1024); } while (0)
#define PG8_MMA(ai, bj, At, Bt) do { __builtin_amdgcn_s_setprio(1); _Pragma("unroll") for (int m = 0; m < 4; ++m) _Pragma("unroll") for (int n = 0; n < 2; ++n) _Pragma("unroll") for (int k = 0; k < 2; ++k) \
        acc[ai][bj][m][n] = __builtin_amdgcn_mfma_f32_16x16x32_bf16(Bt[n][k], At[m][k], acc[ai][bj][m][n], 0, 0, 0); __builtin_amdgcn_s_setprio(0); } while (0)
#define PG8_WAIT_V(n) asm volatile("s_waitcnt vmcnt(" #n ")" ::: "memory")
#define PG8_WAIT_L(n) asm volatile("s_waitcnt lgkmcnt(" #n ")" ::: "memory")
#define PG8_BAR __builtin_amdgcn_s_barrier()
#define PG8_SCHED __builtin_amdgcn_sched_barrier(0)
    Unit cur, nxt; int ui = 0;
    if (!S.next(0, cur)) return;
    f32x4 acc[2][2][4][2];
#pragma unroll
    for (int a = 0; a < 2; ++a)
#pragma unroll
        for (int b = 0; b < 2; ++b)
#pragma unroll
            for (int m = 0; m < 4; ++m)
#pragma unroll
                for (int n = 0; n < 2; ++n) acc[a][b][m][n] = (f32x4){0.f, 0.f, 0.f, 0.f};
    bf16x8 At[4][2], B0[2][2], B1[2][2];
    const char* cA = S.a_ptr(cur); const char* cB = S.b_ptr(cur);
    PG8_STAGE(PG8_SB(0, 0), cB, voffB); PG8_STAGE(PG8_SB(0, 1), cB + hstepB, voffB); PG8_STAGE(PG8_SA(0, 0), cA, voffA); PG8_STAGE(PG8_SA(0, 1), cA + hstepA, voffA);
    if (wr == 1) PG8_BAR;
    PG8_WAIT_V(2); PG8_BAR;
    PG8_STAGE(PG8_SB(1, 0), cB + kstep, voffB); PG8_STAGE(PG8_SA(1, 0), cA + kstep, voffA); PG8_STAGE(PG8_SB(1, 1), cB + hstepB + kstep, voffB);
    PG8_WAIT_V(6); PG8_BAR;
    for (;;) {
        const bool has_next = S.next(ui + 1, nxt);
        const char* nA = has_next ? S.a_ptr(nxt) : cA; const char* nB = has_next ? S.b_ptr(nxt) : cB;
        for (int t = 0; t < nt; t += 2) {
            const bool last = (t == nt - 2);
            const char* a1 = cA + (size_t)(t + 1) * kstep;
            const char* a2 = last ? nA : cA + (size_t)(t + 2) * kstep; const char* b2 = last ? nB : cB + (size_t)(t + 2) * kstep;
            const char* a3 = a2 + kstep; const char* b3 = b2 + kstep;
            PG8_LDB(B0, 0, 0); PG8_LDB(B1, 0, 1); PG8_SCHED; PG8_LDA(At, 0, 0); PG8_STAGE(PG8_SA(1, 1), a1 + hstepA, voffA);
            PG8_WAIT_V(8); PG8_WAIT_L(0); PG8_BAR; PG8_MMA(0, 0, At, B0); PG8_MMA(0, 1, At, B1); PG8_BAR; PG8_SCHED;
            PG8_LDA(At, 0, 1); PG8_STAGE(PG8_SB(0, 0), b2, voffB); PG8_STAGE(PG8_SB(0, 1), b2 + hstepB, voffB); PG8_STAGE(PG8_SA(0, 0), a2, voffA);
            PG8_WAIT_V(8); PG8_WAIT_L(0); PG8_BAR; PG8_MMA(1, 0, At, B0); PG8_MMA(1, 1, At, B1); PG8_BAR; PG8_SCHED;
            PG8_LDB(B0, 1, 0); PG8_LDB(B1, 1, 1); PG8_SCHED; PG8_LDA(At, 1, 0); PG8_STAGE(PG8_SA(0, 1), a2 + hstepA, voffA);
            PG8_WAIT_V(8); PG8_WAIT_L(0); PG8_BAR; PG8_MMA(0, 0, At, B0); PG8_MMA(0, 1, At, B1); PG8_BAR; PG8_SCHED;
            PG8_LDA(At, 1, 1); PG8_STAGE(PG8_SB(1, 0), b3, voffB); PG8_STAGE(PG8_SB(1, 1), b3 + hstepB, voffB); PG8_STAGE(PG8_SA(1, 0), a3, voffA);
            PG8_WAIT_V(8); PG8_WAIT_L(0); PG8_BAR; PG8_MMA(1, 0, At, B0); PG8_MMA(1, 1, At, B1); PG8_BAR; PG8_SCHED;
        }
        if (wr == 0) PG8_BAR;
        const bool zero = E(acc, cur, wr, wc, fr, fq);
        if (!has_next) break;
        if (zero) {
#pragma unroll
            for (int a = 0; a < 2; ++a)
#pragma unroll
                for (int b = 0; b < 2; ++b)
#pragma unroll
                    for (int m = 0; m < 4; ++m)
#pragma unroll
                        for (int n = 0; n < 2; ++n) acc[a][b][m][n] = (f32x4){0.f, 0.f, 0.f, 0.f};
        }
        cur = nxt; cA = nA; cB = nB; ++ui;
        if (wr == 1) PG8_BAR;
    }
    PG8_WAIT_V(0);
    PG8_BAR;
#undef PG8_SA
#undef PG8_SB
#undef PG8_STAGE
#undef PG8_LDA
#undef PG8_LDB
#undef PG8_MMA
#undef PG8_WAIT_V
#undef PG8_WAIT_L
#undef PG8_BAR
#undef PG8_SCHED
}
}
using pg8::Unit;

struct SchedPlain {
    const bf16_t* A; const bf16_t* Bt; int lda, ldb, nM, nN, G, c;
    __device__ __forceinline__ bool next(int i, Unit& u) const { const int L = i * G + c; if (L >= nM * nN) return false; pg8::tile_of(L, nM, nN, u.pm, u.pn); u.aux = 0; return true; }
    __device__ __forceinline__ const char* a_ptr(const Unit& u) const { return (const char*)(A + (size_t)u.pm * 256 * lda); }
    __device__ __forceinline__ const char* b_ptr(const Unit& u) const { return (const char*)(Bt + (size_t)u.pn * 256 * ldb); }
};
struct SchedProj {
    const bf16_t* A; const bf16_t* Bt; int lda, ldb, nM, nN, G, c;
    __device__ __forceinline__ bool next(int i, Unit& u) const {
        if (G != 256) { const int L = i * G + c; if (L >= nM * nN) return false; pg8::tile_of(L, nM, nN, u.pm, u.pn); u.aux = 0; return true; }
        if (i >= 16) return false;
        const int x = c & 7; u.pm = 8 * x + ((c >> 3) & 7); u.pn = 4 * ((i + 2 * x) & 15) + (c >> 6); u.aux = 0; return true; }
    __device__ __forceinline__ const char* a_ptr(const Unit& u) const { return (const char*)(A + (size_t)u.pm * 256 * lda); }
    __device__ __forceinline__ const char* b_ptr(const Unit& u) const { return (const char*)(Bt + (size_t)u.pn * 256 * ldb); }
};
struct SchedMerge {
    const bf16_t* Y; const bf16_t* W; int G, c;
    __device__ __forceinline__ bool next(int i, Unit& u) const { const int j = i / 3, br = i - 3 * j; const int L = j * G + c; if (L >= 512) return false; pg8::tile_of(L, 64, 8, u.pm, u.pn); u.aux = br; return true; }
    __device__ __forceinline__ const char* a_ptr(const Unit& u) const { return (const char*)(Y + (size_t)u.pm * 256 * 3072 + u.aux * 1024); }
    __device__ __forceinline__ const char* b_ptr(const Unit& u) const { return (const char*)(W + (size_t)u.aux * 2048 * 1024 + (size_t)u.pn * 256 * 1024); }
};
struct SchedPool {
    const bf16_t* P; const bf16_t* W; int G, c;
    __device__ __forceinline__ bool next(int i, Unit& u) const { const int L = i * G + c; if (L >= 256) return false; u.pm = L >> 2; u.pn = L & 3; u.aux = 0; return true; }
    __device__ __forceinline__ const char* a_ptr(const Unit& u) const { return (const char*)(P + (size_t)u.pm * 256 * 1024 + u.pn * 256); }
    __device__ __forceinline__ const char* b_ptr(const Unit& u) const { return (const char*)(W + (size_t)u.pn * 65536); }
};

struct EpiProj {
    static constexpr bool PERM = true;
    bf16_t* P; const float* rope;
    __device__ __forceinline__ bool operator()(f32x4 (&acc)[2][2][4][2], const Unit& u, int wr, int wc, int fr, int fq) const {
        asm volatile("" : "+v"(fr), "+v"(fq));
        const int row0 = u.pm * 256 + wr * 64 + fr, col0 = u.pn * 256 + wc * 32 + 8 * fq;
        const int pn = u.pn;
        int mode;
        if (pn < 4) mode = 3; else if (pn < 8) mode = 4; else if (pn < 16) mode = 0; else if (pn < 20) mode = 5; else if (pn < 40) mode = 0; else mode = 2;
        const int j0 = wc * 16 + 4 * fq;
#pragma unroll
        for (int ai = 0; ai < 2; ++ai) {
            f32x4 csa[4], csb[4];
#pragma unroll
            for (int m = 0; m < 4; ++m) { csa[m] = (f32x4){1.f, 0.f, 1.f, 0.f}; csb[m] = csa[m]; }
            if (mode == 3 || mode == 4) {
#pragma unroll
                for (int m = 0; m < 4; ++m) { const float* tp = rope + ((size_t)((row0 + ai * 128 + m * 16) & (SEQ - 1)) * 64 + j0) * 2; csa[m] = *(const f32x4*)tp; csb[m] = *(const f32x4*)(tp + 4); }
                asm volatile("" : "+v"(csa[0]), "+v"(csa[1]), "+v"(csa[2]), "+v"(csa[3]), "+v"(csb[0]), "+v"(csb[1]), "+v"(csb[2]), "+v"(csb[3]));
            }
#pragma unroll
            for (int m = 0; m < 4; ++m) {
                const int row = row0 + ai * 128 + m * 16;
                bf16_t* rowp = P + (size_t)row * NP + col0;
                const f32x4 cs0 = csa[m], cs1 = csb[m];
#pragma unroll
                for (int bj = 0; bj < 2; ++bj) {
                    f32x4 v0 = acc[ai][bj][m][0], v1 = acc[ai][bj][m][1];
                    if (mode == 1) {
#pragma unroll
                        for (int j = 0; j < 4; ++j) { v0[j] = fast_silu(v0[j]); v1[j] = fast_silu(v1[j]); }
                    } else if (mode == 2) {
#pragma unroll
                        for (int j = 0; j < 4; ++j) { v0[j] = __builtin_amdgcn_exp2f(fminf(fmaxf(v0[j], -60.f), 60.f) * -LOG2E); v1[j] = __builtin_amdgcn_exp2f(fminf(fmaxf(v1[j], -60.f), 60.f) * -LOG2E); }
                    } else if (mode == 3 || mode == 4) {
                        const float sc = (mode == 4) ? 0.08838834764831845f : 1.0f;
                        f32x4 o0, o1;
                        o0[0] = (v0[0] * cs0[0] - v0[1] * cs0[1]) * sc; o0[1] = (v0[0] * cs0[1] + v0[1] * cs0[0]) * sc;
                        o0[2] = (v0[2] * cs0[2] - v0[3] * cs0[3]) * sc; o0[3] = (v0[2] * cs0[3] + v0[3] * cs0[2]) * sc;
                        o1[0] = (v1[0] * cs1[0] - v1[1] * cs1[1]) * sc; o1[1] = (v1[0] * cs1[1] + v1[1] * cs1[0]) * sc;
                        o1[2] = (v1[2] * cs1[2] - v1[3] * cs1[3]) * sc; o1[3] = (v1[2] * cs1[3] + v1[3] * cs1[2]) * sc;
                        v0 = o0; v1 = o1;
                    } else if (mode == 5) { v0 = v0 * (0.08838834764831845f * LOG2E); v1 = v1 * (0.08838834764831845f * LOG2E); }
                    u32x4 w; w.x = pk2(v0[0], v0[1]); w.y = pk2(v0[2], v0[3]); w.z = pk2(v1[0], v1[1]); w.w = pk2(v1[2], v1[3]);
                    *(u32x4*)(rowp + bj * 128) = w;
                }
            }
        }
        return true;
    }
};
struct EpiPool {
    static constexpr bool PERM = true;
    const bf16_t* P; bf16_t* Y; const float* scale;
    __device__ __forceinline__ bool operator()(f32x4 (&acc)[2][2][4][2], const Unit& u, int wr, int wc, int fr, int fq) const {
        asm volatile("" : "+v"(fr), "+v"(fq));
        const int row0 = u.pm * 256 + wr * 64 + fr, col0 = u.pn * 256 + wc * 32 + 8 * fq;
        f32x4 sc[2][2];
#pragma unroll
        for (int bj = 0; bj < 2; ++bj) { sc[bj][0] = *(const f32x4*)(scale + col0 + bj * 128); sc[bj][1] = *(const f32x4*)(scale + col0 + bj * 128 + 4); }
#pragma unroll
        for (int ai = 0; ai < 2; ++ai) {
            u32x4 z[4][2];
#pragma unroll
            for (int m = 0; m < 4; ++m)
#pragma unroll
                for (int bj = 0; bj < 2; ++bj) z[m][bj] = *(const u32x4*)((const char*)P + (unsigned)(((row0 + ai * 128 + m * 16) * NP + COL_PZ + col0 + bj * 128) * 2));
            asm volatile("" : "+v"(z[0][0]), "+v"(z[0][1]), "+v"(z[1][0]), "+v"(z[1][1]), "+v"(z[2][0]), "+v"(z[2][1]), "+v"(z[3][0]), "+v"(z[3][1]));
#pragma unroll
            for (int m = 0; m < 4; ++m)
#pragma unroll
                for (int bj = 0; bj < 2; ++bj) {
                    const u32x4 zz = z[m][bj];
                    const f32x4 v0 = acc[ai][bj][m][0] * sc[bj][0], v1 = acc[ai][bj][m][1] * sc[bj][1];
                    u32x4 w; w.x = pk2(v0[0] * fast_silu(bflo(zz.x)), v0[1] * fast_silu(bfhi(zz.x))); w.y = pk2(v0[2] * fast_silu(bflo(zz.y)), v0[3] * fast_silu(bfhi(zz.y)));
                    w.z = pk2(v1[0] * fast_silu(bflo(zz.z)), v1[1] * fast_silu(bfhi(zz.z))); w.w = pk2(v1[2] * fast_silu(bflo(zz.w)), v1[3] * fast_silu(bfhi(zz.w)));
                    *(u32x4*)((char*)Y + (unsigned)(((row0 + ai * 128 + m * 16) * 3072 + 2048 + col0 + bj * 128) * 2)) = w;
                }
        }
        return true;
    }
};
struct EpiMerge {
    static constexpr bool PERM = true;
    const bf16_t* P; bf16_t* O;
    __device__ __forceinline__ bool operator()(f32x4 (&acc)[2][2][4][2], const Unit& u, int wr, int wc, int fr, int fq) const {
        asm volatile("" : "+v"(fr), "+v"(fq));
        const int row0 = u.pm * 256 + wr * 64 + fr, col0 = u.pn * 256 + wc * 32 + 8 * fq;
        const int br = u.aux;
        const int cnum = (br == 0) ? COL_GA : (br == 1) ? COL_GB : COL_GC;
        const int cden = (br == 0) ? COL_GB : COL_GC;
#pragma unroll
        for (int ai = 0; ai < 2; ++ai)
#pragma unroll
            for (int mp = 0; mp < 2; ++mp) {
                u32x4 gn[2][2], gd[2][2];
#pragma unroll
                for (int mm = 0; mm < 2; ++mm)
#pragma unroll
                    for (int bj = 0; bj < 2; ++bj) { const bf16_t* prow = P + (size_t)(row0 + ai * 128 + (2 * mp + mm) * 16) * NP + col0 + bj * 128;
                        gn[mm][bj] = *(const u32x4*)(prow + cnum); gd[mm][bj] = *(const u32x4*)(prow + cden); }
                asm volatile("" : "+v"(gn[0][0]), "+v"(gn[0][1]), "+v"(gn[1][0]), "+v"(gn[1][1]), "+v"(gd[0][0]), "+v"(gd[0][1]), "+v"(gd[1][0]), "+v"(gd[1][1]));
#pragma unroll
                for (int mm = 0; mm < 2; ++mm)
#pragma unroll
                    for (int bj = 0; bj < 2; ++bj) {
                        const int m = 2 * mp + mm; const u32x4 g = gn[mm][bj], d = gd[mm][bj];
                        f32x4 f0 = (f32x4){bflo(g.x), bfhi(g.x), bflo(g.y), bfhi(g.y)}, f1 = (f32x4){bflo(g.z), bfhi(g.z), bflo(g.w), bfhi(g.w)};
#pragma unroll
                        for (int j = 0; j < 4; ++j) { f0[j] = __builtin_amdgcn_rcpf(1.0f + f0[j]); f1[j] = __builtin_amdgcn_rcpf(1.0f + f1[j]); }
                        if (br < 2) {
                            f0[0] *= 1.0f + bflo(d.x); f0[1] *= 1.0f + bfhi(d.x); f0[2] *= 1.0f + bflo(d.y); f0[3] *= 1.0f + bfhi(d.y);
                            f1[0] *= 1.0f + bflo(d.z); f1[1] *= 1.0f + bfhi(d.z); f1[2] *= 1.0f + bflo(d.w); f1[3] *= 1.0f + bfhi(d.w);
                        }
                        acc[ai][bj][m][0] = acc[ai][bj][m][0] * f0; acc[ai][bj][m][1] = acc[ai][bj][m][1] * f1;
                        if (br == 2) {
                            const f32x4 v0 = acc[ai][bj][m][0], v1 = acc[ai][bj][m][1];
                            u32x4 w; w.x = pk2(v0[0], v0[1]); w.y = pk2(v0[2], v0[3]); w.z = pk2(v1[0], v1[1]); w.w = pk2(v1[2], v1[3]);
                            *(u32x4*)(O + (size_t)(row0 + ai * 128 + m * 16) * DM + col0 + bj * 128) = w;
                        }
                    }
            }
        return br == 2;
    }
};
struct EpiOut {
    static constexpr bool PERM = false;
    const float* xin; float* xout;
    __device__ __forceinline__ bool operator()(f32x4 (&acc)[2][2][4][2], const Unit& u, int wr, int wc, int fr, int fq) const {
        asm volatile("" : "+v"(fr), "+v"(fq));
        const int row0 = u.pm * 256 + wr * 64 + fr, col0 = u.pn * 256 + wc * 32 + 4 * fq;
#pragma unroll
        for (int ai = 0; ai < 2; ++ai)
#pragma unroll
            for (int mp = 0; mp < 2; ++mp) {
                f32x4 xo[2][2][2];
#pragma unroll
                for (int mm = 0; mm < 2; ++mm)
#pragma unroll
                    for (int bj = 0; bj < 2; ++bj)
#pragma unroll
                        for (int n = 0; n < 2; ++n) xo[mm][bj][n] = *(const f32x4*)(xin + (size_t)(row0 + ai * 128 + (2 * mp + mm) * 16) * DM + col0 + bj * 128 + n * 16);
                asm volatile("" : "+v"(xo[0][0][0]), "+v"(xo[0][0][1]), "+v"(xo[0][1][0]), "+v"(xo[0][1][1]), "+v"(xo[1][0][0]), "+v"(xo[1][0][1]), "+v"(xo[1][1][0]), "+v"(xo[1][1][1]));
#pragma unroll
                for (int mm = 0; mm < 2; ++mm)
#pragma unroll
                    for (int bj = 0; bj < 2; ++bj)
#pragma unroll
                        for (int n = 0; n < 2; ++n) *(f32x4*)(xout + (size_t)(row0 + ai * 128 + (2 * mp + mm) * 16) * DM + col0 + bj * 128 + n * 16) = xo[mm][bj][n] + acc[ai][bj][2 * mp + mm][n];
            }
        return true;
    }
};

struct Params {
    const float* x; const float* norm_g; const float* w_in; const float* ret_gn_g; const float* fox_b_f; const float* pool_w; const float* pool_scale;
    const float* w_ret; const float* w_fox; const float* w_pool; const float* w_out; const float* final_g;
    float* out; unsigned char* ws;
};

#define XB_TMO      128
#define XB_XCNT(j)  (256  + 64 * (j))
#define XB_XSUB(j)  (1280 + 64 * (j))
#define XB_XGEN(j)  (2304 + 64 * (j))
#define XB_TOP      3328
#define XB_TOPGEN   3392
#define XCD_BAR_WORDS 3456
#define XB_SPIN_CAP (1u << 18)

__device__ __forceinline__ unsigned xb_ld(unsigned* p)              { return __hip_atomic_load(p, __ATOMIC_RELAXED, __HIP_MEMORY_SCOPE_AGENT); }
__device__ __forceinline__ unsigned xb_add(unsigned* p, unsigned v) { return __hip_atomic_fetch_add(p, v, __ATOMIC_RELAXED, __HIP_MEMORY_SCOPE_AGENT); }
__device__ __forceinline__ unsigned xb_xcc_id() { return (unsigned)__builtin_amdgcn_s_getreg((3 << 11) | 20) & 0xFu; }
#define XB_SPIN(cond, bar) do { unsigned _sp = 0; while (cond) { __builtin_amdgcn_s_sleep(1); \
    if ((++_sp & 255u) == 0u) { if (xb_ld(&(bar)[XB_TMO])) break; if (_sp > XB_SPIN_CAP) { atomicAdd(&(bar)[XB_TMO], 1u); break; } } } } while (0)

struct XcdBarrier {
    unsigned* bar; unsigned x;
    volatile LAS unsigned* st;
};

__device__ __forceinline__ XcdBarrier xcd_barrier_post(unsigned* bar, volatile LAS unsigned* st) {
    XcdBarrier b; b.bar = bar; b.x = xb_xcc_id(); b.st = st;
    if (threadIdx.x == 0) (void)xb_add(&bar[XB_XCNT(b.x)], 1u);
    return b;
}
__device__ __forceinline__ void xcd_barrier_complete(unsigned* bar, unsigned x, unsigned& nloc, unsigned& nx) {
    const unsigned G = gridDim.x * gridDim.y * gridDim.z;
    unsigned sum, cnt, mine, sp = 0u;
    for (;;) {
        sum = 0u; cnt = 0u; mine = 0u;
#pragma unroll
        for (unsigned j = 0; j < 16; ++j) { const unsigned c = xb_ld(&bar[XB_XCNT(j)]); sum += c; cnt += (c > 0u) ? 1u : 0u; mine = (j == x) ? c : mine; }
        if (sum == G) break;
        __builtin_amdgcn_s_sleep(1);
        if ((++sp & 255u) == 0u) { if (xb_ld(&bar[XB_TMO])) break; if (sp > XB_SPIN_CAP) { atomicAdd(&bar[XB_TMO], 1u); break; } }
    }
    nloc = mine > 0u ? mine : 1u; nx = cnt > 0u ? cnt : 1u;
}

__device__ __forceinline__ void xcd_barrier(const XcdBarrier& b) {
    asm volatile("s_waitcnt vmcnt(0)" ::: "memory");
    __syncthreads();
    if (threadIdx.x == 0) {
        unsigned* bar = b.bar;
        __builtin_amdgcn_s_waitcnt(0);
        unsigned nloc = b.st[0], nx = b.st[1];
        if (nloc == 0u) { xcd_barrier_complete(bar, b.x, nloc, nx); b.st[0] = nloc; b.st[1] = nx; }
        const unsigned old = xb_add(&bar[XB_XSUB(b.x)], 1u);
        const unsigned gen = old / nloc;
        if (old + 1u == (gen + 1u) * nloc) {
            __builtin_amdgcn_fence(__ATOMIC_RELEASE, "agent");
            asm volatile("s_waitcnt vmcnt(0)" ::: "memory");
            const unsigned og = xb_add(&bar[XB_TOP], 1u);
            const unsigned tg = og / nx;
            if (og + 1u == (tg + 1u) * nx) xb_add(&bar[XB_TOPGEN], 1u);
            else XB_SPIN(xb_ld(&bar[XB_TOPGEN]) == tg, bar);
            __builtin_amdgcn_fence(__ATOMIC_ACQUIRE, "agent");
            xb_add(&bar[XB_XGEN(b.x)], 1u);
            asm volatile("s_waitcnt vmcnt(0)" ::: "memory");
        } else {
            XB_SPIN(xb_ld(&bar[XB_XGEN(b.x)]) == gen, bar);
            __builtin_amdgcn_fence(__ATOMIC_ACQUIRE, "agent");
            asm volatile("s_waitcnt vmcnt(0)" ::: "memory");
        }
    }
    __syncthreads();
}


typedef const Params __attribute__((address_space(4))) CParams;
__device__ __forceinline__ Params loadp() {
    const CParams* pp = (const CParams*)__builtin_amdgcn_kernarg_segment_ptr();
    asm volatile("" : "+s"(pp));
    Params p;
    p.x = pp->x; p.norm_g = pp->norm_g; p.w_in = pp->w_in; p.ret_gn_g = pp->ret_gn_g; p.fox_b_f = pp->fox_b_f; p.pool_w = pp->pool_w; p.pool_scale = pp->pool_scale;
    p.w_ret = pp->w_ret; p.w_fox = pp->w_fox; p.w_pool = pp->w_pool; p.w_out = pp->w_out; p.final_g = pp->final_g; p.out = pp->out; p.ws = pp->ws;
    return p;
}
__device__ __forceinline__ int launder_s(int v) { asm volatile("" : "+s"(v)); return v; }
__device__ __forceinline__ void geom(int& G, int& bx, int& vcu) { G = launder_s((int)gridDim.x); bx = launder_s((int)blockIdx.x); vcu = (G % 8 == 0) ? (bx % 8) * (G / 8) + bx / 8 : bx; }
__device__ __forceinline__ const float* sel_ptr(const float* a, const float* b, int useb) { const uintptr_t m = (uintptr_t)0 - (uintptr_t)(useb != 0); return (const float*)(((uintptr_t)a & ~m) | ((uintptr_t)b & m)); }

__device__ __forceinline__ int win_dest(int n) {
    if (n < 2048) { const int head = n >> 7, w = n & 127; return head * 128 + 2 * (w & 63) + (w >> 6); }
    if (n < 8192) return n;
    if (n < 8200) return -1;
    return n - 8;
}
struct TrItem { const float* W; bf16_t* WT; int ldw, ncols, K, item; bool winmap; };
__device__ __forceinline__ void tr_load(const TrItem& t, f32x4 (&ld)[8], int lane) {
    const int nblk = (t.ncols + 31) >> 5, kb = t.item / nblk, nb = t.item - kb * nblk, k0 = 64 * kb, n0 = 32 * nb;
    const int c4 = lane & 7, kr = lane >> 3; const bool okc = (n0 + 4 * c4) < t.ncols;
#pragma unroll
    for (int i = 0; i < 8; ++i) ld[i] = okc ? *(const f32x4*)(t.W + (size_t)(k0 + 8 * i + kr) * t.ldw + n0 + 4 * c4) : (f32x4){0.f, 0.f, 0.f, 0.f};
}
__device__ __forceinline__ void tr_finish(const TrItem& t, const f32x4 (&ld)[8], LAS float* scr, int lane) {
    const int nblk = (t.ncols + 31) >> 5, kb = t.item / nblk, nb = t.item - kb * nblk, k0 = 64 * kb, n0 = 32 * nb;
    const int c4 = lane & 7, kr = lane >> 3;
#pragma unroll
    for (int i = 0; i < 8; ++i) { LAS float* d = scr + (8 * i + kr) * 33 + 4 * c4; d[0] = ld[i].x; d[1] = ld[i].y; d[2] = ld[i].z; d[3] = ld[i].w; }
    LDS_WAIT(); asm volatile("" ::: "memory");
    const int c = lane & 7;
#pragma unroll
    for (int j = 0; j < 4; ++j) { const int n = (lane >> 3) + 8 * j; const int ns = n0 + n; const int dest = (ns < t.ncols) ? (t.winmap ? win_dest(ns) : ns) : -1;
        const LAS float* sp = scr + (8 * c) * 33 + n;
        u32x4 o; o.x = pk2(sp[0 * 33], sp[1 * 33]); o.y = pk2(sp[2 * 33], sp[3 * 33]); o.z = pk2(sp[4 * 33], sp[5 * 33]); o.w = pk2(sp[6 * 33], sp[7 * 33]);
        if (dest >= 0) *(u32x4*)(t.WT + (size_t)dest * t.K + k0 + 8 * c) = o; }
    LDS_WAIT(); asm volatile("" ::: "memory");
}

__device__ __forceinline__ void phase_a(LAS unsigned char* lds, int layer) {
    const Params p = loadp(); int G, bx, vcu; geom(G, bx, vcu); layer = launder_s(layer);
    const int tid = tid_l(), lane = tid & 63, wave = __builtin_amdgcn_readfirstlane(tid >> 6);
    unsigned char* ws = p.ws;
    const float* w_in = p.w_in + (size_t)layer * DM * CIN;
    LAS float* wff = (LAS float*)lds;
    for (int k = tid; k < DM; k += NTHREADS) {
        const float* src = w_in + (size_t)k * CIN + 8192;
        const f32x4 a = *(const f32x4*)src, b = *(const f32x4*)(src + 4);
        const int j = k >> 8, l = (k >> 2) & 63, i = k & 3;
        LAS float* d = wff + ((j * 4 + i) * 64 + l) * 8;
        *(LAS f32x4*)d = a; *(LAS f32x4*)(d + 4) = b;
    }
    __syncthreads();
    LAS float* scr = (LAS float*)(lds + 65536 + wave * 8448);
    const int gw = vcu * NWAVES + wave, NGW = G * NWAVES;
    constexpr int I_IN = 32 * 513, I_BR = 16 * 64, I_OUT = 32 * 64, I_PW = 4 * 8;
    constexpr int NITEMS = I_IN + 3 * I_BR + I_OUT + 4 * I_PW;
    auto decode = [&](int it) -> TrItem {
        TrItem t; int r = it; unsigned char* wsb = ws;
        if (r < I_IN) { t.W = w_in; t.WT = (bf16_t*)(wsb + WS_WIN); t.ldw = CIN; t.ncols = CIN; t.K = DM; t.item = r; t.winmap = true; return t; } r -= I_IN;
        t.winmap = false;
        if (r < 3 * I_BR) { const int q = r / I_BR; r -= q * I_BR; const float* wb = (q == 0) ? p.w_ret : (q == 1) ? p.w_fox : p.w_pool;
            t.W = wb + (size_t)layer * 1024 * DM; t.WT = (bf16_t*)(wsb + WS_WBR) + (size_t)q * 2048 * 1024; t.ldw = DM; t.ncols = DM; t.K = 1024; t.item = r; return t; } r -= 3 * I_BR;
        if (r < I_OUT) { t.W = p.w_out + (size_t)layer * DM * DM; t.WT = (bf16_t*)(wsb + WS_WOUT); t.ldw = DM; t.ncols = DM; t.K = DM; t.item = r; return t; } r -= I_OUT;
        { const int g = r / I_PW; t.W = p.pool_w + (size_t)layer * 4 * 65536 + (size_t)g * 65536; t.WT = (bf16_t*)(wsb + WS_WPOOL) + (size_t)g * 65536; t.ldw = 256; t.ncols = 256; t.K = 256; t.item = r - g * I_PW; return t; }
    };
    {
        int it = gw;
        if (it < NITEMS) {
            TrItem cur = decode(it); f32x4 lda[8], ldb[8];
            tr_load(cur, lda, lane);
            for (;;) {
                const int nit = it + NGW; const bool hn = nit < NITEMS;
                TrItem nxt = cur; if (hn) { nxt = decode(nit); tr_load(nxt, ldb, lane); }
                tr_finish(cur, lda, scr, lane);
                if (!hn) break;
#pragma unroll
                for (int i = 0; i < 8; ++i) lda[i] = ldb[i];
                cur = nxt; it = nit;
            }
        }
    }
    if (layer == 0) {
        float* rope = (float*)(ws + WS_ROPE);
        for (int idx = (vcu * NTHREADS + tid); idx < SEQ * 64; idx += G * NTHREADS) {
            const int pos = idx >> 6, j = idx & 63;
            const float inv = exp2f(-(float)j * (13.287712379549449f / 64.0f));
            const float ang = (float)pos * inv;
            double rev = (double)ang * 0.15915494309189535; rev -= floor(rev);
            const float rf = (float)rev;
            rope[2 * idx] = __builtin_amdgcn_cosf(rf); rope[2 * idx + 1] = __builtin_amdgcn_sinf(rf);
        }
    }
    const float* xin = sel_ptr(p.x, p.out, layer);
    const float* g = p.norm_g + (size_t)layer * DM;
    bf16_t* H = (bf16_t*)(ws + WS_H);
    float* lsig = (float*)(ws + WS_LSIG);
    const float* bf = p.fox_b_f + layer * 8;
    f32x4 gv[8];
#pragma unroll
    for (int j = 0; j < 8; ++j) gv[j] = *((const f32x4*)g + lane + 64 * j);
    f32x4 vn[8];
    if (gw < M) {
#pragma unroll
        for (int j = 0; j < 8; ++j) vn[j] = *((const f32x4*)(xin + (size_t)gw * DM) + lane + 64 * j);
    }
    for (int m = gw; m < M; m += NGW) {
        f32x4 v[8]; float ss = 0.f;
#pragma unroll
        for (int j = 0; j < 8; ++j) { v[j] = vn[j]; ss += (v[j].x * v[j].x + v[j].y * v[j].y) + (v[j].z * v[j].z + v[j].w * v[j].w); }
        if (m + NGW < M) {
#pragma unroll
            for (int j = 0; j < 8; ++j) vn[j] = *((const f32x4*)(xin + (size_t)(m + NGW) * DM) + lane + 64 * j);
        }
        const float rstd = 1.0f / sqrtf(wave_sum(ss) * (1.0f / DM) + EPS);
        float fa[8];
#pragma unroll
        for (int o = 0; o < 8; ++o) fa[o] = 0.f;
        u32x2* o8 = (u32x2*)(H + (size_t)m * DM) + lane;
#pragma unroll
        for (int j = 0; j < 8; ++j) {
            const f32x4 hv = v[j] * rstd * gv[j];
            u32x2 w; w.x = pk2(hv.x, hv.y); w.y = pk2(hv.z, hv.w); o8[64 * j] = w;
#pragma unroll
            for (int i = 0; i < 4; ++i) {
                const LAS float* wp = wff + ((j * 4 + i) * 64 + lane) * 8;
                const f32x4 wa = *(const LAS f32x4*)wp, wb = *(const LAS f32x4*)(wp + 4);
                const float hh = hv[i];
                fa[0] += hh * wa.x; fa[1] += hh * wa.y; fa[2] += hh * wa.z; fa[3] += hh * wa.w;
                fa[4] += hh * wb.x; fa[5] += hh * wb.y; fa[6] += hh * wb.z; fa[7] += hh * wb.w;
            }
            asm volatile("" ::: "memory");
        }
        float mine = 0.f;
#pragma unroll
        for (int o = 0; o < 8; ++o) { const float t = wave_sum(fa[o]); mine = (lane == o) ? t : mine; }
        if (lane < 8) { const float xl = mine + bf[lane]; lsig[(size_t)m * 8 + lane] = fminf(xl, 0.f) - log1pf(__expf(-fabsf(xl))); }
    }
    __syncthreads();
}

__device__ __forceinline__ int swap23(int t) { return (t & ~12) | ((t & 4) << 1) | ((t & 8) >> 1); }
__device__ __forceinline__ int tswz(int row) { return ((row >> 3) ^ (row & 7)) & 15; }
__device__ __forceinline__ int timg(int row, int pos) { return row * 256 + ((((pos >> 3) ^ tswz(row)) << 4) | ((pos & 7) << 1)); }

template <bool RET>
__device__ __forceinline__ void c1_chunk_unit(const Params& p, LAS unsigned char* lds, int layer, int unit) {
    const int tid = tid_l(), lane = tid & 63, wave = __builtin_amdgcn_readfirstlane(tid >> 6);
    const int bh = unit >> 4, c = unit & 15, b = bh >> 3, h = bh & 7;
    const bf16_t* PROJ = (const bf16_t*)(p.ws + WS_PROJ);
    const size_t tok0 = (size_t)b * SEQ + c * 128;
    LAS unsigned char* VtL = lds; LAS unsigned char* KtL = lds + 32768;
    const float lg2 = log1pf(-exp2f(-5.0f - (float)h)) * LOG2E;
    {
        const int T = tid >> 4, ch = tid & 15, pos0 = swap23(4 * T);
        const bf16_t* src = PROJ + (tok0 + 4 * T) * NP + h * 128 + ch * 8;
        u32x4 vv[4], kv[4];
#pragma unroll
        for (int j = 0; j < 4; ++j) { vv[j] = *(const u32x4*)(src + (size_t)j * NP + (RET ? COL_RV : COL_FV)); if (RET) kv[j] = *(const u32x4*)(src + (size_t)j * NP + COL_RK); }
#pragma unroll
        for (int e = 0; e < 4; ++e) {
            const unsigned w0 = vv[0][e], w1 = vv[1][e], w2 = vv[2][e], w3 = vv[3][e];
            u32x2 lo, hi; lo.x = (w0 & 0xffffu) | (w1 << 16); lo.y = (w2 & 0xffffu) | (w3 << 16); hi.x = (w0 >> 16) | (w1 & 0xffff0000u); hi.y = (w2 >> 16) | (w3 & 0xffff0000u);
            *(LAS u32x2*)(VtL + timg(ch * 8 + 2 * e, pos0)) = lo;
            *(LAS u32x2*)(VtL + timg(ch * 8 + 2 * e + 1, pos0)) = hi;
        }
        if (RET) {
            float z[4];
#pragma unroll
            for (int j = 0; j < 4; ++j) z[j] = __builtin_amdgcn_exp2f(lg2 * (float)(127 - (4 * T + j)));
#pragma unroll
            for (int e = 0; e < 4; ++e) {
                const unsigned w0 = kv[0][e], w1 = kv[1][e], w2 = kv[2][e], w3 = kv[3][e];
                u32x2 lo, hi; lo.x = pk2(bflo(w0) * z[0], bflo(w1) * z[1]); lo.y = pk2(bflo(w2) * z[2], bflo(w3) * z[3]);
                hi.x = pk2(bfhi(w0) * z[0], bfhi(w1) * z[1]); hi.y = pk2(bfhi(w2) * z[2], bfhi(w3) * z[3]);
                *(LAS u32x2*)(KtL + timg(ch * 8 + 2 * e, pos0)) = lo;
                *(LAS u32x2*)(KtL + timg(ch * 8 + 2 * e + 1, pos0)) = hi;
            }
        }
    }
    __syncthreads();
    bf16_t* VT = (bf16_t*)(p.ws + (RET ? WS_VTR : WS_VTF));
#pragma unroll
    for (int i = 0; i < 4; ++i) {
        const int pc = tid + 512 * i, d = pc >> 4, ch = pc & 15;
        const u32x4 w = *(const LAS u32x4*)(VtL + d * 256 + ((ch ^ tswz(d)) << 4));
        *(u32x4*)(VT + ((size_t)bh * 128 + d) * SEQ + c * 128 + ch * 8) = w;
    }
    if (RET) {
        const int l31 = lane & 31, hh = lane >> 5;
        const int bv = wave >> 1, bk0 = 2 * (wave & 1);
        f32x16 a0 = {}, a1 = {};
        const int rv = 32 * bv + l31, rk0 = 32 * bk0 + l31, rk1 = rk0 + 32;
#pragma unroll
        for (int s = 0; s < 8; ++s) {
            const int chunk = 2 * s + hh;
            const bf16x8 A = *(const LAS bf16x8*)(VtL + rv * 256 + ((chunk ^ tswz(rv)) << 4));
            const bf16x8 B0 = *(const LAS bf16x8*)(KtL + rk0 * 256 + ((chunk ^ tswz(rk0)) << 4));
            const bf16x8 B1 = *(const LAS bf16x8*)(KtL + rk1 * 256 + ((chunk ^ tswz(rk1)) << 4));
            a0 = __builtin_amdgcn_mfma_f32_32x32x16_bf16(A, B0, a0, 0, 0, 0);
            a1 = __builtin_amdgcn_mfma_f32_32x32x16_bf16(A, B1, a1, 0, 0, 0);
        }
        float* ST = (float*)(p.ws + WS_STATE) + (size_t)unit * 16384;
#pragma unroll
        for (int r = 0; r < 16; ++r) {
            const int dv = 32 * bv + (r & 3) + 8 * (r >> 2) + 4 * hh;
            ST[dv * 128 + 32 * bk0 + l31] = a0[r];
            ST[dv * 128 + 32 * bk0 + 32 + l31] = a1[r];
        }
    }
    __syncthreads();
}

template <int W>
__device__ __forceinline__ void pooled_rows(const bf16_t* PROJ, bf16_t* PO, int r0, int col) {
    constexpr int NL = 8 + W - 1;
    const int t0 = r0 & (SEQ - 1);
    u32x4 L[NL];
#pragma unroll
    for (int j = 0; j < NL; ++j) { const int dt = j - (W - 1); L[j] = (t0 + dt >= 0) ? *(const u32x4*)(PROJ + (size_t)(r0 + dt) * NP + COL_PU + col) : (u32x4){0u, 0u, 0u, 0u}; }
    float s[8];
#pragma unroll
    for (int e = 0; e < 8; ++e) s[e] = 0.f;
#pragma unroll
    for (int j = 0; j < W - 1; ++j) { s[0] += bflo(L[j].x); s[1] += bfhi(L[j].x); s[2] += bflo(L[j].y); s[3] += bfhi(L[j].y); s[4] += bflo(L[j].z); s[5] += bfhi(L[j].z); s[6] += bflo(L[j].w); s[7] += bfhi(L[j].w); }
#pragma unroll
    for (int k = 0; k < 8; ++k) {
        const u32x4 nw = L[k + W - 1];
        s[0] += bflo(nw.x); s[1] += bfhi(nw.x); s[2] += bflo(nw.y); s[3] += bfhi(nw.y); s[4] += bflo(nw.z); s[5] += bfhi(nw.z); s[6] += bflo(nw.w); s[7] += bfhi(nw.w);
        const int n = (t0 + k + 1 < W) ? (t0 + k + 1) : W;
        const float inv = 1.0f / (float)n;
        u32x4 o;
        o.x = pk2(s[0] * inv - bflo(nw.x), s[1] * inv - bfhi(nw.x)); o.y = pk2(s[2] * inv - bflo(nw.y), s[3] * inv - bfhi(nw.y));
        o.z = pk2(s[4] * inv - bflo(nw.z), s[5] * inv - bfhi(nw.z)); o.w = pk2(s[6] * inv - bflo(nw.w), s[7] * inv - bfhi(nw.w));
        *(u32x4*)(PO + (size_t)(r0 + k) * 1024 + col) = o;
        const u32x4 od = L[k];
        s[0] -= bflo(od.x); s[1] -= bfhi(od.x); s[2] -= bflo(od.y); s[3] -= bfhi(od.y); s[4] -= bflo(od.z); s[5] -= bfhi(od.z); s[6] -= bflo(od.w); s[7] -= bfhi(od.w);
    }
}
__device__ __forceinline__ void c1_pooled_unit(const Params& p, int unit) {
    const int tid = tid_l(), lane = tid & 63, w8 = __builtin_amdgcn_readfirstlane(tid >> 6);
    const bf16_t* PROJ = (const bf16_t*)(p.ws + WS_PROJ);
    bf16_t* PO = (bf16_t*)(p.ws + WS_POOLED);
    const int g = w8 & 3, col = g * 256 + (lane & 31) * 8;
    const int strip = (w8 >> 2) * 2 + (lane >> 5);
#pragma unroll 1
    for (int pass = 0; pass < 2; ++pass) {
        const int r0 = unit * 64 + strip * 16 + pass * 8;
        if (g == 0) pooled_rows<2>(PROJ, PO, r0, col);
        else if (g == 1) pooled_rows<4>(PROJ, PO, r0, col);
        else if (g == 2) pooled_rows<8>(PROJ, PO, r0, col);
        else pooled_rows<16>(PROJ, PO, r0, col);
    }
}

__device__ __forceinline__ void c1_cumsum_unit(const Params& p, int b) {
    const int tid = tid_l(), lane = tid & 63, h = tid >> 6;
    const float* lsig = (const float*)(p.ws + WS_LSIG) + ((size_t)b * SEQ + lane) * 8 + h;
    float* cum = (float*)(p.ws + WS_CUM) + (size_t)(b * 8 + h) * SEQ + lane;
    float v[32];
#pragma unroll
    for (int i = 0; i < 32; ++i) v[i] = lsig[(size_t)i * 64 * 8];
    float carry = 0.f;
#pragma unroll
    for (int i = 0; i < 32; ++i) {
        float inc = v[i];
#pragma unroll
        for (int o = 1; o < 64; o <<= 1) { const float t = __shfl_up(inc, o); if (lane >= o) inc += t; }
        inc += carry;
        cum[i * 64] = inc * LOG2E;
        carry = __shfl(inc, 63);
    }
}

__device__ __forceinline__ void phase_c1(LAS unsigned char* lds, int layer) {
    const Params p = loadp(); int G, bx, vcu; geom(G, bx, vcu); layer = launder_s(layer);
    constexpr int NU = 1024 + 1024 + 256 + 8;
    for (int u = vcu; u < NU; u += G) {
        if (u < 1024) c1_chunk_unit<true>(p, lds, layer, u);
        else if (u < 2048) c1_chunk_unit<false>(p, lds, layer, u - 1024);
        else if (u < 2304) c1_pooled_unit(p, u - 2048);
        else c1_cumsum_unit(p, u - 2304);
    }
}

__device__ __forceinline__ void phase_c1b() {
    const Params p = loadp(); int G, bx, vcu; geom(G, bx, vcu);
    const float* ST = (const float*)(p.ws + WS_STATE);
    bf16_t* SC = (bf16_t*)(p.ws + WS_STATEC);
    for (int idx = vcu * NTHREADS + tid_l(); idx < 64 * 4096; idx += G * NTHREADS) {
        const int bh = idx >> 12, e4 = idx & 4095, h = bh & 7;
        const float gch = exp2f(log1pf(-exp2f(-5.0f - (float)h)) * LOG2E * 128.0f);
        const size_t off0 = (size_t)bh * 16 * 16384 + e4 * 4;
        f32x4 sv[15];
#pragma unroll
        for (int c = 0; c < 15; ++c) sv[c] = *(const f32x4*)(ST + off0 + (size_t)c * 16384);
        f32x4 run = (f32x4){0.f, 0.f, 0.f, 0.f};
#pragma unroll
        for (int c = 1; c < 16; ++c) {
            run = run * gch + sv[c - 1];
            u32x2 w; w.x = pk2(run.x, run.y); w.y = pk2(run.z, run.w);
            *(u32x2*)(SC + off0 + (size_t)c * 16384) = w;
        }
    }
}

__device__ __forceinline__ bf16x8 pack8(const f32x16& v, int base) {
    u32x4 w; w.x = pk2(v[base + 0], v[base + 1]); w.y = pk2(v[base + 2], v[base + 3]); w.z = pk2(v[base + 4], v[base + 5]); w.w = pk2(v[base + 6], v[base + 7]);
    return __builtin_bit_cast(bf16x8, w);
}

__device__ __forceinline__ void attn_block(const Params& p, LAS unsigned char* lds, int bh, int qb) {
    const int tid = tid_l(), lane = tid & 63, w = __builtin_amdgcn_readfirstlane(tid >> 6), l31 = lane & 31, hh = lane >> 5;
    const int b = bh >> 3, h = bh & 7;
    const bf16_t* PROJ = (const bf16_t*)(p.ws + WS_PROJ);
    const bf16_t* VTF = (const bf16_t*)(p.ws + WS_VTF) + (size_t)bh * 128 * SEQ;
    const float* cum = (const float*)(p.ws + WS_CUM) + (size_t)bh * SEQ;
    bf16_t* Y = (bf16_t*)(p.ws + WS_Y);
    const size_t rowbase = (size_t)b * SEQ;
    const int qrow = 256 * qb + 32 * w + l31;
    bf16x8 Qf[8];
    { const bf16_t* qp = PROJ + (rowbase + qrow) * NP + COL_FQ + h * 128 + 8 * hh;
#pragma unroll
      for (int ks = 0; ks < 8; ++ks) Qf[ks] = *(const bf16x8*)(qp + 16 * ks); }
    bf16x8 Qone;
    { u32x4 o; o.x = hh ? 0u : 0x3F803F80u; o.y = hh ? 0u : 0x00003F80u; o.z = 0u; o.w = 0u; Qone = __builtin_bit_cast(bf16x8, o); }
    const int ntiles = 4 * (qb + 1), wlast = 4 * qb + (w >> 1);
    const bf16_t* ksrc[2]; const bf16_t* vsrc[2];
#pragma unroll
    for (int i = 0; i < 2; ++i) {
        const int krow = (w + 8 * i) * 4 + (lane >> 4), kch = (lane & 15) ^ (krow & 15);
        ksrc[i] = PROJ + (rowbase + krow) * NP + COL_FK + h * 128 + kch * 8;
        const int vrow = (w + 8 * i) * 8 + (lane >> 3), vch = (lane & 7) ^ ((vrow >> 1) & 7);
        vsrc[i] = VTF + (size_t)vrow * SEQ + vch * 8;
    }
#define ATT_ISSUE(tile, bufoff) do { LAS unsigned char* b_ = lds + (bufoff) + w * 1024; \
        _Pragma("unroll") for (int i_ = 0; i_ < 2; ++i_) { \
            __builtin_amdgcn_global_load_lds((const unsigned*)(ksrc[i_] + (size_t)(tile) * 64 * NP), (LAS unsigned*)(b_ + i_ * 8192), 16, 0, 0); \
            __builtin_amdgcn_global_load_lds((const unsigned*)(vsrc[i_] + (tile) * 64), (LAS unsigned*)(b_ + 16384 + i_ * 8192), 16, 0, 0); } } while (0)
    int kaddr[4], vaddr[4];
#pragma unroll
    for (int q = 0; q < 4; ++q) { kaddr[q] = l31 * 256 + (((2 * q + hh) ^ (l31 & 15)) << 4); vaddr[q] = l31 * 128 + (((2 * q + hh) ^ ((l31 >> 1) & 7)) << 4); }
    f32x16 O0 = {}, O1 = {}, O2 = {}, O3 = {};
    float mrun = -1e30f, lrun = 0.f;
    LAS float* cumL = (LAS float*)(lds + 98304);
    *(LAS f32x4*)(cumL + 4 * tid) = *(const f32x4*)(cum + 4 * tid);
    ATT_ISSUE(ntiles - 1, 0);
    if (ntiles > 1) ATT_ISSUE(ntiles - 2, 32768);
    __syncthreads();
    int bcur = 0, bnext2 = 65536;
    for (int it = 0; it < ntiles; ++it) {
        const int kt = ntiles - 1 - it;
        if (it + 1 < ntiles) asm volatile("s_waitcnt vmcnt(4)" ::: "memory"); else asm volatile("s_waitcnt vmcnt(0)" ::: "memory");
        __builtin_amdgcn_s_barrier(); asm volatile("" ::: "memory");
        if (it + 2 < ntiles) ATT_ISSUE(kt - 2, bnext2);
        LAS unsigned char* buf = lds + bcur;
        if (kt <= wlast) {
            const float cb0 = -cumL[64 * kt + l31], cb1 = -cumL[64 * kt + 32 + l31];
            f32x16 S0 = {}, S1 = {};
#pragma unroll
            for (int ks = 0; ks < 4; ++ks) {
                LAS unsigned char* kp_ = buf + kaddr[ks]; LAS unsigned char* kq_ = buf + (kaddr[ks] ^ 128);
                const bf16x8 A0 = *(const LAS bf16x8*)(kp_);
                const bf16x8 A1 = *(const LAS bf16x8*)(kp_ + 8192);
                const bf16x8 A2 = *(const LAS bf16x8*)(kq_);
                const bf16x8 A3 = *(const LAS bf16x8*)(kq_ + 8192);
                S0 = __builtin_amdgcn_mfma_f32_32x32x16_bf16(A0, Qf[ks], S0, 0, 0, 0);
                S1 = __builtin_amdgcn_mfma_f32_32x32x16_bf16(A1, Qf[ks], S1, 0, 0, 0);
                S0 = __builtin_amdgcn_mfma_f32_32x32x16_bf16(A2, Qf[ks + 4], S0, 0, 0, 0);
                S1 = __builtin_amdgcn_mfma_f32_32x32x16_bf16(A3, Qf[ks + 4], S1, 0, 0, 0);
            }
            {
                const unsigned h0 = f2bf(cb0); const float r0f = cb0 - bflo(h0); const unsigned m0 = f2bf(r0f); const unsigned l0 = f2bf(r0f - bflo(m0));
                const unsigned h1 = f2bf(cb1); const float r1f = cb1 - bflo(h1); const unsigned m1 = f2bf(r1f); const unsigned l1 = f2bf(r1f - bflo(m1));
                u32x4 a0 = {hh ? 0u : (h0 | (m0 << 16)), hh ? 0u : l0, 0u, 0u}, a1 = {hh ? 0u : (h1 | (m1 << 16)), hh ? 0u : l1, 0u, 0u};
                S0 = __builtin_amdgcn_mfma_f32_32x32x16_bf16(__builtin_bit_cast(bf16x8, a0), Qone, S0, 0, 0, 0);
                S1 = __builtin_amdgcn_mfma_f32_32x32x16_bf16(__builtin_bit_cast(bf16x8, a1), Qone, S1, 0, 0, 0);
            }
            if (kt == wlast) {
                const float NEG = -__builtin_inff();
                const int kb = 64 * kt + 4 * hh;
#pragma unroll
                for (int r = 0; r < 16; ++r) { const int key = kb + (r & 3) + 8 * (r >> 2); if (key > qrow) S0[r] = NEG; if (key + 32 > qrow) S1[r] = NEG; }
            }
            float mx = S0[0];
#pragma unroll
            for (int r = 1; r < 16; ++r) mx = fmaxf(mx, S0[r]);
#pragma unroll
            for (int r = 0; r < 16; ++r) mx = fmaxf(mx, S1[r]);
            mx = fmaxf(mx, __shfl_xor(mx, 32));
            if (!__all(mx - mrun < -160.0f)) {
                if (!__all(mx <= mrun)) {
                    const float mnew = fmaxf(mrun, mx);
                    const float alpha = __builtin_amdgcn_exp2f(mrun - mnew);
                    mrun = mnew; lrun *= alpha;
                    O0 = O0 * alpha; O1 = O1 * alpha; O2 = O2 * alpha; O3 = O3 * alpha;
                }
                float ps = 0.f;
#pragma unroll
                for (int r = 0; r < 16; ++r) { S0[r] = __builtin_amdgcn_exp2f(S0[r] - mrun); S1[r] = __builtin_amdgcn_exp2f(S1[r] - mrun); ps += S0[r] + S1[r]; }
                lrun += ps;
                const bf16x8 P00 = pack8(S0, 0), P01 = pack8(S0, 8), P10 = pack8(S1, 0), P11 = pack8(S1, 8);
                LAS unsigned char* vb = buf + 16384;
#define ATT_PVQ(q, PX) do { \
                const bf16x8 V0_ = *(const LAS bf16x8*)(vb + vaddr[q]), V1_ = *(const LAS bf16x8*)(vb + vaddr[q] + 4096), V2_ = *(const LAS bf16x8*)(vb + vaddr[q] + 8192), V3_ = *(const LAS bf16x8*)(vb + vaddr[q] + 12288); \
                O0 = __builtin_amdgcn_mfma_f32_32x32x16_bf16(V0_, PX, O0, 0, 0, 0); O1 = __builtin_amdgcn_mfma_f32_32x32x16_bf16(V1_, PX, O1, 0, 0, 0); \
                O2 = __builtin_amdgcn_mfma_f32_32x32x16_bf16(V2_, PX, O2, 0, 0, 0); O3 = __builtin_amdgcn_mfma_f32_32x32x16_bf16(V3_, PX, O3, 0, 0, 0); } while (0)
                ATT_PVQ(0, P00); ATT_PVQ(1, P01); ATT_PVQ(2, P10); ATT_PVQ(3, P11);
#undef ATT_PVQ
            }
        }
        bnext2 = bcur; bcur = (bcur == 65536) ? 0 : bcur + 32768;
    }
#undef ATT_ISSUE
    const float ltot = lrun + __shfl_xor(lrun, 32);
    const float inv = __builtin_amdgcn_rcpf(ltot);
    const size_t grow = rowbase + qrow;
    const bf16_t* zp = PROJ + grow * NP + COL_FZ + h * 128 + 4 * hh;
    bf16_t* yp = Y + grow * 3072 + 1024 + h * 128 + 4 * hh;
    u32x2 zz[16];
#pragma unroll
    for (int i = 0; i < 16; ++i) zz[i] = *(const u32x2*)(zp + 32 * (i >> 2) + 8 * (i & 3));
    asm volatile("" : "+v"(zz[0]), "+v"(zz[1]), "+v"(zz[2]), "+v"(zz[3]), "+v"(zz[4]), "+v"(zz[5]), "+v"(zz[6]), "+v"(zz[7]));
    asm volatile("" : "+v"(zz[8]), "+v"(zz[9]), "+v"(zz[10]), "+v"(zz[11]), "+v"(zz[12]), "+v"(zz[13]), "+v"(zz[14]), "+v"(zz[15]));
#define ATT_ST(OX, db) do { _Pragma("unroll") for (int g = 0; g < 4; ++g) { const u32x2 z = zz[4 * (db) + g]; u32x2 o; \
        o.x = pk2(OX[4 * g + 0] * inv * fast_silu(bflo(z.x)), OX[4 * g + 1] * inv * fast_silu(bfhi(z.x))); o.y = pk2(OX[4 * g + 2] * inv * fast_silu(bflo(z.y)), OX[4 * g + 3] * inv * fast_silu(bfhi(z.y))); \
        *(u32x2*)(yp + 32 * (db) + 8 * g) = o; } } while (0)
    ATT_ST(O0, 0); ATT_ST(O1, 1); ATT_ST(O2, 2); ATT_ST(O3, 3);
#undef ATT_ST
    __syncthreads();
}

__device__ __forceinline__ void ret_out_unit(const Params& p, int layer, int unit, int gq) {
    const int lane = tid_l() & 63, l31 = lane & 31, hh = lane >> 5;
    const int bh = unit >> 4, c = unit & 15, b = bh >> 3, h = bh & 7;
    const bf16_t* PROJ = (const bf16_t*)(p.ws + WS_PROJ);
    const bf16_t* VTR = (const bf16_t*)(p.ws + WS_VTR) + (size_t)bh * 128 * SEQ + c * 128;
    const bf16_t* SC = (const bf16_t*)(p.ws + WS_STATEC) + (size_t)unit * 16384;
    bf16_t* Y = (bf16_t*)(p.ws + WS_Y);
    const size_t tok0 = (size_t)b * SEQ + c * 128;
    const int ql = 32 * gq + l31;
    const float lg2 = log1pf(-exp2f(-5.0f - (float)h)) * LOG2E;
    bf16x8 Qf[8];
    { const bf16_t* qp = PROJ + (tok0 + ql) * NP + COL_RQ + h * 128 + 8 * hh;
#pragma unroll
      for (int ks = 0; ks < 8; ++ks) Qf[ks] = *(const bf16x8*)(qp + 16 * ks); }
    f32x16 O0 = {}, O1 = {}, O2 = {}, O3 = {};
#define PIN8(X) asm volatile("" : "+v"(X[0]), "+v"(X[1]), "+v"(X[2]), "+v"(X[3]), "+v"(X[4]), "+v"(X[5]), "+v"(X[6]), "+v"(X[7]))
    if (c > 0) {
        const bf16_t* sp = SC + (size_t)l31 * 128 + 8 * hh;
#pragma unroll
        for (int kh = 0; kh < 2; ++kh) {
            bf16x8 Fa[8], Fb[8];
#pragma unroll
            for (int k4 = 0; k4 < 4; ++k4) { const int ks = 4 * kh + k4;
                Fa[2 * k4] = *(const bf16x8*)(sp + 0 * 4096 + 16 * ks); Fa[2 * k4 + 1] = *(const bf16x8*)(sp + 1 * 4096 + 16 * ks);
                Fb[2 * k4] = *(const bf16x8*)(sp + 2 * 4096 + 16 * ks); Fb[2 * k4 + 1] = *(const bf16x8*)(sp + 3 * 4096 + 16 * ks); }
            PIN8(Fa); PIN8(Fb);
#pragma unroll
            for (int k4 = 0; k4 < 4; ++k4) { const int ks = 4 * kh + k4;
                O0 = __builtin_amdgcn_mfma_f32_32x32x16_bf16(Fa[2 * k4], Qf[ks], O0, 0, 0, 0);
                O1 = __builtin_amdgcn_mfma_f32_32x32x16_bf16(Fa[2 * k4 + 1], Qf[ks], O1, 0, 0, 0);
                O2 = __builtin_amdgcn_mfma_f32_32x32x16_bf16(Fb[2 * k4], Qf[ks], O2, 0, 0, 0);
                O3 = __builtin_amdgcn_mfma_f32_32x32x16_bf16(Fb[2 * k4 + 1], Qf[ks], O3, 0, 0, 0); }
        }
        const float xi = __builtin_amdgcn_exp2f(lg2 * (float)(ql + 1));
        O0 = O0 * xi; O1 = O1 * xi; O2 = O2 * xi; O3 = O3 * xi;
    }
    for (int kb = 0; kb <= gq; ++kb) {
        const bf16_t* kp = PROJ + (tok0 + 32 * kb + l31) * NP + COL_RK + h * 128 + 8 * hh;
        const bf16_t* vp = VTR + (size_t)l31 * SEQ + 32 * kb + 8 * hh;
        bf16x8 Kf[8], Vf[8];
#pragma unroll
        for (int ks = 0; ks < 8; ++ks) Kf[ks] = *(const bf16x8*)(kp + 16 * ks);
#pragma unroll
        for (int db = 0; db < 4; ++db) { Vf[2 * db] = *(const bf16x8*)(vp + (size_t)(32 * db) * SEQ); Vf[2 * db + 1] = *(const bf16x8*)(vp + (size_t)(32 * db) * SEQ + 16); }
        PIN8(Kf);
        f32x16 S = {};
#pragma unroll
        for (int ks = 0; ks < 8; ++ks) S = __builtin_amdgcn_mfma_f32_32x32x16_bf16(Kf[ks], Qf[ks], S, 0, 0, 0);
#pragma unroll
        for (int r = 0; r < 16; ++r) { const int key = 32 * kb + (r & 3) + 8 * (r >> 2) + 4 * hh; const int d = ql - key; S[r] = (d >= 0) ? S[r] * __builtin_amdgcn_exp2f(lg2 * (float)d) : 0.f; }
        const bf16x8 P0 = pack8(S, 0), P1 = pack8(S, 8);
        PIN8(Vf);
        O0 = __builtin_amdgcn_mfma_f32_32x32x16_bf16(Vf[0], P0, O0, 0, 0, 0); O1 = __builtin_amdgcn_mfma_f32_32x32x16_bf16(Vf[2], P0, O1, 0, 0, 0);
        O2 = __builtin_amdgcn_mfma_f32_32x32x16_bf16(Vf[4], P0, O2, 0, 0, 0); O3 = __builtin_amdgcn_mfma_f32_32x32x16_bf16(Vf[6], P0, O3, 0, 0, 0);
        O0 = __builtin_amdgcn_mfma_f32_32x32x16_bf16(Vf[1], P1, O0, 0, 0, 0); O1 = __builtin_amdgcn_mfma_f32_32x32x16_bf16(Vf[3], P1, O1, 0, 0, 0);
        O2 = __builtin_amdgcn_mfma_f32_32x32x16_bf16(Vf[5], P1, O2, 0, 0, 0); O3 = __builtin_amdgcn_mfma_f32_32x32x16_bf16(Vf[7], P1, O3, 0, 0, 0);
    }
#undef PIN8
    float s1 = 0.f;
#pragma unroll
    for (int r = 0; r < 16; ++r) s1 += (O0[r] + O1[r]) + (O2[r] + O3[r]);
    s1 += __shfl_xor(s1, 32);
    const float mean = s1 * (1.0f / 128.0f);
    float s2 = 0.f;
#pragma unroll
    for (int r = 0; r < 16; ++r) { const float a = O0[r] - mean, bq = O1[r] - mean, cq = O2[r] - mean, dq = O3[r] - mean; s2 += (a * a + bq * bq) + (cq * cq + dq * dq); }
    s2 += __shfl_xor(s2, 32);
    const float rstd = 1.0f / sqrtf(s2 * (1.0f / 128.0f) + EPS);
    const float* gn = p.ret_gn_g + (size_t)layer * 1024 + h * 128 + 4 * hh;
    const size_t grow = tok0 + ql;
    const bf16_t* zp = PROJ + grow * NP + COL_RZ + h * 128 + 4 * hh;
    bf16_t* yp = Y + grow * 3072 + h * 128 + 4 * hh;
    u32x2 zz[16];
#pragma unroll
    for (int i = 0; i < 16; ++i) zz[i] = *(const u32x2*)(zp + 32 * (i >> 2) + 8 * (i & 3));
    f32x4 gg[8];
#pragma unroll
    for (int i = 0; i < 8; ++i) gg[i] = *(const f32x4*)(gn + 32 * (i >> 2) + 8 * (i & 3));
    asm volatile("" : "+v"(zz[0]), "+v"(zz[1]), "+v"(zz[2]), "+v"(zz[3]), "+v"(zz[4]), "+v"(zz[5]), "+v"(zz[6]), "+v"(zz[7]));
    asm volatile("" : "+v"(zz[8]), "+v"(zz[9]), "+v"(zz[10]), "+v"(zz[11]), "+v"(zz[12]), "+v"(zz[13]), "+v"(zz[14]), "+v"(zz[15]));
    asm volatile("" : "+v"(gg[0]), "+v"(gg[1]), "+v"(gg[2]), "+v"(gg[3]), "+v"(gg[4]), "+v"(gg[5]), "+v"(gg[6]), "+v"(gg[7]));
#define RET_ST(OX, db, GG) do { _Pragma("unroll") for (int g = 0; g < 4; ++g) { const u32x2 z = zz[4 * (db) + g]; const f32x4 gq_ = GG[4 * ((db) & 1) + g]; u32x2 o; \
        o.x = pk2((OX[4 * g + 0] - mean) * rstd * gq_.x * fast_silu(bflo(z.x)), (OX[4 * g + 1] - mean) * rstd * gq_.y * fast_silu(bfhi(z.x))); \
        o.y = pk2((OX[4 * g + 2] - mean) * rstd * gq_.z * fast_silu(bflo(z.y)), (OX[4 * g + 3] - mean) * rstd * gq_.w * fast_silu(bfhi(z.y))); \
        *(u32x2*)(yp + 32 * (db) + 8 * g) = o; } } while (0)
    RET_ST(O0, 0, gg); RET_ST(O1, 1, gg);
#pragma unroll
    for (int i = 0; i < 8; ++i) gg[i] = *(const f32x4*)(gn + 64 + 32 * (i >> 2) + 8 * (i & 3));
    asm volatile("" : "+v"(gg[0]), "+v"(gg[1]), "+v"(gg[2]), "+v"(gg[3]), "+v"(gg[4]), "+v"(gg[5]), "+v"(gg[6]), "+v"(gg[7]));
    RET_ST(O2, 2, gg); RET_ST(O3, 3, gg);
#undef RET_ST
}

__device__ __forceinline__ void phase_c2(LAS unsigned char* lds, int layer) {
#if PHC2 & 1
    { const Params p = loadp(); int G, bx, vcu; geom(G, bx, vcu);
      for (int it = vcu; it < 256; it += G) { const int bh = it >> 2, i = it & 3; for (int k2 = 0; k2 < 2; ++k2) attn_block(p, lds, bh, k2 ? i : 7 - i); } }
#endif
#if PHC2 & 2
    { const Params p = loadp(); int G, bx, vcu; geom(G, bx, vcu); const int ly = launder_s(layer);
      const int wave = __builtin_amdgcn_readfirstlane(tid_l() >> 6);
      for (int it = vcu; it < 512; it += G) ret_out_unit(p, ly, 2 * it + (wave >> 2), wave & 3); }
#endif
    __syncthreads();
#if PHC2 & 4
    { const Params p = loadp(); int G, bx, vcu; geom(G, bx, vcu); const int ly = launder_s(layer);
      SchedPool S{(const bf16_t*)(p.ws + WS_POOLED), (const bf16_t*)(p.ws + WS_WPOOL), G, bx};
      EpiPool E{(const bf16_t*)(p.ws + WS_PROJ), (bf16_t*)(p.ws + WS_Y), p.pool_scale + (size_t)ly * 1024};
      pg8::gemm_phase<EpiPool, SchedPool>(lds, launder_s(256), 1024, 256, S, E); }
#endif
}

__device__ __forceinline__ void phase_final() {
    const Params p = loadp(); int G, bx, vcu; geom(G, bx, vcu);
    const int tid = tid_l(), lane = tid & 63, wave = tid >> 6;
    const int gw = vcu * NWAVES + wave, NGW = G * NWAVES;
    f32x4 gfin[8];
#pragma unroll
    for (int j = 0; j < 8; ++j) gfin[j] = *((const f32x4*)p.final_g + lane + 64 * j);
    f32x4 vn[8];
    if (gw < M) {
#pragma unroll
        for (int j = 0; j < 8; ++j) vn[j] = *((const f32x4*)(p.out + (size_t)gw * DM) + lane + 64 * j);
    }
    for (int m = gw; m < M; m += NGW) {
        f32x4* xr = (f32x4*)(p.out + (size_t)m * DM) + lane;
        f32x4 v[8]; float ss = 0.f;
#pragma unroll
        for (int j = 0; j < 8; ++j) { v[j] = vn[j]; ss += (v[j].x * v[j].x + v[j].y * v[j].y) + (v[j].z * v[j].z + v[j].w * v[j].w); }
        if (m + NGW < M) {
#pragma unroll
            for (int j = 0; j < 8; ++j) vn[j] = *((const f32x4*)(p.out + (size_t)(m + NGW) * DM) + lane + 64 * j);
        }
        const float rstd = 1.0f / sqrtf(wave_sum(ss) * (1.0f / DM) + EPS);
#pragma unroll
        for (int j = 0; j < 8; ++j) xr[64 * j] = v[j] * rstd * gfin[j];
    }
}

__global__ void __launch_bounds__(NTHREADS, 2) hybrid_fwd(Params p_unused) {
    extern __shared__ __attribute__((aligned(16))) unsigned char lds_raw[];
    LAS unsigned char* lds = (LAS unsigned char*)lds_raw;
    cg::grid_group grid = cg::this_grid();
    if (gridDim.y == 0x7fffffffu) grid.sync();
    if (threadIdx.x < 16) ((volatile LAS unsigned*)(lds + LDS_BARST))[threadIdx.x] = 0u;
    __syncthreads();
    (void)xcd_barrier_post((unsigned*)(loadp().ws + WS_BAR), (volatile LAS unsigned*)(lds + LDS_BARST));
#define GSYNC() do { XcdBarrier b_; b_.bar = (unsigned*)(loadp().ws + WS_BAR); b_.x = xb_xcc_id(); b_.st = (volatile LAS unsigned*)(lds + LDS_BARST); xcd_barrier(b_); } while (0)
#pragma unroll 1
    for (int layer = 0; layer < DEPTH; ++layer) {
#if PHM & 1
        phase_a(lds, layer);
#if REPM & 1
        GSYNC(); phase_a(lds, layer);
#endif
#endif
        GSYNC();
#if PHM & 2
        {
            const Params p = loadp(); int G, bx, vcu; geom(G, bx, vcu);
            SchedProj S{(const bf16_t*)(p.ws + WS_H), (const bf16_t*)(p.ws + WS_WIN), DM, DM, 64, 64, G, bx};
            EpiProj E{(bf16_t*)(p.ws + WS_PROJ), (const float*)(p.ws + WS_ROPE)};
            pg8::gemm_phase<EpiProj, SchedProj>(lds, DM, DM, DM, S, E);
        }
#endif
        GSYNC();
#if PHM & 4
        phase_c1(lds, layer);
#if REPM & 4
        GSYNC(); phase_c1(lds, layer);
#endif
#endif
        GSYNC();
#if PHM & 8
        phase_c1b();
#endif
        GSYNC();
#if PHM & 16
        phase_c2(lds, layer);
#if REPM & 16
        GSYNC(); phase_c2(lds, layer);
#endif
#endif
        GSYNC();
#if PHM & 32
        {
            const Params p = loadp(); int G, bx, vcu; geom(G, bx, vcu);
            SchedMerge S{(const bf16_t*)(p.ws + WS_Y), (const bf16_t*)(p.ws + WS_WBR), G, bx};
            EpiMerge E{(const bf16_t*)(p.ws + WS_PROJ), (bf16_t*)(p.ws + WS_H)};
            pg8::gemm_phase<EpiMerge, SchedMerge>(lds, 1024, 3072, 1024, S, E);
        }
#endif
        GSYNC();
#if PHM & 64
        {
            const Params p = loadp(); int G, bx, vcu; geom(G, bx, vcu); const int ly = launder_s(layer);
            SchedPlain S{(const bf16_t*)(p.ws + WS_H), (const bf16_t*)(p.ws + WS_WOUT), DM, DM, 64, 8, G, bx};
            EpiOut E{sel_ptr(p.x, p.out, ly), p.out};
            pg8::gemm_phase<EpiOut, SchedPlain>(lds, DM, DM, DM, S, E);
        }
#endif
        GSYNC();
    }
#if PHM & 128
    phase_final();
#endif
}

extern "C" void kernel_launch(void* const* d_in, const int* in_sizes, int n_in, void* d_out, int out_size, void* d_ws, size_t ws_size, hipStream_t stream) {
    static int grid_blocks = 0;
    if (!grid_blocks) {
        int dev = 0, cus = 0, per_cu = 0;
        hipGetDevice(&dev);
        hipDeviceGetAttribute(&cus, hipDeviceAttributeMultiprocessorCount, dev);
        hipFuncSetAttribute((const void*)hybrid_fwd, hipFuncAttributeMaxDynamicSharedMemorySize, LDS_BYTES);
        hipOccupancyMaxActiveBlocksPerMultiprocessor(&per_cu, (const void*)hybrid_fwd, NTHREADS, LDS_BYTES);
        if (per_cu < 1) per_cu = 1;
        grid_blocks = cus * 1;
        if (ws_size < WS_END) fprintf(stderr, "kernel_launch: workspace too small: %zu < %zu\n", ws_size, (size_t)WS_END);
    }
    Params p{};
    p.x = (const float*)d_in[0]; p.norm_g = (const float*)d_in[1]; p.w_in = (const float*)d_in[2]; p.ret_gn_g = (const float*)d_in[3]; p.fox_b_f = (const float*)d_in[4];
    p.pool_w = (const float*)d_in[5]; p.pool_scale = (const float*)d_in[6]; p.w_ret = (const float*)d_in[7]; p.w_fox = (const float*)d_in[8]; p.w_pool = (const float*)d_in[9];
    p.w_out = (const float*)d_in[10]; p.final_g = (const float*)d_in[11];
    p.out = (float*)d_out; p.ws = (unsigned char*)d_ws;
    (void)hipMemsetAsync((char*)d_ws + WS_BAR, 0, XCD_BAR_WORDS * sizeof(unsigned), stream);
    void* args[] = {&p};
    hipError_t e = hipLaunchCooperativeKernel((const void*)hybrid_fwd, dim3(grid_blocks), dim3(NTHREADS), args, LDS_BYTES, stream);
    if (e != hipSuccess) fprintf(stderr, "cooperative launch failed: %s (grid %d)\n", hipGetErrorString(e), grid_blocks);
}
```

```cpp
#include <hip/hip_runtime.h>
#include <hip/hip_cooperative_groups.h>
#include <cstdio>
#include <cstdint>
namespace cg = cooperative_groups;
#ifndef PHM
#define PHM 255
#endif
#ifndef PHC2
#define PHC2 7
#endif
#ifndef REPM
#define REPM 0
#endif

#define LAS __attribute__((address_space(3)))
typedef unsigned short bf16_t;
typedef short bf16x8 __attribute__((ext_vector_type(8)));
typedef float f32x4 __attribute__((ext_vector_type(4)));
typedef float f32x16 __attribute__((ext_vector_type(16)));
typedef unsigned u32x4 __attribute__((ext_vector_type(4)));
typedef unsigned u32x2 __attribute__((ext_vector_type(2)));

constexpr int BATCH = 8, SEQ = 2048, DM = 2048, M = BATCH * SEQ, NH = 8, CIN = 16392, NP = 16384, DEPTH = 2;
constexpr int COL_RQ = 0, COL_RK = 1024, COL_RV = 2048, COL_RZ = 3072, COL_FQ = 4096, COL_FK = 5120, COL_FV = 6144, COL_FZ = 7168,
              COL_PU = 8192, COL_PZ = 9216, COL_GA = 10240, COL_GB = 12288, COL_GC = 14336;
constexpr float EPS = 1e-6f, LOG2E = 1.4426950408889634f;
constexpr int NWAVES = 8, NTHREADS = 512;
constexpr int LDS_BYTES = 147456;
constexpr int LDS_BARST = LDS_BYTES - 64;

constexpr size_t MiB = 1u << 20;
constexpr size_t WS_LSIG = 0;
constexpr size_t WS_CUM = MiB / 2;
constexpr size_t WS_ROPE = 1 * MiB;
constexpr size_t WS_WPOOL = 2 * MiB;
constexpr size_t WS_BAR = 3 * MiB;
constexpr size_t WS_WOUT = 4 * MiB;
constexpr size_t WS_WBR = 12 * MiB;
constexpr size_t WS_WIN = 24 * MiB;
constexpr size_t WS_H = 88 * MiB;
constexpr size_t WS_PROJ = 152 * MiB;
constexpr size_t WS_Y = 664 * MiB;
constexpr size_t WS_STATE = 760 * MiB;
constexpr size_t WS_STATEC = 824 * MiB;
constexpr size_t WS_POOLED = 856 * MiB;
constexpr size_t WS_VTF = 888 * MiB;
constexpr size_t WS_VTR = 920 * MiB;
constexpr size_t WS_END = 952 * MiB;

__device__ __forceinline__ unsigned f2bf(float f) { unsigned u = __builtin_bit_cast(unsigned, f); return (u + 0x7fffu + ((u >> 16) & 1u)) >> 16; }
typedef float f32x2 __attribute__((ext_vector_type(2)));
typedef __bf16 hwbf16x2 __attribute__((ext_vector_type(2)));
__device__ __forceinline__ unsigned pk2(float lo, float hi) { const f32x2 v = {lo, hi}; const hwbf16x2 b = __builtin_convertvector(v, hwbf16x2); return __builtin_bit_cast(unsigned, b); }
__device__ __forceinline__ float bflo(unsigned w) { return __builtin_bit_cast(float, w << 16); }
__device__ __forceinline__ float bfhi(unsigned w) { return __builtin_bit_cast(float, w & 0xffff0000u); }
__device__ __forceinline__ float wave_sum(float v) {
#pragma unroll
    for (int o = 1; o < 64; o <<= 1) v += __shfl_xor(v, o);
    return v;
}
__device__ __forceinline__ float fast_sigmoid(float x) { return __builtin_amdgcn_rcpf(1.0f + __builtin_amdgcn_exp2f(-x * LOG2E)); }
__device__ __forceinline__ float fast_silu(float x) { return x * fast_sigmoid(x); }
#define LDS_WAIT() asm volatile("s_waitcnt lgkmcnt(0)" ::: "memory")
__device__ __forceinline__ int tid_l() { int t = threadIdx.x; asm volatile("" : "+v"(t)); return t; }

namespace pg8 {
constexpr int BM = 256, BK = 64, HALF = 128, HTB = HALF * BK * 2, STAGE_BYTES = 8 * HTB, NXCD = 8, WGM = 8;
__device__ __forceinline__ int lds_byte(int r, int c) { const int st = (r >> 4) * 2 + (c >> 5), rr = r & 15, cc = c & 31, ob = rr * 64 + cc * 2; return st * 1024 + (ob ^ (((ob >> 9) & 1) << 5)); }
__device__ __forceinline__ void stage_rc(int b, int& R, int& C) { const int st = b / 1024, sb = b % 1024, swz = sb ^ (((sb >> 9) & 1) << 5); R = (st >> 1) * 16 + swz / 64; C = (st & 1) * 32 + (swz % 64) / 2; }
__device__ __forceinline__ int perm32(int rho) { const int n = rho >> 4, i = rho & 15; return 8 * (i >> 2) + 4 * n + (i & 3); }

struct Unit { int pm, pn, aux; };

__device__ __forceinline__ void tile_of(int L, int nM, int nN, int& pm, int& pn) {
    const int nwg = nM * nN; int wgid = L;
    { const int q = nwg / NXCD, r = nwg % NXCD, xcd = wgid % NXCD, off = wgid / NXCD; wgid = (xcd < r ? xcd * (q + 1) : r * (q + 1) + (xcd - r) * q) + off; }
    const int nig = WGM * nN, gid = wgid / nig, fm = gid * WGM, gsz = (nM - fm) < WGM ? (nM - fm) : WGM;
    pm = fm + ((wgid % nig) % gsz); pn = (wgid % nig) / gsz;
}

template <class Epi, class Sched>
__device__ __forceinline__ void gemm_phase(LAS unsigned char* lds, const int K, const int lda, const int ldb, const Sched& S, const Epi& E) {
    const int tid = tid_l(), wid = __builtin_amdgcn_readfirstlane(tid >> 6), lane = tid & 63, wr = wid >> 2, wc = wid & 3, fr = lane & 15, fq = lane >> 4;
    const int nt = K / BK;
    unsigned voffA[2], voffB[2];
#pragma unroll
    for (int i = 0; i < 2; ++i) { int R, C; stage_rc(tid * 16 + i * 8192, R, C); const int Rb = Epi::PERM ? ((R & ~31) + perm32(R & 31)) : R;
        voffA[i] = (unsigned)(R * lda + C) * 2u; voffB[i] = (unsigned)(Rb * ldb + C) * 2u; }
    const size_t kstep = (size_t)(BK * 2);
    const size_t hstepA = (size_t)HALF * lda * 2, hstepB = (size_t)HALF * ldb * 2;
    const unsigned ldsw = (unsigned)wid * 1024u;
    const int aoff = lds_byte(wr * 64 + fr, fq * 8), boff = lds_byte(wc * 32 + fr, fq * 8);
#define PG8_SA(b, h) (((b) * 2 + (h)) * HTB)
#define PG8_SB(b, h) ((4 + (b) * 2 + (h)) * HTB)
#define PG8_STAGE(bufoff, gbase, voff) do { _Pragma("unroll") for (int _i = 0; _i < 2; ++_i) \
        __builtin_amdgcn_global_load_lds((const unsigned*)((const char*)(gbase) + (voff)[_i]), (LAS unsigned*)(lds + (bufoff) + ldsw + _i * 8192), 16, 0, 0); } while (0)
#define PG8_LDA(dst, b, h) do { _Pragma("unroll") for (int m = 0; m < 4; ++m) _Pragma("unroll") for (int k = 0; k < 2; ++k) dst[m][k] = *(const LAS bf16x8*)(lds + PG8_SA(b, h) + aoff + m * 2048 + k * 1024); } while (0)
#define PG8_LDB(dst, b, h) do { _Pragma("unroll") for (int n = 0; n < 2; ++n) _Pragma("unroll") for (int k = 0; k < 2; ++k) dst[n][k] = *(const LAS bf16x8*)(lds + PG8_SB(b, h) + boff + n * 2048 + k * 1024); } while (0)
#define PG8_MMA(ai, bj, At, Bt) do { __builtin_amdgcn_s_setprio(1); _Pragma("unroll") for (int m = 0; m < 4; ++m) _Pragma("unroll") for (int n = 0; n < 2; ++n) _Pragma("unroll") for (int k = 0; k < 2; ++k) \
        acc[ai][bj][m][n] = __builtin_amdgcn_mfma_f32_16x16x32_bf16(Bt[n][k], At[m][k], acc[ai][bj][m][n], 0, 0, 0); __builtin_amdgcn_s_setprio(0); } while (0)
#define PG8_WAIT_V(n) asm volatile("s_waitcnt vmcnt(" #n ")" ::: "memory")
#define PG8_WAIT_L(n) asm volatile("s_waitcnt lgkmcnt(" #n ")" ::: "memory")
#define PG8_BAR __builtin_amdgcn_s_barrier()
#define PG8_SCHED __builtin_amdgcn_sched_barrier(0)
    Unit cur, nxt; int ui = 0;
    if (!S.next(0, cur)) return;
    f32x4 acc[2][2][4][2];
#pragma unroll
    for (int a = 0; a < 2; ++a)
#pragma unroll
        for (int b = 0; b < 2; ++b)
#pragma unroll
            for (int m = 0; m < 4; ++m)
#pragma unroll
                for (int n = 0; n < 2; ++n) acc[a][b][m][n] = (f32x4){0.f, 0.f, 0.f, 0.f};
    bf16x8 At[4][2], B0[2][2], B1[2][2];
    const char* cA = S.a_ptr(cur); const char* cB = S.b_ptr(cur);
    PG8_STAGE(PG8_SB(0, 0), cB, voffB); PG8_STAGE(PG8_SB(0, 1), cB + hstepB, voffB); PG8_STAGE(PG8_SA(0, 0), cA, voffA); PG8_STAGE(PG8_SA(0, 1), cA + hstepA, voffA);
    if (wr == 1) PG8_BAR;
    PG8_WAIT_V(2); PG8_BAR;
    PG8_STAGE(PG8_SB(1, 0), cB + kstep, voffB); PG8_STAGE(PG8_SA(1, 0), cA + kstep, voffA); PG8_STAGE(PG8_SB(1, 1), cB + hstepB + kstep, voffB);
    PG8_WAIT_V(6); PG8_BAR;
    for (;;) {
        const bool has_next = S.next(ui + 1, nxt);
        const char* nA = has_next ? S.a_ptr(nxt) : cA; const char* nB = has_next ? S.b_ptr(nxt) : cB;
        for (int t = 0; t < nt; t += 2) {
            const bool last = (t == nt - 2);
            const char* a1 = cA + (size_t)(t + 1) * kstep;
            const char* a2 = last ? nA : cA + (size_t)(t + 2) * kstep; const char* b2 = last ? nB : cB + (size_t)(t + 2) * kstep;
            const char* a3 = a2 + kstep; const char* b3 = b2 + kstep;
            PG8_LDB(B0, 0, 0); PG8_LDB(B1, 0, 1); PG8_SCHED; PG8_LDA(At, 0, 0); PG8_STAGE(PG8_SA(1, 1), a1 + hstepA, voffA);
            PG8_WAIT_V(8); PG8_WAIT_L(0); PG8_BAR; PG8_MMA(0, 0, At, B0); PG8_MMA(0, 1, At, B1); PG8_BAR; PG8_SCHED;
            PG8_LDA(At, 0, 1); PG8_STAGE(PG8_SB(0, 0), b2, voffB); PG8_STAGE(PG8_SB(0, 1), b2 + hstepB, voffB); PG8_STAGE(PG8_SA(0, 0), a2, voffA);
            PG8_WAIT_V(8); PG8_WAIT_L(0); PG8_BAR; PG8_MMA(1, 0, At, B0); PG8_MMA(1, 1, At, B1); PG8_BAR; PG8_SCHED;
            PG8_LDB(B0, 1, 0); PG8_LDB(B1, 1, 1); PG8_SCHED; PG8_LDA(At, 1, 0); PG8_STAGE(PG8_SA(0, 1), a2 + hstepA, voffA);
            PG8_WAIT_V(8); PG8_WAIT_L(0); PG8_BAR; PG8_MMA(0, 0, At, B0); PG8_MMA(0, 1, At, B1); PG8_BAR; PG8_SCHED;
            PG8_LDA(At, 1, 1); PG8_STAGE(PG8_SB(1, 0), b3, voffB); PG8_STAGE(PG8_SB(1, 1), b3 + hstepB, voffB); PG8_STAGE(PG8_SA(1, 0), a3, voffA);
            PG8_WAIT_V(8); PG8_WAIT_L(0); PG8_BAR; PG8_MMA(1, 0, At, B0); PG8_MMA(1, 1, At, B1); PG8_BAR; PG8_SCHED;
        }
        if (wr == 0) PG8_BAR;
        const bool zero = E(acc, cur, wr, wc, fr, fq);
        if (!has_next) break;
        if (zero) {
#pragma unroll
            for (int a = 0; a < 2; ++a)
#pragma unroll
                for (int b = 0; b < 2; ++b)
#pragma unroll
                    for (int m = 0; m < 4; ++m)
#pragma unroll
                        for (int n = 0; n < 2; ++n) acc[a][b][m][n] = (f32x4){0.f, 0.f, 0.f, 0.f};
        }
        cur = nxt; cA = nA; cB = nB; ++ui;
        if (wr == 1) PG8_BAR;
    }
    PG8_WAIT_V(0);
    PG8_BAR;
#undef PG8_SA
#undef PG8_SB
#undef PG8_STAGE
#undef PG8_LDA
#undef PG8_LDB
#undef PG8_MMA
#undef PG8_WAIT_V
#undef PG8_WAIT_L
#undef PG8_BAR
#undef PG8_SCHED
}
}
using pg8::Unit;

struct SchedPlain {
    const bf16_t* A; const bf16_t* Bt; int lda, ldb, nM, nN, G, c;
    __device__ __forceinline__ bool next(int i, Unit& u) const { const int L = i * G + c; if (L >= nM * nN) return false; pg8::tile_of(L, nM, nN, u.pm, u.pn); u.aux = 0; return true; }
    __device__ __forceinline__ const char* a_ptr(const Unit& u) const { return (const char*)(A + (size_t)u.pm * 256 * lda); }
    __device__ __forceinline__ const char* b_ptr(const Unit& u) const { return (const char*)(Bt + (size_t)u.pn * 256 * ldb); }
};
struct SchedProj {
    const bf16_t* A; const bf16_t* Bt; int lda, ldb, nM, nN, G, c;
    __device__ __forceinline__ bool next(int i, Unit& u) const {
        if (G != 256) { const int L = i * G + c; if (L >= nM * nN) return false; pg8::tile_of(L, nM, nN, u.pm, u.pn); u.aux = 0; return true; }
        if (i >= 16) return false;
        const int x = c & 7; u.pm = 8 * x + ((c >> 3) & 7); u.pn = 4 * ((i + 2 * x) & 15) + (c >> 6); u.aux = 0; return true; }
    __device__ __forceinline__ const char* a_ptr(const Unit& u) const { return (const char*)(A + (size_t)u.pm * 256 * lda); }
    __device__ __forceinline__ const char* b_ptr(const Unit& u) const { return (const char*)(Bt + (size_t)u.pn * 256 * ldb); }
};
struct SchedMerge {
    const bf16_t* Y; const bf16_t* W; int G, c;
    __device__ __forceinline__ bool next(int i, Unit& u) const { const int j = i / 3, br = i - 3 * j; const int L = j * G + c; if (L >= 512) return false; pg8::tile_of(L, 64, 8, u.pm, u.pn); u.aux = br; return true; }
    __device__ __forceinline__ const char* a_ptr(const Unit& u) const { return (const char*)(Y + (size_t)u.pm * 256 * 3072 + u.aux * 1024); }
    __device__ __forceinline__ const char* b_ptr(const Unit& u) const { return (const char*)(W + (size_t)u.aux * 2048 * 1024 + (size_t)u.pn * 256 * 1024); }
};
struct SchedPool {
    const bf16_t* P; const bf16_t* W; int G, c;
    __device__ __forceinline__ bool next(int i, Unit& u) const { const int L = i * G + c; if (L >= 256) return false; u.pm = L >> 2; u.pn = L & 3; u.aux = 0; return true; }
    __device__ __forceinline__ const char* a_ptr(const Unit& u) const { return (const char*)(P + (size_t)u.pm * 256 * 1024 + u.pn * 256); }
    __device__ __forceinline__ const char* b_ptr(const Unit& u) const { return (const char*)(W + (size_t)u.pn * 65536); }
};

struct EpiProj {
    static constexpr bool PERM = true;
    bf16_t* P; const float* rope;
    __device__ __forceinline__ bool operator()(f32x4 (&acc)[2][2][4][2], const Unit& u, int wr, int wc, int fr, int fq) const {
        asm volatile("" : "+v"(fr), "+v"(fq));
        const int row0 = u.pm * 256 + wr * 64 + fr, col0 = u.pn * 256 + wc * 32 + 8 * fq;
        const int pn = u.pn;
        int mode;
        if (pn < 4) mode = 3; else if (pn < 8) mode = 4; else if (pn < 12) mode = 0; else if (pn < 16) mode = 1; else if (pn < 20) mode = 5; else if (pn < 28) mode = 0;
        else if (pn < 32) mode = 1; else if (pn < 36) mode = 0; else if (pn < 40) mode = 1; else mode = 2;
        const int j0 = wc * 16 + 4 * fq;
#pragma unroll
        for (int ai = 0; ai < 2; ++ai) {
            f32x4 csa[4], csb[4];
#pragma unroll
            for (int m = 0; m < 4; ++m) { csa[m] = (f32x4){1.f, 0.f, 1.f, 0.f}; csb[m] = csa[m]; }
            if (mode == 3 || mode == 4) {
#pragma unroll
                for (int m = 0; m < 4; ++m) { const float* tp = rope + ((size_t)((row0 + ai * 128 + m * 16) & (SEQ - 1)) * 64 + j0) * 2; csa[m] = *(const f32x4*)tp; csb[m] = *(const f32x4*)(tp + 4); }
                asm volatile("" : "+v"(csa[0]), "+v"(csa[1]), "+v"(csa[2]), "+v"(csa[3]), "+v"(csb[0]), "+v"(csb[1]), "+v"(csb[2]), "+v"(csb[3]));
            }
#pragma unroll
            for (int m = 0; m < 4; ++m) {
                const int row = row0 + ai * 128 + m * 16;
                bf16_t* rowp = P + (size_t)row * NP + col0;
                const f32x4 cs0 = csa[m], cs1 = csb[m];
#pragma unroll
                for (int bj = 0; bj < 2; ++bj) {
                    f32x4 v0 = acc[ai][bj][m][0], v1 = acc[ai][bj][m][1];
                    if (mode == 1) {
#pragma unroll
                        for (int j = 0; j < 4; ++j) { v0[j] = fast_silu(v0[j]); v1[j] = fast_silu(v1[j]); }
                    } else if (mode == 2) {
#pragma unroll
                        for (int j = 0; j < 4; ++j) { v0[j] = fast_sigmoid(fminf(fmaxf(v0[j], -60.f), 60.f)); v1[j] = fast_sigmoid(fminf(fmaxf(v1[j], -60.f), 60.f)); }
                    } else if (mode == 3 || mode == 4) {
                        const float sc = (mode == 4) ? 0.08838834764831845f : 1.0f;
                        f32x4 o0, o1;
                        o0[0] = (v0[0] * cs0[0] - v0[1] * cs0[1]) * sc; o0[1] = (v0[0] * cs0[1] + v0[1] * cs0[0]) * sc;
                        o0[2] = (v0[2] * cs0[2] - v0[3] * cs0[3]) * sc; o0[3] = (v0[2] * cs0[3] + v0[3] * cs0[2]) * sc;
                        o1[0] = (v1[0] * cs1[0] - v1[1] * cs1[1]) * sc; o1[1] = (v1[0] * cs1[1] + v1[1] * cs1[0]) * sc;
                        o1[2] = (v1[2] * cs1[2] - v1[3] * cs1[3]) * sc; o1[3] = (v1[2] * cs1[3] + v1[3] * cs1[2]) * sc;
                        v0 = o0; v1 = o1;
                    } else if (mode == 5) { v0 = v0 * (0.08838834764831845f * LOG2E); v1 = v1 * (0.08838834764831845f * LOG2E); }
                    u32x4 w; w.x = pk2(v0[0], v0[1]); w.y = pk2(v0[2], v0[3]); w.z = pk2(v1[0], v1[1]); w.w = pk2(v1[2], v1[3]);
                    *(u32x4*)(rowp + bj * 128) = w;
                }
            }
        }
        return true;
    }
};
struct EpiPool {
    static constexpr bool PERM = true;
    const bf16_t* P; bf16_t* Y; const float* scale;
    __device__ __forceinline__ bool operator()(f32x4 (&acc)[2][2][4][2], const Unit& u, int wr, int wc, int fr, int fq) const {
        asm volatile("" : "+v"(fr), "+v"(fq));
        const int row0 = u.pm * 256 + wr * 64 + fr, col0 = u.pn * 256 + wc * 32 + 8 * fq;
        f32x4 sc[2][2];
#pragma unroll
        for (int bj = 0; bj < 2; ++bj) { sc[bj][0] = *(const f32x4*)(scale + col0 + bj * 128); sc[bj][1] = *(const f32x4*)(scale + col0 + bj * 128 + 4); }
#pragma unroll
        for (int ai = 0; ai < 2; ++ai) {
            u32x4 z[4][2];
#pragma unroll
            for (int m = 0; m < 4; ++m)
#pragma unroll
                for (int bj = 0; bj < 2; ++bj) z[m][bj] = *(const u32x4*)((const char*)P + (unsigned)(((row0 + ai * 128 + m * 16) * NP + COL_PZ + col0 + bj * 128) * 2));
            asm volatile("" : "+v"(z[0][0]), "+v"(z[0][1]), "+v"(z[1][0]), "+v"(z[1][1]), "+v"(z[2][0]), "+v"(z[2][1]), "+v"(z[3][0]), "+v"(z[3][1]));
#pragma unroll
            for (int m = 0; m < 4; ++m)
#pragma unroll
                for (int bj = 0; bj < 2; ++bj) {
                    const u32x4 zz = z[m][bj];
                    const f32x4 v0 = acc[ai][bj][m][0] * sc[bj][0], v1 = acc[ai][bj][m][1] * sc[bj][1];
                    u32x4 w; w.x = pk2(v0[0] * bflo(zz.x), v0[1] * bfhi(zz.x)); w.y = pk2(v0[2] * bflo(zz.y), v0[3] * bfhi(zz.y));
                    w.z = pk2(v1[0] * bflo(zz.z), v1[1] * bfhi(zz.z)); w.w = pk2(v1[2] * bflo(zz.w), v1[3] * bfhi(zz.w));
                    *(u32x4*)((char*)Y + (unsigned)(((row0 + ai * 128 + m * 16) * 3072 + 2048 + col0 + bj * 128) * 2)) = w;
                }
        }
        return true;
    }
};
struct EpiMerge {
    static constexpr bool PERM = true;
    const bf16_t* P; bf16_t* O;
    __device__ __forceinline__ bool operator()(f32x4 (&acc)[2][2][4][2], const Unit& u, int wr, int wc, int fr, int fq) const {
        asm volatile("" : "+v"(fr), "+v"(fq));
        const int row0 = u.pm * 256 + wr * 64 + fr, col0 = u.pn * 256 + wc * 32 + 8 * fq;
        const int br = u.aux;
        const int cnum = (br == 0) ? COL_GA : (br == 1) ? COL_GB : COL_GC;
        const int cden = (br == 0) ? COL_GB : COL_GC;
#pragma unroll
        for (int ai = 0; ai < 2; ++ai)
#pragma unroll
            for (int mp = 0; mp < 2; ++mp) {
                u32x4 gn[2][2], gd[2][2];
#pragma unroll
                for (int mm = 0; mm < 2; ++mm)
#pragma unroll
                    for (int bj = 0; bj < 2; ++bj) { const bf16_t* prow = P + (size_t)(row0 + ai * 128 + (2 * mp + mm) * 16) * NP + col0 + bj * 128;
                        gn[mm][bj] = *(const u32x4*)(prow + cnum); gd[mm][bj] = *(const u32x4*)(prow + cden); }
                asm volatile("" : "+v"(gn[0][0]), "+v"(gn[0][1]), "+v"(gn[1][0]), "+v"(gn[1][1]), "+v"(gd[0][0]), "+v"(gd[0][1]), "+v"(gd[1][0]), "+v"(gd[1][1]));
#pragma unroll
                for (int mm = 0; mm < 2; ++mm)
#pragma unroll
                    for (int bj = 0; bj < 2; ++bj) {
                        const int m = 2 * mp + mm; const u32x4 g = gn[mm][bj], d = gd[mm][bj];
                        f32x4 f0 = (f32x4){bflo(g.x), bfhi(g.x), bflo(g.y), bfhi(g.y)}, f1 = (f32x4){bflo(g.z), bfhi(g.z), bflo(g.w), bfhi(g.w)};
                        if (br < 2) {
                            f0[0] *= __builtin_amdgcn_rcpf(bflo(d.x)); f0[1] *= __builtin_amdgcn_rcpf(bfhi(d.x)); f0[2] *= __builtin_amdgcn_rcpf(bflo(d.y)); f0[3] *= __builtin_amdgcn_rcpf(bfhi(d.y));
                            f1[0] *= __builtin_amdgcn_rcpf(bflo(d.z)); f1[1] *= __builtin_amdgcn_rcpf(bfhi(d.z)); f1[2] *= __builtin_amdgcn_rcpf(bflo(d.w)); f1[3] *= __builtin_amdgcn_rcpf(bfhi(d.w));
                        }
                        acc[ai][bj][m][0] = acc[ai][bj][m][0] * f0; acc[ai][bj][m][1] = acc[ai][bj][m][1] * f1;
                        if (br == 2) {
                            const f32x4 v0 = acc[ai][bj][m][0], v1 = acc[ai][bj][m][1];
                            u32x4 w; w.x = pk2(v0[0], v0[1]); w.y = pk2(v0[2], v0[3]); w.z = pk2(v1[0], v1[1]); w.w = pk2(v1[2], v1[3]);
                            *(u32x4*)(O + (size_t)(row0 + ai * 128 + m * 16) * DM + col0 + bj * 128) = w;
                        }
                    }
            }
        return br == 2;
    }
};
struct EpiOut {
    static constexpr bool PERM = false;
    const float* xin; float* xout;
    __device__ __forceinline__ bool operator()(f32x4 (&acc)[2][2][4][2], const Unit& u, int wr, int wc, int fr, int fq) const {
        asm volatile("" : "+v"(fr), "+v"(fq));
        const int row0 = u.pm * 256 + wr * 64 + fr, col0 = u.pn * 256 + wc * 32 + 4 * fq;
#pragma unroll
        for (int ai = 0; ai < 2; ++ai)
#pragma unroll
            for (int mp = 0; mp < 2; ++mp) {
                f32x4 xo[2][2][2];
#pragma unroll
                for (int mm = 0; mm < 2; ++mm)
#pragma unroll
                    for (int bj = 0; bj < 2; ++bj)
#pragma unroll
                        for (int n = 0; n < 2; ++n) xo[mm][bj][n] = *(const f32x4*)(xin + (size_t)(row0 + ai * 128 + (2 * mp + mm) * 16) * DM + col0 + bj * 128 + n * 16);
                asm volatile("" : "+v"(xo[0][0][0]), "+v"(xo[0][0][1]), "+v"(xo[0][1][0]), "+v"(xo[0][1][1]), "+v"(xo[1][0][0]), "+v"(xo[1][0][1]), "+v"(xo[1][1][0]), "+v"(xo[1][1][1]));
#pragma unroll
                for (int mm = 0; mm < 2; ++mm)
#pragma unroll
                    for (int bj = 0; bj < 2; ++bj)
#pragma unroll
                        for (int n = 0; n < 2; ++n) *(f32x4*)(xout + (size_t)(row0 + ai * 128 + (2 * mp + mm) * 16) * DM + col0 + bj * 128 + n * 16) = xo[mm][bj][n] + acc[ai][bj][2 * mp + mm][n];
            }
        return true;
    }
};

struct Params {
    const float* x; const float* norm_g; const float* w_in; const float* ret_gn_g; const float* fox_b_f; const float* pool_w; const float* pool_scale;
    const float* w_ret; const float* w_fox; const float* w_pool; const float* w_out; const float* final_g;
    float* out; unsigned char* ws;
};

#define XB_TMO      128
#define XB_XCNT(j)  (256  + 64 * (j))
#define XB_XSUB(j)  (1280 + 64 * (j))
#define XB_XGEN(j)  (2304 + 64 * (j))
#define XB_TOP      3328
#define XB_TOPGEN   3392
#define XCD_BAR_WORDS 3456
#define XB_SPIN_CAP (1u << 18)

__device__ __forceinline__ unsigned xb_ld(unsigned* p)              { return __hip_atomic_load(p, __ATOMIC_RELAXED, __HIP_MEMORY_SCOPE_AGENT); }
__device__ __forceinline__ unsigned xb_add(unsigned* p, unsigned v) { return __hip_atomic_fetch_add(p, v, __ATOMIC_RELAXED, __HIP_MEMORY_SCOPE_AGENT); }
__device__ __forceinline__ unsigned xb_xcc_id() { return (unsigned)__builtin_amdgcn_s_getreg((3 << 11) | 20) & 0xFu; }
#define XB_SPIN(cond, bar) do { unsigned _sp = 0; while (cond) { __builtin_amdgcn_s_sleep(1); \
    if ((++_sp & 255u) == 0u) { if (xb_ld(&(bar)[XB_TMO])) break; if (_sp > XB_SPIN_CAP) { atomicAdd(&(bar)[XB_TMO], 1u); break; } } } } while (0)

struct XcdBarrier {
    unsigned* bar; unsigned x;
    volatile LAS unsigned* st;
};

__device__ __forceinline__ XcdBarrier xcd_barrier_post(unsigned* bar, volatile LAS unsigned* st) {
    XcdBarrier b; b.bar = bar; b.x = xb_xcc_id(); b.st = st;
    if (threadIdx.x == 0) (void)xb_add(&bar[XB_XCNT(b.x)], 1u);
    return b;
}
__device__ __forceinline__ void xcd_barrier_complete(unsigned* bar, unsigned x, unsigned& nloc, unsigned& nx) {
    const unsigned G = gridDim.x * gridDim.y * gridDim.z;
    unsigned sum, cnt, mine, sp = 0u;
    for (;;) {
        sum = 0u; cnt = 0u; mine = 0u;
#pragma unroll
        for (unsigned j = 0; j < 16; ++j) { const unsigned c = xb_ld(&bar[XB_XCNT(j)]); sum += c; cnt += (c > 0u) ? 1u : 0u; mine = (j == x) ? c : mine; }
        if (sum == G) break;
        __builtin_amdgcn_s_sleep(1);
        if ((++sp & 255u) == 0u) { if (xb_ld(&bar[XB_TMO])) break; if (sp > XB_SPIN_CAP) { atomicAdd(&bar[XB_TMO], 1u); break; } }
    }
    nloc = mine > 0u ? mine : 1u; nx = cnt > 0u ? cnt : 1u;
}

__device__ __forceinline__ void xcd_barrier(const XcdBarrier& b) {
    asm volatile("s_waitcnt vmcnt(0)" ::: "memory");
    __syncthreads();
    if (threadIdx.x == 0) {
        unsigned* bar = b.bar;
        __builtin_amdgcn_s_waitcnt(0);
        unsigned nloc = b.st[0], nx = b.st[1];
        if (nloc == 0u) { xcd_barrier_complete(bar, b.x, nloc, nx); b.st[0] = nloc; b.st[1] = nx; }
        const unsigned old = xb_add(&bar[XB_XSUB(b.x)], 1u);
        const unsigned gen = old / nloc;
        if (old + 1u == (gen + 1u) * nloc) {
            __builtin_amdgcn_fence(__ATOMIC_RELEASE, "agent");
            asm volatile("s_waitcnt vmcnt(0)" ::: "memory");
            const unsigned og = xb_add(&bar[XB_TOP], 1u);
            const unsigned tg = og / nx;
            if (og + 1u == (tg + 1u) * nx) xb_add(&bar[XB_TOPGEN], 1u);
            else XB_SPIN(xb_ld(&bar[XB_TOPGEN]) == tg, bar);
            __builtin_amdgcn_fence(__ATOMIC_ACQUIRE, "agent");
            xb_add(&bar[XB_XGEN(b.x)], 1u);
            asm volatile("s_waitcnt vmcnt(0)" ::: "memory");
        } else {
            XB_SPIN(xb_ld(&bar[XB_XGEN(b.x)]) == gen, bar);
            __builtin_amdgcn_fence(__ATOMIC_ACQUIRE, "agent");
            asm volatile("s_waitcnt vmcnt(0)" ::: "memory");
        }
    }
    __syncthreads();
}


typedef const Params __attribute__((address_space(4))) CParams;
__device__ __forceinline__ Params loadp() {
    const CParams* pp = (const CParams*)__builtin_amdgcn_kernarg_segment_ptr();
    asm volatile("" : "+s"(pp));
    Params p;
    p.x = pp->x; p.norm_g = pp->norm_g; p.w_in = pp->w_in; p.ret_gn_g = pp->ret_gn_g; p.fox_b_f = pp->fox_b_f; p.pool_w = pp->pool_w; p.pool_scale = pp->pool_scale;
    p.w_ret = pp->w_ret; p.w_fox = pp->w_fox; p.w_pool = pp->w_pool; p.w_out = pp->w_out; p.final_g = pp->final_g; p.out = pp->out; p.ws = pp->ws;
    return p;
}
__device__ __forceinline__ int launder_s(int v) { asm volatile("" : "+s"(v)); return v; }
__device__ __forceinline__ void geom(int& G, int& bx, int& vcu) { G = launder_s((int)gridDim.x); bx = launder_s((int)blockIdx.x); vcu = (G % 8 == 0) ? (bx % 8) * (G / 8) + bx / 8 : bx; }
__device__ __forceinline__ const float* sel_ptr(const float* a, const float* b, int useb) { const uintptr_t m = (uintptr_t)0 - (uintptr_t)(useb != 0); return (const float*)(((uintptr_t)a & ~m) | ((uintptr_t)b & m)); }

__device__ __forceinline__ int win_dest(int n) {
    if (n < 2048) { const int head = n >> 7, w = n & 127; return head * 128 + 2 * (w & 63) + (w >> 6); }
    if (n < 8192) return n;
    if (n < 8200) return -1;
    return n - 8;
}
struct TrItem { const float* W; bf16_t* WT; int ldw, ncols, K, item; bool winmap; };
__device__ __forceinline__ void tr_load(const TrItem& t, f32x4 (&ld)[8], int lane) {
    const int nblk = (t.ncols + 31) >> 5, kb = t.item / nblk, nb = t.item - kb * nblk, k0 = 64 * kb, n0 = 32 * nb;
    const int c4 = lane & 7, kr = lane >> 3; const bool okc = (n0 + 4 * c4) < t.ncols;
#pragma unroll
    for (int i = 0; i < 8; ++i) ld[i] = okc ? *(const f32x4*)(t.W + (size_t)(k0 + 8 * i + kr) * t.ldw + n0 + 4 * c4) : (f32x4){0.f, 0.f, 0.f, 0.f};
}
__device__ __forceinline__ void tr_finish(const TrItem& t, const f32x4 (&ld)[8], LAS float* scr, int lane) {
    const int nblk = (t.ncols + 31) >> 5, kb = t.item / nblk, nb = t.item - kb * nblk, k0 = 64 * kb, n0 = 32 * nb;
    const int c4 = lane & 7, kr = lane >> 3;
#pragma unroll
    for (int i = 0; i < 8; ++i) { LAS float* d = scr + (8 * i + kr) * 33 + 4 * c4; d[0] = ld[i].x; d[1] = ld[i].y; d[2] = ld[i].z; d[3] = ld[i].w; }
    LDS_WAIT(); asm volatile("" ::: "memory");
    const int c = lane & 7;
#pragma unroll
    for (int j = 0; j < 4; ++j) { const int n = (lane >> 3) + 8 * j; const int ns = n0 + n; const int dest = (ns < t.ncols) ? (t.winmap ? win_dest(ns) : ns) : -1;
        const LAS float* sp = scr + (8 * c) * 33 + n;
        u32x4 o; o.x = pk2(sp[0 * 33], sp[1 * 33]); o.y = pk2(sp[2 * 33], sp[3 * 33]); o.z = pk2(sp[4 * 33], sp[5 * 33]); o.w = pk2(sp[6 * 33], sp[7 * 33]);
        if (dest >= 0) *(u32x4*)(t.WT + (size_t)dest * t.K + k0 + 8 * c) = o; }
    LDS_WAIT(); asm volatile("" ::: "memory");
}

__device__ __forceinline__ void phase_a(LAS unsigned char* lds, int layer) {
    const Params p = loadp(); int G, bx, vcu; geom(G, bx, vcu); layer = launder_s(layer);
    const int tid = tid_l(), lane = tid & 63, wave = __builtin_amdgcn_readfirstlane(tid >> 6);
    unsigned char* ws = p.ws;
    const float* w_in = p.w_in + (size_t)layer * DM * CIN;
    LAS float* wff = (LAS float*)lds;
    for (int k = tid; k < DM; k += NTHREADS) {
        const float* src = w_in + (size_t)k * CIN + 8192;
        const f32x4 a = *(const f32x4*)src, b = *(const f32x4*)(src + 4);
        const int j = k >> 8, l = (k >> 2) & 63, i = k & 3;
        LAS float* d = wff + ((j * 4 + i) * 64 + l) * 8;
        *(LAS f32x4*)d = a; *(LAS f32x4*)(d + 4) = b;
    }
    __syncthreads();
    LAS float* scr = (LAS float*)(lds + 65536 + wave * 8448);
    const int gw = vcu * NWAVES + wave, NGW = G * NWAVES;
    constexpr int I_IN = 32 * 513, I_BR = 16 * 64, I_OUT = 32 * 64, I_PW = 4 * 8;
    constexpr int NITEMS = I_IN + 3 * I_BR + I_OUT + 4 * I_PW;
    auto decode = [&](int it) -> TrItem {
        TrItem t; int r = it; unsigned char* wsb = ws;
        if (r < I_IN) { t.W = w_in; t.WT = (bf16_t*)(wsb + WS_WIN); t.ldw = CIN; t.ncols = CIN; t.K = DM; t.item = r; t.winmap = true; return t; } r -= I_IN;
        t.winmap = false;
        if (r < 3 * I_BR) { const int q = r / I_BR; r -= q * I_BR; const float* wb = (q == 0) ? p.w_ret : (q == 1) ? p.w_fox : p.w_pool;
            t.W = wb + (size_t)layer * 1024 * DM; t.WT = (bf16_t*)(wsb + WS_WBR) + (size_t)q * 2048 * 1024; t.ldw = DM; t.ncols = DM; t.K = 1024; t.item = r; return t; } r -= 3 * I_BR;
        if (r < I_OUT) { t.W = p.w_out + (size_t)layer * DM * DM; t.WT = (bf16_t*)(wsb + WS_WOUT); t.ldw = DM; t.ncols = DM; t.K = DM; t.item = r; return t; } r -= I_OUT;
        { const int g = r / I_PW; t.W = p.pool_w + (size_t)layer * 4 * 65536 + (size_t)g * 65536; t.WT = (bf16_t*)(wsb + WS_WPOOL) + (size_t)g * 65536; t.ldw = 256; t.ncols = 256; t.K = 256; t.item = r - g * I_PW; return t; }
    };
    {
        int it = gw;
        if (it < NITEMS) {
            TrItem cur = decode(it); f32x4 lda[8], ldb[8];
            tr_load(cur, lda, lane);
            for (;;) {
                const int nit = it + NGW; const bool hn = nit < NITEMS;
                TrItem nxt = cur; if (hn) { nxt = decode(nit); tr_load(nxt, ldb, lane); }
                tr_finish(cur, lda, scr, lane);
                if (!hn) break;
#pragma unroll
                for (int i = 0; i < 8; ++i) lda[i] = ldb[i];
                cur = nxt; it = nit;
            }
        }
    }
    if (layer == 0) {
        float* rope = (float*)(ws + WS_ROPE);
        for (int idx = (vcu * NTHREADS + tid); idx < SEQ * 64; idx += G * NTHREADS) {
            const int pos = idx >> 6, j = idx & 63;
            const float inv = exp2f(-(float)j * (13.287712379549449f / 64.0f));
            const float ang = (float)pos * inv;
            double rev = (double)ang * 0.15915494309189535; rev -= floor(rev);
            const float rf = (float)rev;
            rope[2 * idx] = __builtin_amdgcn_cosf(rf); rope[2 * idx + 1] = __builtin_amdgcn_sinf(rf);
        }
    }
    const float* xin = sel_ptr(p.x, p.out, layer);
    const float* g = p.norm_g + (size_t)layer * DM;
    bf16_t* H = (bf16_t*)(ws + WS_H);
    float* lsig = (float*)(ws + WS_LSIG);
    const float* bf = p.fox_b_f + layer * 8;
    f32x4 gv[8];
#pragma unroll
    for (int j = 0; j < 8; ++j) gv[j] = *((const f32x4*)g + lane + 64 * j);
    f32x4 vn[8];
    if (gw < M) {
#pragma unroll
        for (int j = 0; j < 8; ++j) vn[j] = *((const f32x4*)(xin + (size_t)gw * DM) + lane + 64 * j);
    }
    for (int m = gw; m < M; m += NGW) {
        f32x4 v[8]; float ss = 0.f;
#pragma unroll
        for (int j = 0; j < 8; ++j) { v[j] = vn[j]; ss += (v[j].x * v[j].x + v[j].y * v[j].y) + (v[j].z * v[j].z + v[j].w * v[j].w); }
        if (m + NGW < M) {
#pragma unroll
            for (int j = 0; j < 8; ++j) vn[j] = *((const f32x4*)(xin + (size_t)(m + NGW) * DM) + lane + 64 * j);
        }
        const float rstd = 1.0f / sqrtf(wave_sum(ss) * (1.0f / DM) + EPS);
        float fa[8];
#pragma unroll
        for (int o = 0; o < 8; ++o) fa[o] = 0.f;
        u32x2* o8 = (u32x2*)(H + (size_t)m * DM) + lane;
#pragma unroll
        for (int j = 0; j < 8; ++j) {
            const f32x4 hv = v[j] * rstd * gv[j];
            u32x2 w; w.x = pk2(hv.x, hv.y); w.y = pk2(hv.z, hv.w); o8[64 * j] = w;
#pragma unroll
            for (int i = 0; i < 4; ++i) {
                const LAS float* wp = wff + ((j * 4 + i) * 64 + lane) * 8;
                const f32x4 wa = *(const LAS f32x4*)wp, wb = *(const LAS f32x4*)(wp + 4);
                const float hh = hv[i];
                fa[0] += hh * wa.x; fa[1] += hh * wa.y; fa[2] += hh * wa.z; fa[3] += hh * wa.w;
                fa[4] += hh * wb.x; fa[5] += hh * wb.y; fa[6] += hh * wb.z; fa[7] += hh * wb.w;
            }
            asm volatile("" ::: "memory");
        }
        float mine = 0.f;
#pragma unroll
        for (int o = 0; o < 8; ++o) { const float t = wave_sum(fa[o]); mine = (lane == o) ? t : mine; }
        if (lane < 8) { const float xl = mine + bf[lane]; lsig[(size_t)m * 8 + lane] = fminf(xl, 0.f) - log1pf(__expf(-fabsf(xl))); }
    }
    __syncthreads();
}

__device__ __forceinline__ int swap23(int t) { return (t & ~12) | ((t & 4) << 1) | ((t & 8) >> 1); }
__device__ __forceinline__ int tswz(int row) { return ((row >> 3) ^ (row & 7)) & 15; }
__device__ __forceinline__ int timg(int row, int pos) { return row * 256 + ((((pos >> 3) ^ tswz(row)) << 4) | ((pos & 7) << 1)); }

struct ChunkRegs { u32x4 kv[4], vv[4], fv[4]; };
__device__ __forceinline__ void c1_chunk_load(const Params& p, int unit, int tid, ChunkRegs& R) {
    const int bh = unit >> 4, c = unit & 15, b = bh >> 3, h = bh & 7;
    const bf16_t* PROJ = (const bf16_t*)(p.ws + WS_PROJ);
    const int T = tid >> 4, ch = tid & 15;
    const bf16_t* src = PROJ + ((size_t)b * SEQ + c * 128 + 4 * T) * NP + h * 128 + ch * 8;
#pragma unroll
    for (int j = 0; j < 4; ++j) { R.kv[j] = *(const u32x4*)(src + (size_t)j * NP + COL_RK); R.vv[j] = *(const u32x4*)(src + (size_t)j * NP + COL_RV); R.fv[j] = *(const u32x4*)(src + (size_t)j * NP + COL_FV); }
}
__device__ __forceinline__ void c1_chunk_stage(LAS unsigned char* lds, int unit, int tid, const ChunkRegs& R) {
    const int h = (unit >> 4) & 7;
    const int T = tid >> 4, ch = tid & 15, pos0 = swap23(4 * T);
    LAS unsigned char* VtL = lds; LAS unsigned char* KtL = lds + 32768; LAS unsigned char* VfL = lds + 65536;
    const float lg2 = log1pf(-exp2f(-5.0f - (float)h)) * LOG2E;
    float z[4];
#pragma unroll
    for (int j = 0; j < 4; ++j) z[j] = __builtin_amdgcn_exp2f(lg2 * (float)(127 - (4 * T + j)));
#pragma unroll
    for (int e = 0; e < 4; ++e) {
        { const unsigned w0 = R.vv[0][e], w1 = R.vv[1][e], w2 = R.vv[2][e], w3 = R.vv[3][e];
          u32x2 lo, hi; lo.x = (w0 & 0xffffu) | (w1 << 16); lo.y = (w2 & 0xffffu) | (w3 << 16); hi.x = (w0 >> 16) | (w1 & 0xffff0000u); hi.y = (w2 >> 16) | (w3 & 0xffff0000u);
          *(LAS u32x2*)(VtL + timg(ch * 8 + 2 * e, pos0)) = lo; *(LAS u32x2*)(VtL + timg(ch * 8 + 2 * e + 1, pos0)) = hi; }
        { const unsigned w0 = R.fv[0][e], w1 = R.fv[1][e], w2 = R.fv[2][e], w3 = R.fv[3][e];
          u32x2 lo, hi; lo.x = (w0 & 0xffffu) | (w1 << 16); lo.y = (w2 & 0xffffu) | (w3 << 16); hi.x = (w0 >> 16) | (w1 & 0xffff0000u); hi.y = (w2 >> 16) | (w3 & 0xffff0000u);
          *(LAS u32x2*)(VfL + timg(ch * 8 + 2 * e, pos0)) = lo; *(LAS u32x2*)(VfL + timg(ch * 8 + 2 * e + 1, pos0)) = hi; }
        { const unsigned w0 = R.kv[0][e], w1 = R.kv[1][e], w2 = R.kv[2][e], w3 = R.kv[3][e];
          u32x2 lo, hi; lo.x = pk2(bflo(w0) * z[0], bflo(w1) * z[1]); lo.y = pk2(bflo(w2) * z[2], bflo(w3) * z[3]);
          hi.x = pk2(bfhi(w0) * z[0], bfhi(w1) * z[1]); hi.y = pk2(bfhi(w2) * z[2], bfhi(w3) * z[3]);
          *(LAS u32x2*)(KtL + timg(ch * 8 + 2 * e, pos0)) = lo; *(LAS u32x2*)(KtL + timg(ch * 8 + 2 * e + 1, pos0)) = hi; }
    }
}
__device__ __forceinline__ void c1_chunk_finish(const Params& p, LAS unsigned char* lds, int unit, int tid) {
    const int lane = tid & 63, wave = __builtin_amdgcn_readfirstlane(tid >> 6);
    const int bh = unit >> 4, c = unit & 15;
    LAS unsigned char* VtL = lds; LAS unsigned char* KtL = lds + 32768; LAS unsigned char* VfL = lds + 65536;
    bf16_t* VTR = (bf16_t*)(p.ws + WS_VTR); bf16_t* VTF = (bf16_t*)(p.ws + WS_VTF);
#pragma unroll
    for (int i = 0; i < 4; ++i) {
        const int pc = tid + 512 * i, d = pc >> 4, ch = pc & 15; const int lo = d * 256 + ((ch ^ tswz(d)) << 4);
        const u32x4 w = *(const LAS u32x4*)(VtL + lo), f = *(const LAS u32x4*)(VfL + lo);
        const size_t go = ((size_t)bh * 128 + d) * SEQ + c * 128 + ch * 8;
        *(u32x4*)(VTR + go) = w; *(u32x4*)(VTF + go) = f;
    }
    const int l31 = lane & 31, hh = lane >> 5;
    const int bv = wave >> 1, bk0 = 2 * (wave & 1);
    f32x16 a0 = {}, a1 = {};
    const int rv = 32 * bv + l31, rk0 = 32 * bk0 + l31, rk1 = rk0 + 32;
#pragma unroll
    for (int s = 0; s < 8; ++s) {
        const int chunk = 2 * s + hh;
        const bf16x8 A = *(const LAS bf16x8*)(VtL + rv * 256 + ((chunk ^ tswz(rv)) << 4));
        const bf16x8 B0 = *(const LAS bf16x8*)(KtL + rk0 * 256 + ((chunk ^ tswz(rk0)) << 4));
        const bf16x8 B1 = *(const LAS bf16x8*)(KtL + rk1 * 256 + ((chunk ^ tswz(rk1)) << 4));
        a0 = __builtin_amdgcn_mfma_f32_32x32x16_bf16(A, B0, a0, 0, 0, 0);
        a1 = __builtin_amdgcn_mfma_f32_32x32x16_bf16(A, B1, a1, 0, 0, 0);
    }
    float* ST = (float*)(p.ws + WS_STATE) + (size_t)unit * 16384;
#pragma unroll
    for (int r = 0; r < 16; ++r) {
        const int dv = 32 * bv + (r & 3) + 8 * (r >> 2) + 4 * hh;
        ST[dv * 128 + 32 * bk0 + l31] = a0[r];
        ST[dv * 128 + 32 * bk0 + 32 + l31] = a1[r];
    }
}

template <int W>
__device__ __forceinline__ void pooled_rows(const bf16_t* PROJ, bf16_t* PO, int r0, int col) {
    constexpr int NL = 8 + W - 1;
    const int t0 = r0 & (SEQ - 1);
    u32x4 L[NL];
#pragma unroll
    for (int j = 0; j < NL; ++j) { const int dt = j - (W - 1); L[j] = (t0 + dt >= 0) ? *(const u32x4*)(PROJ + (size_t)(r0 + dt) * NP + COL_PU + col) : (u32x4){0u, 0u, 0u, 0u}; }
    float s[8];
#pragma unroll
    for (int e = 0; e < 8; ++e) s[e] = 0.f;
#pragma unroll
    for (int j = 0; j < W - 1; ++j) { s[0] += bflo(L[j].x); s[1] += bfhi(L[j].x); s[2] += bflo(L[j].y); s[3] += bfhi(L[j].y); s[4] += bflo(L[j].z); s[5] += bfhi(L[j].z); s[6] += bflo(L[j].w); s[7] += bfhi(L[j].w); }
#pragma unroll
    for (int k = 0; k < 8; ++k) {
        const u32x4 nw = L[k + W - 1];
        s[0] += bflo(nw.x); s[1] += bfhi(nw.x); s[2] += bflo(nw.y); s[3] += bfhi(nw.y); s[4] += bflo(nw.z); s[5] += bfhi(nw.z); s[6] += bflo(nw.w); s[7] += bfhi(nw.w);
        const int n = (t0 + k + 1 < W) ? (t0 + k + 1) : W;
        const float inv = 1.0f / (float)n;
        u32x4 o;
        o.x = pk2(s[0] * inv - bflo(nw.x), s[1] * inv - bfhi(nw.x)); o.y = pk2(s[2] * inv - bflo(nw.y), s[3] * inv - bfhi(nw.y));
        o.z = pk2(s[4] * inv - bflo(nw.z), s[5] * inv - bfhi(nw.z)); o.w = pk2(s[6] * inv - bflo(nw.w), s[7] * inv - bfhi(nw.w));
        *(u32x4*)(PO + (size_t)(r0 + k) * 1024 + col) = o;
        const u32x4 od = L[k];
        s[0] -= bflo(od.x); s[1] -= bfhi(od.x); s[2] -= bflo(od.y); s[3] -= bfhi(od.y); s[4] -= bflo(od.z); s[5] -= bfhi(od.z); s[6] -= bflo(od.w); s[7] -= bfhi(od.w);
    }
}
__device__ __forceinline__ void c1_pooled_unit(const Params& p, int unit) {
    const int tid = tid_l(), lane = tid & 63, w8 = __builtin_amdgcn_readfirstlane(tid >> 6);
    const bf16_t* PROJ = (const bf16_t*)(p.ws + WS_PROJ);
    bf16_t* PO = (bf16_t*)(p.ws + WS_POOLED);
    const int g = w8 & 3, col = g * 256 + (lane & 31) * 8;
    const int strip = (w8 >> 2) * 2 + (lane >> 5);
#pragma unroll 1
    for (int pass = 0; pass < 2; ++pass) {
        const int r0 = unit * 64 + strip * 16 + pass * 8;
        if (g == 0) pooled_rows<2>(PROJ, PO, r0, col);
        else if (g == 1) pooled_rows<4>(PROJ, PO, r0, col);
        else if (g == 2) pooled_rows<8>(PROJ, PO, r0, col);
        else pooled_rows<16>(PROJ, PO, r0, col);
    }
}

__device__ __forceinline__ void c1_cumsum_unit(const Params& p, int b) {
    const int tid = tid_l(), lane = tid & 63, h = tid >> 6;
    const float* lsig = (const float*)(p.ws + WS_LSIG) + ((size_t)b * SEQ + lane) * 8 + h;
    float* cum = (float*)(p.ws + WS_CUM) + (size_t)(b * 8 + h) * SEQ + lane;
    float v[32];
#pragma unroll
    for (int i = 0; i < 32; ++i) v[i] = lsig[(size_t)i * 64 * 8];
    float carry = 0.f;
#pragma unroll
    for (int i = 0; i < 32; ++i) {
        float inc = v[i];
#pragma unroll
        for (int o = 1; o < 64; o <<= 1) { const float t = __shfl_up(inc, o); if (lane >= o) inc += t; }
        inc += carry;
        cum[i * 64] = inc * LOG2E;
        carry = __shfl(inc, 63);
    }
}

__device__ __forceinline__ void phase_c1(LAS unsigned char* lds, int layer) {
    const Params p = loadp(); int G, bx, vcu; geom(G, bx, vcu);
    const int tid = tid_l();
    {
        int u = vcu;
        if (u < 1024) {
            ChunkRegs R; c1_chunk_load(p, u, tid, R);
            for (;;) {
                c1_chunk_stage(lds, u, tid, R);
                __syncthreads();
                const int un = u + G;
                if (un < 1024) c1_chunk_load(p, un, tid, R);
                c1_chunk_finish(p, lds, u, tid);
                __syncthreads();
                if (un >= 1024) break;
                u = un;
            }
        }
    }
    for (int u = vcu; u < 256 + 8; u += G) {
        if (u < 256) c1_pooled_unit(p, u);
        else c1_cumsum_unit(p, u - 256);
    }
}

__device__ __forceinline__ void phase_c1b() {
    const Params p = loadp(); int G, bx, vcu; geom(G, bx, vcu);
    const float* ST = (const float*)(p.ws + WS_STATE);
    bf16_t* SC = (bf16_t*)(p.ws + WS_STATEC);
    for (int idx = vcu * NTHREADS + tid_l(); idx < 64 * 4096; idx += G * NTHREADS) {
        const int bh = idx >> 12, e4 = idx & 4095, h = bh & 7;
        const float gch = exp2f(log1pf(-exp2f(-5.0f - (float)h)) * LOG2E * 128.0f);
        const size_t off0 = (size_t)bh * 16 * 16384 + e4 * 4;
        f32x4 sv[15];
#pragma unroll
        for (int c = 0; c < 15; ++c) sv[c] = *(const f32x4*)(ST + off0 + (size_t)c * 16384);
        f32x4 run = (f32x4){0.f, 0.f, 0.f, 0.f};
#pragma unroll
        for (int c = 1; c < 16; ++c) {
            run = run * gch + sv[c - 1];
            u32x2 w; w.x = pk2(run.x, run.y); w.y = pk2(run.z, run.w);
            *(u32x2*)(SC + off0 + (size_t)c * 16384) = w;
        }
    }
}

__device__ __forceinline__ bf16x8 pack8(const f32x16& v, int base) {
    u32x4 w; w.x = pk2(v[base + 0], v[base + 1]); w.y = pk2(v[base + 2], v[base + 3]); w.z = pk2(v[base + 4], v[base + 5]); w.w = pk2(v[base + 6], v[base + 7]);
    return __builtin_bit_cast(bf16x8, w);
}

__device__ __forceinline__ void attn_block(const Params& p, LAS unsigned char* lds, int bh, int qb) {
    const int tid = tid_l(), lane = tid & 63, w = __builtin_amdgcn_readfirstlane(tid >> 6), l31 = lane & 31, hh = lane >> 5;
    const int b = bh >> 3, h = bh & 7;
    const bf16_t* PROJ = (const bf16_t*)(p.ws + WS_PROJ);
    const bf16_t* VTF = (const bf16_t*)(p.ws + WS_VTF) + (size_t)bh * 128 * SEQ;
    const float* cum = (const float*)(p.ws + WS_CUM) + (size_t)bh * SEQ;
    bf16_t* Y = (bf16_t*)(p.ws + WS_Y);
    const size_t rowbase = (size_t)b * SEQ;
    const int qrow = 256 * qb + 32 * w + l31;
    bf16x8 Qf[8];
    { const bf16_t* qp = PROJ + (rowbase + qrow) * NP + COL_FQ + h * 128 + 8 * hh;
#pragma unroll
      for (int ks = 0; ks < 8; ++ks) Qf[ks] = *(const bf16x8*)(qp + 16 * ks); }
    bf16x8 Qone;
    { u32x4 o; o.x = hh ? 0u : 0x3F803F80u; o.y = hh ? 0u : 0x00003F80u; o.z = 0u; o.w = 0u; Qone = __builtin_bit_cast(bf16x8, o); }
    const int ntiles = 4 * (qb + 1), wlast = 4 * qb + (w >> 1);
    const bf16_t* ksrc[2]; const bf16_t* vsrc[2];
#pragma unroll
    for (int i = 0; i < 2; ++i) {
        const int krow = (w + 8 * i) * 4 + (lane >> 4), kch = (lane & 15) ^ (krow & 15);
        ksrc[i] = PROJ + (rowbase + krow) * NP + COL_FK + h * 128 + kch * 8;
        const int vrow = (w + 8 * i) * 8 + (lane >> 3), vch = (lane & 7) ^ ((vrow >> 1) & 7);
        vsrc[i] = VTF + (size_t)vrow * SEQ + vch * 8;
    }
#define ATT_ISSUE(tile, bufoff) do { LAS unsigned char* b_ = lds + (bufoff) + w * 1024; \
        _Pragma("unroll") for (int i_ = 0; i_ < 2; ++i_) { \
            __builtin_amdgcn_global_load_lds((const unsigned*)(ksrc[i_] + (size_t)(tile) * 64 * NP), (LAS unsigned*)(b_ + i_ * 8192), 16, 0, 0); \
            __builtin_amdgcn_global_load_lds((const unsigned*)(vsrc[i_] + (tile) * 64), (LAS unsigned*)(b_ + 16384 + i_ * 8192), 16, 0, 0); } } while (0)
    int kaddr[4], vaddr[4];
#pragma unroll
    for (int q = 0; q < 4; ++q) { kaddr[q] = l31 * 256 + (((2 * q + hh) ^ (l31 & 15)) << 4); vaddr[q] = l31 * 128 + (((2 * q + hh) ^ ((l31 >> 1) & 7)) << 4); }
    f32x16 O0 = {}, O1 = {}, O2 = {}, O3 = {};
    float mrun = -1e30f, lrun = 0.f;
    LAS float* cumL = (LAS float*)(lds + 98304);
    *(LAS f32x4*)(cumL + 4 * tid) = *(const f32x4*)(cum + 4 * tid);
    ATT_ISSUE(ntiles - 1, 0);
    if (ntiles > 1) ATT_ISSUE(ntiles - 2, 32768);
    __syncthreads();
    int bcur = 0, bnext2 = 65536;
    for (int it = 0; it < ntiles; ++it) {
        const int kt = ntiles - 1 - it;
        if (it + 1 < ntiles) asm volatile("s_waitcnt vmcnt(4)" ::: "memory"); else asm volatile("s_waitcnt vmcnt(0)" ::: "memory");
        __builtin_amdgcn_s_barrier(); asm volatile("" ::: "memory");
        if (it + 2 < ntiles) ATT_ISSUE(kt - 2, bnext2);
        LAS unsigned char* buf = lds + bcur;
        if (kt <= wlast) {
            const float cb0 = -cumL[64 * kt + l31], cb1 = -cumL[64 * kt + 32 + l31];
            f32x16 S0 = {}, S1 = {};
#pragma unroll
            for (int ks = 0; ks < 4; ++ks) {
                LAS unsigned char* kp_ = buf + kaddr[ks]; LAS unsigned char* kq_ = buf + (kaddr[ks] ^ 128);
                const bf16x8 A0 = *(const LAS bf16x8*)(kp_);
                const bf16x8 A1 = *(const LAS bf16x8*)(kp_ + 8192);
                const bf16x8 A2 = *(const LAS bf16x8*)(kq_);
                const bf16x8 A3 = *(const LAS bf16x8*)(kq_ + 8192);
                S0 = __builtin_amdgcn_mfma_f32_32x32x16_bf16(A0, Qf[ks], S0, 0, 0, 0);
                S1 = __builtin_amdgcn_mfma_f32_32x32x16_bf16(A1, Qf[ks], S1, 0, 0, 0);
                S0 = __builtin_amdgcn_mfma_f32_32x32x16_bf16(A2, Qf[ks + 4], S0, 0, 0, 0);
                S1 = __builtin_amdgcn_mfma_f32_32x32x16_bf16(A3, Qf[ks + 4], S1, 0, 0, 0);
            }
            {
                const unsigned h0 = f2bf(cb0); const float r0f = cb0 - bflo(h0); const unsigned m0 = f2bf(r0f); const unsigned l0 = f2bf(r0f - bflo(m0));
                const unsigned h1 = f2bf(cb1); const float r1f = cb1 - bflo(h1); const unsigned m1 = f2bf(r1f); const unsigned l1 = f2bf(r1f - bflo(m1));
                u32x4 a0 = {hh ? 0u : (h0 | (m0 << 16)), hh ? 0u : l0, 0u, 0u}, a1 = {hh ? 0u : (h1 | (m1 << 16)), hh ? 0u : l1, 0u, 0u};
                S0 = __builtin_amdgcn_mfma_f32_32x32x16_bf16(__builtin_bit_cast(bf16x8, a0), Qone, S0, 0, 0, 0);
                S1 = __builtin_amdgcn_mfma_f32_32x32x16_bf16(__builtin_bit_cast(bf16x8, a1), Qone, S1, 0, 0, 0);
            }
            if (kt == wlast) {
                const float NEG = -__builtin_inff();
                const int kb = 64 * kt + 4 * hh;
#pragma unroll
                for (int r = 0; r < 16; ++r) { const int key = kb + (r & 3) + 8 * (r >> 2); if (key > qrow) S0[r] = NEG; if (key + 32 > qrow) S1[r] = NEG; }
            }
            float mx = S0[0];
#pragma unroll
            for (int r = 1; r < 16; ++r) mx = fmaxf(mx, S0[r]);
#pragma unroll
            for (int r = 0; r < 16; ++r) mx = fmaxf(mx, S1[r]);
            mx = fmaxf(mx, __shfl_xor(mx, 32));
            if (!__all(mx - mrun < -160.0f)) {
                if (!__all(mx <= mrun)) {
                    const float mnew = fmaxf(mrun, mx);
                    const float alpha = __builtin_amdgcn_exp2f(mrun - mnew);
                    mrun = mnew; lrun *= alpha;
                    O0 = O0 * alpha; O1 = O1 * alpha; O2 = O2 * alpha; O3 = O3 * alpha;
                }
                float ps = 0.f;
#pragma unroll
                for (int r = 0; r < 16; ++r) { S0[r] = __builtin_amdgcn_exp2f(S0[r] - mrun); S1[r] = __builtin_amdgcn_exp2f(S1[r] - mrun); ps += S0[r] + S1[r]; }
                lrun += ps;
                const bf16x8 P00 = pack8(S0, 0), P01 = pack8(S0, 8), P10 = pack8(S1, 0), P11 = pack8(S1, 8);
                LAS unsigned char* vb = buf + 16384;
#define ATT_PVQ(q, PX) do { \
                const bf16x8 V0_ = *(const LAS bf16x8*)(vb + vaddr[q]), V1_ = *(const LAS bf16x8*)(vb + vaddr[q] + 4096), V2_ = *(const LAS bf16x8*)(vb + vaddr[q] + 8192), V3_ = *(const LAS bf16x8*)(vb + vaddr[q] + 12288); \
                O0 = __builtin_amdgcn_mfma_f32_32x32x16_bf16(V0_, PX, O0, 0, 0, 0); O1 = __builtin_amdgcn_mfma_f32_32x32x16_bf16(V1_, PX, O1, 0, 0, 0); \
                O2 = __builtin_amdgcn_mfma_f32_32x32x16_bf16(V2_, PX, O2, 0, 0, 0); O3 = __builtin_amdgcn_mfma_f32_32x32x16_bf16(V3_, PX, O3, 0, 0, 0); } while (0)
                ATT_PVQ(0, P00); ATT_PVQ(1, P01); ATT_PVQ(2, P10); ATT_PVQ(3, P11);
#undef ATT_PVQ
            }
        }
        bnext2 = bcur; bcur = (bcur == 65536) ? 0 : bcur + 32768;
    }
#undef ATT_ISSUE
    const float ltot = lrun + __shfl_xor(lrun, 32);
    const float inv = __builtin_amdgcn_rcpf(ltot);
    const size_t grow = rowbase + qrow;
    const bf16_t* zp = PROJ + grow * NP + COL_FZ + h * 128 + 4 * hh;
    bf16_t* yp = Y + grow * 3072 + 1024 + h * 128 + 4 * hh;
    u32x2 zz[16];
#pragma unroll
    for (int i = 0; i < 16; ++i) zz[i] = *(const u32x2*)(zp + 32 * (i >> 2) + 8 * (i & 3));
    asm volatile("" : "+v"(zz[0]), "+v"(zz[1]), "+v"(zz[2]), "+v"(zz[3]), "+v"(zz[4]), "+v"(zz[5]), "+v"(zz[6]), "+v"(zz[7]));
    asm volatile("" : "+v"(zz[8]), "+v"(zz[9]), "+v"(zz[10]), "+v"(zz[11]), "+v"(zz[12]), "+v"(zz[13]), "+v"(zz[14]), "+v"(zz[15]));
#define ATT_ST(OX, db) do { _Pragma("unroll") for (int g = 0; g < 4; ++g) { const u32x2 z = zz[4 * (db) + g]; u32x2 o; \
        o.x = pk2(OX[4 * g + 0] * inv * bflo(z.x), OX[4 * g + 1] * inv * bfhi(z.x)); o.y = pk2(OX[4 * g + 2] * inv * bflo(z.y), OX[4 * g + 3] * inv * bfhi(z.y)); \
        *(u32x2*)(yp + 32 * (db) + 8 * g) = o; } } while (0)
    ATT_ST(O0, 0); ATT_ST(O1, 1); ATT_ST(O2, 2); ATT_ST(O3, 3);
#undef ATT_ST
    __syncthreads();
}

__device__ __forceinline__ void ret_out_unit(const Params& p, int layer, int unit, int gq) {
    const int lane = tid_l() & 63, l31 = lane & 31, hh = lane >> 5;
    const int bh = unit >> 4, c = unit & 15, b = bh >> 3, h = bh & 7;
    const bf16_t* PROJ = (const bf16_t*)(p.ws + WS_PROJ);
    const bf16_t* VTR = (const bf16_t*)(p.ws + WS_VTR) + (size_t)bh * 128 * SEQ + c * 128;
    const bf16_t* SC = (const bf16_t*)(p.ws + WS_STATEC) + (size_t)unit * 16384;
    bf16_t* Y = (bf16_t*)(p.ws + WS_Y);
    const size_t tok0 = (size_t)b * SEQ + c * 128;
    const int ql = 32 * gq + l31;
    const float lg2 = log1pf(-exp2f(-5.0f - (float)h)) * LOG2E;
    bf16x8 Qf[8];
    { const bf16_t* qp = PROJ + (tok0 + ql) * NP + COL_RQ + h * 128 + 8 * hh;
#pragma unroll
      for (int ks = 0; ks < 8; ++ks) Qf[ks] = *(const bf16x8*)(qp + 16 * ks); }
    f32x16 O0 = {}, O1 = {}, O2 = {}, O3 = {};
#define PIN8(X) asm volatile("" : "+v"(X[0]), "+v"(X[1]), "+v"(X[2]), "+v"(X[3]), "+v"(X[4]), "+v"(X[5]), "+v"(X[6]), "+v"(X[7]))
    if (c > 0) {
        const bf16_t* sp = SC + (size_t)l31 * 128 + 8 * hh;
#pragma unroll
        for (int kh = 0; kh < 2; ++kh) {
            bf16x8 Fa[8], Fb[8];
#pragma unroll
            for (int k4 = 0; k4 < 4; ++k4) { const int ks = 4 * kh + k4;
                Fa[2 * k4] = *(const bf16x8*)(sp + 0 * 4096 + 16 * ks); Fa[2 * k4 + 1] = *(const bf16x8*)(sp + 1 * 4096 + 16 * ks);
                Fb[2 * k4] = *(const bf16x8*)(sp + 2 * 4096 + 16 * ks); Fb[2 * k4 + 1] = *(const bf16x8*)(sp + 3 * 4096 + 16 * ks); }
            PIN8(Fa); PIN8(Fb);
#pragma unroll
            for (int k4 = 0; k4 < 4; ++k4) { const int ks = 4 * kh + k4;
                O0 = __builtin_amdgcn_mfma_f32_32x32x16_bf16(Fa[2 * k4], Qf[ks], O0, 0, 0, 0);
                O1 = __builtin_amdgcn_mfma_f32_32x32x16_bf16(Fa[2 * k4 + 1], Qf[ks], O1, 0, 0, 0);
                O2 = __builtin_amdgcn_mfma_f32_32x32x16_bf16(Fb[2 * k4], Qf[ks], O2, 0, 0, 0);
                O3 = __builtin_amdgcn_mfma_f32_32x32x16_bf16(Fb[2 * k4 + 1], Qf[ks], O3, 0, 0, 0); }
        }
        const float xi = __builtin_amdgcn_exp2f(lg2 * (float)(ql + 1));
        O0 = O0 * xi; O1 = O1 * xi; O2 = O2 * xi; O3 = O3 * xi;
    }
    for (int kb = 0; kb <= gq; ++kb) {
        const bf16_t* kp = PROJ + (tok0 + 32 * kb + l31) * NP + COL_RK + h * 128 + 8 * hh;
        const bf16_t* vp = VTR + (size_t)l31 * SEQ + 32 * kb + 8 * hh;
        bf16x8 Kf[8], Vf[8];
#pragma unroll
        for (int ks = 0; ks < 8; ++ks) Kf[ks] = *(const bf16x8*)(kp + 16 * ks);
#pragma unroll
        for (int db = 0; db < 4; ++db) { Vf[2 * db] = *(const bf16x8*)(vp + (size_t)(32 * db) * SEQ); Vf[2 * db + 1] = *(const bf16x8*)(vp + (size_t)(32 * db) * SEQ + 16); }
        PIN8(Kf);
        f32x16 S = {};
#pragma unroll
        for (int ks = 0; ks < 8; ++ks) S = __builtin_amdgcn_mfma_f32_32x32x16_bf16(Kf[ks], Qf[ks], S, 0, 0, 0);
#pragma unroll
        for (int r = 0; r < 16; ++r) { const int key = 32 * kb + (r & 3) + 8 * (r >> 2) + 4 * hh; const int d = ql - key; S[r] = (d >= 0) ? S[r] * __builtin_amdgcn_exp2f(lg2 * (float)d) : 0.f; }
        const bf16x8 P0 = pack8(S, 0), P1 = pack8(S, 8);
        PIN8(Vf);
        O0 = __builtin_amdgcn_mfma_f32_32x32x16_bf16(Vf[0], P0, O0, 0, 0, 0); O1 = __builtin_amdgcn_mfma_f32_32x32x16_bf16(Vf[2], P0, O1, 0, 0, 0);
        O2 = __builtin_amdgcn_mfma_f32_32x32x16_bf16(Vf[4], P0, O2, 0, 0, 0); O3 = __builtin_amdgcn_mfma_f32_32x32x16_bf16(Vf[6], P0, O3, 0, 0, 0);
        O0 = __builtin_amdgcn_mfma_f32_32x32x16_bf16(Vf[1], P1, O0, 0, 0, 0); O1 = __builtin_amdgcn_mfma_f32_32x32x16_bf16(Vf[3], P1, O1, 0, 0, 0);
        O2 = __builtin_amdgcn_mfma_f32_32x32x16_bf16(Vf[5], P1, O2, 0, 0, 0); O3 = __builtin_amdgcn_mfma_f32_32x32x16_bf16(Vf[7], P1, O3, 0, 0, 0);
    }
#undef PIN8
    float s1 = 0.f;
#pragma unroll
    for (int r = 0; r < 16; ++r) s1 += (O0[r] + O1[r]) + (O2[r] + O3[r]);
    s1 += __shfl_xor(s1, 32);
    const float mean = s1 * (1.0f / 128.0f);
    float s2 = 0.f;
#pragma unroll
    for (int r = 0; r < 16; ++r) { const float a = O0[r] - mean, bq = O1[r] - mean, cq = O2[r] - mean, dq = O3[r] - mean; s2 += (a * a + bq * bq) + (cq * cq + dq * dq); }
    s2 += __shfl_xor(s2, 32);
    const float rstd = 1.0f / sqrtf(s2 * (1.0f / 128.0f) + EPS);
    const float* gn = p.ret_gn_g + (size_t)layer * 1024 + h * 128 + 4 * hh;
    const size_t grow = tok0 + ql;
    const bf16_t* zp = PROJ + grow * NP + COL_RZ + h * 128 + 4 * hh;
    bf16_t* yp = Y + grow * 3072 + h * 128 + 4 * hh;
    u32x2 zz[16];
#pragma unroll
    for (int i = 0; i < 16; ++i) zz[i] = *(const u32x2*)(zp + 32 * (i >> 2) + 8 * (i & 3));
    f32x4 gg[8];
#pragma unroll
    for (int i = 0; i < 8; ++i) gg[i] = *(const f32x4*)(gn + 32 * (i >> 2) + 8 * (i & 3));
    asm volatile("" : "+v"(zz[0]), "+v"(zz[1]), "+v"(zz[2]), "+v"(zz[3]), "+v"(zz[4]), "+v"(zz[5]), "+v"(zz[6]), "+v"(zz[7]));
    asm volatile("" : "+v"(zz[8]), "+v"(zz[9]), "+v"(zz[10]), "+v"(zz[11]), "+v"(zz[12]), "+v"(zz[13]), "+v"(zz[14]), "+v"(zz[15]));
    asm volatile("" : "+v"(gg[0]), "+v"(gg[1]), "+v"(gg[2]), "+v"(gg[3]), "+v"(gg[4]), "+v"(gg[5]), "+v"(gg[6]), "+v"(gg[7]));
#define RET_ST(OX, db, GG) do { _Pragma("unroll") for (int g = 0; g < 4; ++g) { const u32x2 z = zz[4 * (db) + g]; const f32x4 gq_ = GG[4 * ((db) & 1) + g]; u32x2 o; \
        o.x = pk2((OX[4 * g + 0] - mean) * rstd * gq_.x * bflo(z.x), (OX[4 * g + 1] - mean) * rstd * gq_.y * bfhi(z.x)); \
        o.y = pk2((OX[4 * g + 2] - mean) * rstd * gq_.z * bflo(z.y), (OX[4 * g + 3] - mean) * rstd * gq_.w * bfhi(z.y)); \
        *(u32x2*)(yp + 32 * (db) + 8 * g) = o; } } while (0)
    RET_ST(O0, 0, gg); RET_ST(O1, 1, gg);
#pragma unroll
    for (int i = 0; i < 8; ++i) gg[i] = *(const f32x4*)(gn + 64 + 32 * (i >> 2) + 8 * (i & 3));
    asm volatile("" : "+v"(gg[0]), "+v"(gg[1]), "+v"(gg[2]), "+v"(gg[3]), "+v"(gg[4]), "+v"(gg[5]), "+v"(gg[6]), "+v"(gg[7]));
    RET_ST(O2, 2, gg); RET_ST(O3, 3, gg);
#undef RET_ST
}

__device__ __forceinline__ void phase_c2(LAS unsigned char* lds, int layer) {
#if PHC2 & 1
    { const Params p = loadp(); int G, bx, vcu; geom(G, bx, vcu);
      for (int it = vcu; it < 256; it += G) { const int bh = it >> 2, i = it & 3; for (int k2 = 0; k2 < 2; ++k2) attn_block(p, lds, bh, k2 ? i : 7 - i); } }
#endif
#if PHC2 & 2
    { const Params p = loadp(); int G, bx, vcu; geom(G, bx, vcu); const int ly = launder_s(layer);
      const int wave = __builtin_amdgcn_readfirstlane(tid_l() >> 6);
      for (int it = vcu; it < 512; it += G) ret_out_unit(p, ly, 2 * it + (wave >> 2), wave & 3); }
#endif
    __syncthreads();
#if PHC2 & 4
    { const Params p = loadp(); int G, bx, vcu; geom(G, bx, vcu); const int ly = launder_s(layer);
      SchedPool S{(const bf16_t*)(p.ws + WS_POOLED), (const bf16_t*)(p.ws + WS_WPOOL), G, bx};
      EpiPool E{(const bf16_t*)(p.ws + WS_PROJ), (bf16_t*)(p.ws + WS_Y), p.pool_scale + (size_t)ly * 1024};
      pg8::gemm_phase<EpiPool, SchedPool>(lds, launder_s(256), 1024, 256, S, E); }
#endif
}

__device__ __forceinline__ void phase_final() {
    const Params p = loadp(); int G, bx, vcu; geom(G, bx, vcu);
    const int tid = tid_l(), lane = tid & 63, wave = tid >> 6;
    const int gw = vcu * NWAVES + wave, NGW = G * NWAVES;
    f32x4 gfin[8];
#pragma unroll
    for (int j = 0; j < 8; ++j) gfin[j] = *((const f32x4*)p.final_g + lane + 64 * j);
    f32x4 vn[8];
    if (gw < M) {
#pragma unroll
        for (int j = 0; j < 8; ++j) vn[j] = *((const f32x4*)(p.out + (size_t)gw * DM) + lane + 64 * j);
    }
    for (int m = gw; m < M; m += NGW) {
        f32x4* xr = (f32x4*)(p.out + (size_t)m * DM) + lane;
        f32x4 v[8]; float ss = 0.f;
#pragma unroll
        for (int j = 0; j < 8; ++j) { v[j] = vn[j]; ss += (v[j].x * v[j].x + v[j].y * v[j].y) + (v[j].z * v[j].z + v[j].w * v[j].w); }
        if (m + NGW < M) {
#pragma unroll
            for (int j = 0; j < 8; ++j) vn[j] = *((const f32x4*)(p.out + (size_t)(m + NGW) * DM) + lane + 64 * j);
        }
        const float rstd = 1.0f / sqrtf(wave_sum(ss) * (1.0f / DM) + EPS);
#pragma unroll
        for (int j = 0; j < 8; ++j) xr[64 * j] = v[j] * rstd * gfin[j];
    }
}

__global__ void __launch_bounds__(NTHREADS, 2) hybrid_fwd(Params p_unused) {
    extern __shared__ __attribute__((aligned(16))) unsigned char lds_raw[];
    LAS unsigned char* lds = (LAS unsigned char*)lds_raw;
    cg::grid_group grid = cg::this_grid();
    if (gridDim.y == 0x7fffffffu) grid.sync();
    if (threadIdx.x < 16) ((volatile LAS unsigned*)(lds + LDS_BARST))[threadIdx.x] = 0u;
    __syncthreads();
    (void)xcd_barrier_post((unsigned*)(loadp().ws + WS_BAR), (volatile LAS unsigned*)(lds + LDS_BARST));
#define GSYNC() do { XcdBarrier b_; b_.bar = (unsigned*)(loadp().ws + WS_BAR); b_.x = xb_xcc_id(); b_.st = (volatile LAS unsigned*)(lds + LDS_BARST); xcd_barrier(b_); } while (0)
#pragma unroll 1
    for (int layer = 0; layer < DEPTH; ++layer) {
#if PHM & 1
        phase_a(lds, layer);
#if REPM & 1
        GSYNC(); phase_a(lds, layer);
#endif
#endif
        GSYNC();
#if PHM & 2
        {
            const Params p = loadp(); int G, bx, vcu; geom(G, bx, vcu);
            SchedProj S{(const bf16_t*)(p.ws + WS_H), (const bf16_t*)(p.ws + WS_WIN), DM, DM, 64, 64, G, bx};
            EpiProj E{(bf16_t*)(p.ws + WS_PROJ), (const float*)(p.ws + WS_ROPE)};
            pg8::gemm_phase<EpiProj, SchedProj>(lds, DM, DM, DM, S, E);
        }
#endif
        GSYNC();
#if PHM & 4
        phase_c1(lds, layer);
#if REPM & 4
        GSYNC(); phase_c1(lds, layer);
#endif
#endif
        GSYNC();
#if PHM & 8
        phase_c1b();
#endif
        GSYNC();
#if PHM & 16
        phase_c2(lds, layer);
#if REPM & 16
        GSYNC(); phase_c2(lds, layer);
#endif
#endif
        GSYNC();
#if PHM & 32
        {
            const Params p = loadp(); int G, bx, vcu; geom(G, bx, vcu);
            SchedMerge S{(const bf16_t*)(p.ws + WS_Y), (const bf16_t*)(p.ws + WS_WBR), G, bx};
            EpiMerge E{(const bf16_t*)(p.ws + WS_PROJ), (bf16_t*)(p.ws + WS_H)};
            pg8::gemm_phase<EpiMerge, SchedMerge>(lds, 1024, 3072, 1024, S, E);
        }
#endif
        GSYNC();
#if PHM & 64
        {
            const Params p = loadp(); int G, bx, vcu; geom(G, bx, vcu); const int ly = launder_s(layer);
            SchedPlain S{(const bf16_t*)(p.ws + WS_H), (const bf16_t*)(p.ws + WS_WOUT), DM, DM, 64, 8, G, bx};
            EpiOut E{sel_ptr(p.x, p.out, ly), p.out};
            pg8::gemm_phase<EpiOut, SchedPlain>(lds, DM, DM, DM, S, E);
        }
#endif
        GSYNC();
    }
#if PHM & 128
    phase_final();
#endif
}

extern "C" void kernel_launch(void* const* d_in, const int* in_sizes, int n_in, void* d_out, int out_size, void* d_ws, size_t ws_size, hipStream_t stream) {
    static int grid_blocks = 0;
    if (!grid_blocks) {
        int dev = 0, cus = 0, per_cu = 0;
        hipGetDevice(&dev);
        hipDeviceGetAttribute(&cus, hipDeviceAttributeMultiprocessorCount, dev);
        hipFuncSetAttribute((const void*)hybrid_fwd, hipFuncAttributeMaxDynamicSharedMemorySize, LDS_BYTES);
        hipOccupancyMaxActiveBlocksPerMultiprocessor(&per_cu, (const void*)hybrid_fwd, NTHREADS, LDS_BYTES);
        if (per_cu < 1) per_cu = 1;
        grid_blocks = cus * 1;
        if (ws_size < WS_END) fprintf(stderr, "kernel_launch: workspace too small: %zu < %zu\n", ws_size, (size_t)WS_END);
    }
    Params p{};
    p.x = (const float*)d_in[0]; p.norm_g = (const float*)d_in[1]; p.w_in = (const float*)d_in[2]; p.ret_gn_g = (const float*)d_in[3]; p.fox_b_f = (const float*)d_in[4];
    p.pool_w = (const float*)d_in[5]; p.pool_scale = (const float*)d_in[6]; p.w_ret = (const float*)d_in[7]; p.w_fox = (const float*)d_in[8]; p.w_pool = (const float*)d_in[9];
    p.w_out = (const float*)d_in[10]; p.final_g = (const float*)d_in[11];
    p.out = (float*)d_out; p.ws = (unsigned char*)d_ws;
    (void)hipMemsetAsync((char*)d_ws + WS_BAR, 0, XCD_BAR_WORDS * sizeof(unsigned), stream);
    void* args[] = {&p};
    hipError_t e = hipLaunchCooperativeKernel((const void*)hybrid_fwd, dim3(grid_blocks), dim3(NTHREADS), args, LDS_BYTES, stream);
    if (e != hipSuccess) fprintf(stderr, "cooperative launch failed: %s (grid %d)\n", hipGetErrorString(e), grid_blocks);
}
```

```cpp
#include <hip/hip_runtime.h>
#include <hip/hip_cooperative_groups.h>
#include <cstdio>
#include <cstdint>
namespace cg = cooperative_groups;
#ifndef PHM
#define PHM 255
#endif
#ifndef PHC2
#define PHC2 7
#endif
#ifndef REPM
#define REPM 0
#endif

#define LAS __attribute__((address_space(3)))
typedef unsigned short bf16_t;
typedef short bf16x8 __attribute__((ext_vector_type(8)));
typedef float f32x4 __attribute__((ext_vector_type(4)));
typedef float f32x16 __attribute__((ext_vector_type(16)));
typedef unsigned u32x4 __attribute__((ext_vector_type(4)));
typedef unsigned u32x2 __attribute__((ext_vector_type(2)));

constexpr int BATCH = 8, SEQ = 2048, DM = 2048, M = BATCH * SEQ, NH = 8, CIN = 16392, NP = 16384, DEPTH = 2;
constexpr int COL_RQ = 0, COL_RK = 1024, COL_RV = 2048, COL_RZ = 3072, COL_FQ = 4096, COL_FK = 5120, COL_FV = 6144, COL_FZ = 7168,
              COL_PU = 8192, COL_PZ = 9216, COL_GA = 10240, COL_GB = 12288, COL_GC = 14336;
constexpr float EPS = 1e-6f, LOG2E = 1.4426950408889634f;
constexpr int NWAVES = 8, NTHREADS = 512;
constexpr int LDS_BYTES = 147456;
constexpr int LDS_BARST = LDS_BYTES - 64;

constexpr size_t MiB = 1u << 20;
constexpr size_t WS_LSIG = 0;
constexpr size_t WS_CUM = MiB / 2;
constexpr size_t WS_ROPE = 1 * MiB;
constexpr size_t WS_WPOOL = 2 * MiB;
constexpr size_t WS_BAR = 3 * MiB;
constexpr size_t WS_WOUT = 4 * MiB;
constexpr size_t WS_WBR = 12 * MiB;
constexpr size_t WS_WIN = 24 * MiB;
constexpr size_t WS_H = 88 * MiB;
constexpr size_t WS_PROJ = 152 * MiB;
constexpr size_t WS_Y = 664 * MiB;
constexpr size_t WS_STATE = 760 * MiB;
constexpr size_t WS_STATEC = 824 * MiB;
constexpr size_t WS_POOLED = 856 * MiB;
constexpr size_t WS_VTF = 888 * MiB;
constexpr size_t WS_VTR = 920 * MiB;
constexpr size_t WS_END = 952 * MiB;

__device__ __forceinline__ unsigned f2bf(float f) { unsigned u = __builtin_bit_cast(unsigned, f); return (u + 0x7fffu + ((u >> 16) & 1u)) >> 16; }
typedef float f32x2 __attribute__((ext_vector_type(2)));
typedef __bf16 hwbf16x2 __attribute__((ext_vector_type(2)));
__device__ __forceinline__ unsigned pk2(float lo, float hi) { const f32x2 v = {lo, hi}; const hwbf16x2 b = __builtin_convertvector(v, hwbf16x2); return __builtin_bit_cast(unsigned, b); }
__device__ __forceinline__ float bflo(unsigned w) { return __builtin_bit_cast(float, w << 16); }
__device__ __forceinline__ float bfhi(unsigned w) { return __builtin_bit_cast(float, w & 0xffff0000u); }
__device__ __forceinline__ float wave_sum(float v) {
#pragma unroll
    for (int o = 1; o < 64; o <<= 1) v += __shfl_xor(v, o);
    return v;
}
__device__ __forceinline__ float fast_sigmoid(float x) { return __builtin_amdgcn_rcpf(1.0f + __builtin_amdgcn_exp2f(-x * LOG2E)); }
__device__ __forceinline__ float fast_silu(float x) { return x * fast_sigmoid(x); }
#define LDS_WAIT() asm volatile("s_waitcnt lgkmcnt(0)" ::: "memory")
__device__ __forceinline__ int tid_l() { int t = threadIdx.x; asm volatile("" : "+v"(t)); return t; }

namespace pg8 {
constexpr int BM = 256, BK = 64, HALF = 128, HTB = HALF * BK * 2, STAGE_BYTES = 8 * HTB, NXCD = 8, WGM = 8;
__device__ __forceinline__ int lds_byte(int r, int c) { const int st = (r >> 4) * 2 + (c >> 5), rr = r & 15, cc = c & 31, ob = rr * 64 + cc * 2; return st * 1024 + (ob ^ (((ob >> 9) & 1) << 5)); }
__device__ __forceinline__ void stage_rc(int b, int& R, int& C) { const int st = b / 1024, sb = b % 1024, swz = sb ^ (((sb >> 9) & 1) << 5); R = (st >> 1) * 16 + swz / 64; C = (st & 1) * 32 + (swz % 64) / 2; }
__device__ __forceinline__ int perm32(int rho) { const int n = rho >> 4, i = rho & 15; return 8 * (i >> 2) + 4 * n + (i & 3); }

struct Unit { int pm, pn, aux; };

__device__ __forceinline__ void tile_of(int L, int nM, int nN, int& pm, int& pn) {
    const int nwg = nM * nN; int wgid = L;
    { const int q = nwg / NXCD, r = nwg % NXCD, xcd = wgid % NXCD, off = wgid / NXCD; wgid = (xcd < r ? xcd * (q + 1) : r * (q + 1) + (xcd - r) * q) + off; }
    const int nig = WGM * nN, gid = wgid / nig, fm = gid * WGM, gsz = (nM - fm) < WGM ? (nM - fm) : WGM;
    pm = fm + ((wgid % nig) % gsz); pn = (wgid % nig) / gsz;
}

template <class Epi, class Sched>
__device__ __forceinline__ void gemm_phase(LAS unsigned char* lds, const int K, const int lda, const int ldb, const Sched& S, const Epi& E) {
    const int tid = tid_l(), wid = __builtin_amdgcn_readfirstlane(tid >> 6), lane = tid & 63, wr = wid >> 2, wc = wid & 3, fr = lane & 15, fq = lane >> 4;
    const int nt = K / BK;
    unsigned voffA[2], voffB[2];
#pragma unroll
    for (int i = 0; i < 2; ++i) { int R, C; stage_rc(tid * 16 + i * 8192, R, C); const int Rb = Epi::PERM ? ((R & ~31) + perm32(R & 31)) : R;
        voffA[i] = (unsigned)(R * lda + C) * 2u; voffB[i] = (unsigned)(Rb * ldb + C) * 2u; }
    const size_t kstep = (size_t)(BK * 2);
    const size_t hstepA = (size_t)HALF * lda * 2, hstepB = (size_t)HALF * ldb * 2;
    const unsigned ldsw = (unsigned)wid * 1024u;
    const int aoff = lds_byte(wr * 64 + fr, fq * 8), boff = lds_byte(wc * 32 + fr, fq * 8);
#define PG8_SA(b, h) (((b) * 2 + (h)) * HTB)
#define PG8_SB(b, h) ((4 + (b) * 2 + (h)) * HTB)
#define PG8_STAGE(bufoff, gbase, voff) do { _Pragma("unroll") for (int _i = 0; _i < 2; ++_i) \
        __builtin_amdgcn_global_load_lds((const unsigned*)((const char*)(gbase) + (voff)[_i]), (LAS unsigned*)(lds + (bufoff) + ldsw + _i * 8192), 16, 0, 0); } while (0)
#define PG8_LDA(dst, b, h) do { _Pragma("unroll") for (int m = 0; m < 4; ++m) _Pragma("unroll") for (int k = 0; k < 2; ++k) dst[m][k] = *(const LAS bf16x8*)(lds + PG8_SA(b, h) + aoff + m * 2048 + k * 1024); } while (0)
#define PG8_LDB(dst, b, h) do { _Pragma("unroll") for (int n = 0; n < 2; ++n) _Pragma("unroll") for (int k = 0; k < 2; ++k) dst[n][k] = *(const LAS bf16x8*)(lds + PG8_SB(b, h) + boff + n * 2048 + k * 1024); } while (0)
#define PG8_MMA(ai, bj, At, Bt) do { __builtin_amdgcn_s_setprio(1); _Pragma("unroll") for (int m = 0; m < 4; ++m) _Pragma("unroll") for (int n = 0; n < 2; ++n) _Pragma("unroll") for (int k = 0; k < 2; ++k) \
        acc[ai][bj][m][n] = __builtin_amdgcn_mfma_f32_16x16x32_bf16(Bt[n][k], At[m][k], acc[ai][bj][m][n], 0, 0, 0); __builtin_amdgcn_s_setprio(0); } while (0)
#define PG8_WAIT_V(n) asm volatile("s_waitcnt vmcnt(" #n ")" ::: "memory")
#define PG8_WAIT_L(n) asm volatile("s_waitcnt lgkmcnt(" #n ")" ::: "memory")
#define PG8_BAR __builtin_amdgcn_s_barrier()
#define PG8_SCHED __builtin_amdgcn_sched_barrier(0)
    Unit cur, nxt; int ui = 0;
    if (!S.next(0, cur)) return;
    f32x4 acc[2][2][4][2];
#pragma unroll
    for (int a = 0; a < 2; ++a)
#pragma unroll
        for (int b = 0; b < 2; ++b)
#pragma unroll
            for (int m = 0; m < 4; ++m)
#pragma unroll
                for (int n = 0; n < 2; ++n) acc[a][b][m][n] = (f32x4){0.f, 0.f, 0.f, 0.f};
    bf16x8 At[4][2], B0[2][2], B1[2][2];
    const char* cA = S.a_ptr(cur); const char* cB = S.b_ptr(cur);
    PG8_STAGE(PG8_SB(0, 0), cB, voffB); PG8_STAGE(PG8_SB(0, 1), cB + hstepB, voffB); PG8_STAGE(PG8_SA(0, 0), cA, voffA); PG8_STAGE(PG8_SA(0, 1), cA + hstepA, voffA);
    if (wr == 1) PG8_BAR;
    PG8_WAIT_V(2); PG8_BAR;
    PG8_STAGE(PG8_SB(1, 0), cB + kstep, voffB); PG8_STAGE(PG8_SA(1, 0), cA + kstep, voffA); PG8_STAGE(PG8_SB(1, 1), cB + hstepB + kstep, voffB);
    PG8_WAIT_V(6); PG8_BAR;
    for (;;) {
        const bool has_next = S.next(ui + 1, nxt);
        const char* nA = has_next ? S.a_ptr(nxt) : cA; const char* nB = has_next ? S.b_ptr(nxt) : cB;
        for (int t = 0; t < nt; t += 2) {
            const bool last = (t == nt - 2);
            const char* a1 = cA + (size_t)(t + 1) * kstep;
            const char* a2 = last ? nA : cA + (size_t)(t + 2) * kstep; const char* b2 = last ? nB : cB + (size_t)(t + 2) * kstep;
            const char* a3 = a2 + kstep; const char* b3 = b2 + kstep;
            PG8_LDB(B0, 0, 0); PG8_LDB(B1, 0, 1); PG8_SCHED; PG8_LDA(At, 0, 0); PG8_STAGE(PG8_SA(1, 1), a1 + hstepA, voffA);
            PG8_WAIT_V(8); PG8_WAIT_L(0); PG8_BAR; PG8_MMA(0, 0, At, B0); PG8_MMA(0, 1, At, B1); PG8_BAR; PG8_SCHED;
            PG8_LDA(At, 0, 1); PG8_STAGE(PG8_SB(0, 0), b2, voffB); PG8_STAGE(PG8_SB(0, 1), b2 + hstepB, voffB); PG8_STAGE(PG8_SA(0, 0), a2, voffA);
            PG8_WAIT_V(8); PG8_WAIT_L(0); PG8_BAR; PG8_MMA(1, 0, At, B0); PG8_MMA(1, 1, At, B1); PG8_BAR; PG8_SCHED;
            PG8_LDB(B0, 1, 0); PG8_LDB(B1, 1, 1); PG8_SCHED; PG8_LDA(At, 1, 0); PG8_STAGE(PG8_SA(0, 1), a2 + hstepA, voffA);
            PG8_WAIT_V(8); PG8_WAIT_L(0); PG8_BAR; PG8_MMA(0, 0, At, B0); PG8_MMA(0, 1, At, B1); PG8_BAR; PG8_SCHED;
            PG8_LDA(At, 1, 1); PG8_STAGE(PG8_SB(1, 0), b3, voffB); PG8_STAGE(PG8_SB(1, 1), b3 + hstepB, voffB); PG8_STAGE(PG8_SA(1, 0), a3, voffA);
            PG8_WAIT_V(8); PG8_WAIT_L(0); PG8_BAR; PG8_MMA(1, 0, At, B0); PG8_MMA(1, 1, At, B1); PG8_BAR; PG8_SCHED;
        }
        if (wr == 0) PG8_BAR;
        const bool zero = E(acc, cur, wr, wc, fr, fq);
        if (!has_next) break;
        if (zero) {
#pragma unroll
            for (int a = 0; a < 2; ++a)
#pragma unroll
                for (int b = 0; b < 2; ++b)
#pragma unroll
                    for (int m = 0; m < 4; ++m)
#pragma unroll
                        for (int n = 0; n < 2; ++n) acc[a][b][m][n] = (f32x4){0.f, 0.f, 0.f, 0.f};
        }
        cur = nxt; cA = nA; cB = nB; ++ui;
        if (wr == 1) PG8_BAR;
    }
    PG8_WAIT_V(0);
    PG8_BAR;
#undef PG8_SA
#undef PG8_SB
#undef PG8_STAGE
#undef PG8_LDA
#undef PG8_LDB
#undef PG8_MMA
#undef PG8_WAIT_V
#undef PG8_WAIT_L
#undef PG8_BAR
#undef PG8_SCHED
}
}
using pg8::Unit;

struct SchedPlain {
    const bf16_t* A; const bf16_t* Bt; int lda, ldb, nM, nN, G, c;
    __device__ __forceinline__ bool next(int i, Unit& u) const { const int L = i * G + c; if (L >= nM * nN) return false; pg8::tile_of(L, nM, nN, u.pm, u.pn); u.aux = 0; return true; }
    __device__ __forceinline__ const char* a_ptr(const Unit& u) const { return (const char*)(A + (size_t)u.pm * 256 * lda); }
    __device__ __forceinline__ const char* b_ptr(const Unit& u) const { return (const char*)(Bt + (size_t)u.pn * 256 * ldb); }
};
struct SchedProj {
    const bf16_t* A; const bf16_t* Bt; int lda, ldb, nM, nN, G, c;
    __device__ __forceinline__ bool next(int i, Unit& u) const {
        if (G != 256) { const int L = i * G + c; if (L >= nM * nN) return false; pg8::tile_of(L, nM, nN, u.pm, u.pn); u.aux = 0; return true; }
        if (i >= 16) return false;
        const int x = c & 7; u.pm = 8 * x + ((c >> 3) & 7); u.pn = 4 * ((i + 2 * x) & 15) + (c >> 6); u.aux = 0; return true; }
    __device__ __forceinline__ const char* a_ptr(const Unit& u) const { return (const char*)(A + (size_t)u.pm * 256 * lda); }
    __device__ __forceinline__ const char* b_ptr(const Unit& u) const { return (const char*)(Bt + (size_t)u.pn * 256 * ldb); }
};
struct SchedMerge {
    const bf16_t* Y; const bf16_t* W; int G, c;
    __device__ __forceinline__ bool next(int i, Unit& u) const { const int j = i / 3, br = i - 3 * j; const int L = j * G + c; if (L >= 512) return false; pg8::tile_of(L, 64, 8, u.pm, u.pn); u.aux = br; return true; }
    __device__ __forceinline__ const char* a_ptr(const Unit& u) const { return (const char*)(Y + (size_t)u.pm * 256 * 3072 + u.aux * 1024); }
    __device__ __forceinline__ const char* b_ptr(const Unit& u) const { return (const char*)(W + (size_t)u.aux * 2048 * 1024 + (size_t)u.pn * 256 * 1024); }
};
struct SchedPool {
    const bf16_t* P; const bf16_t* W; int G, c;
    __device__ __forceinline__ bool next(int i, Unit& u) const { const int L = i * G + c; if (L >= 256) return false; u.pm = L >> 2; u.pn = L & 3; u.aux = 0; return true; }
    __device__ __forceinline__ const char* a_ptr(const Unit& u) const { return (const char*)(P + (size_t)u.pm * 256 * 1024 + u.pn * 256); }
    __device__ __forceinline__ const char* b_ptr(const Unit& u) const { return (const char*)(W + (size_t)u.pn * 65536); }
};

struct EpiProj {
    static constexpr bool PERM = true;
    bf16_t* P; const float* rope;
    __device__ __forceinline__ bool operator()(f32x4 (&acc)[2][2][4][2], const Unit& u, int wr, int wc, int fr, int fq) const {
        asm volatile("" : "+v"(fr), "+v"(fq));
        const int row0 = u.pm * 256 + wr * 64 + fr, col0 = u.pn * 256 + wc * 32 + 8 * fq;
        const int pn = u.pn;
        int mode;
        if (pn < 4) mode = 3; else if (pn < 8) mode = 4; else if (pn < 12) mode = 0; else if (pn < 16) mode = 1; else if (pn < 20) mode = 5; else if (pn < 28) mode = 0;
        else if (pn < 32) mode = 1; else if (pn < 36) mode = 0; else if (pn < 40) mode = 1; else mode = 2;
        const int j0 = wc * 16 + 4 * fq;
#pragma unroll
        for (int ai = 0; ai < 2; ++ai) {
            f32x4 csa[4], csb[4];
#pragma unroll
            for (int m = 0; m < 4; ++m) { csa[m] = (f32x4){1.f, 0.f, 1.f, 0.f}; csb[m] = csa[m]; }
            if (mode == 3 || mode == 4) {
#pragma unroll
                for (int m = 0; m < 4; ++m) { const float* tp = rope + ((size_t)((row0 + ai * 128 + m * 16) & (SEQ - 1)) * 64 + j0) * 2; csa[m] = *(const f32x4*)tp; csb[m] = *(const f32x4*)(tp + 4); }
                asm volatile("" : "+v"(csa[0]), "+v"(csa[1]), "+v"(csa[2]), "+v"(csa[3]), "+v"(csb[0]), "+v"(csb[1]), "+v"(csb[2]), "+v"(csb[3]));
            }
#pragma unroll
            for (int m = 0; m < 4; ++m) {
                const int row = row0 + ai * 128 + m * 16;
                bf16_t* rowp = P + (size_t)row * NP + col0;
                const f32x4 cs0 = csa[m], cs1 = csb[m];
#pragma unroll
                for (int bj = 0; bj < 2; ++bj) {
                    f32x4 v0 = acc[ai][bj][m][0], v1 = acc[ai][bj][m][1];
                    if (mode == 1) {
#pragma unroll
                        for (int j = 0; j < 4; ++j) { v0[j] = fast_silu(v0[j]); v1[j] = fast_silu(v1[j]); }
                    } else if (mode == 2) {
#pragma unroll
                        for (int j = 0; j < 4; ++j) { v0[j] = fast_sigmoid(fminf(fmaxf(v0[j], -60.f), 60.f)); v1[j] = fast_sigmoid(fminf(fmaxf(v1[j], -60.f), 60.f)); }
                    } else if (mode == 3 || mode == 4) {
                        const float sc = (mode == 4) ? 0.08838834764831845f : 1.0f;
                        f32x4 o0, o1;
                        o0[0] = (v0[0] * cs0[0] - v0[1] * cs0[1]) * sc; o0[1] = (v0[0] * cs0[1] + v0[1] * cs0[0]) * sc;
                        o0[2] = (v0[2] * cs0[2] - v0[3] * cs0[3]) * sc; o0[3] = (v0[2] * cs0[3] + v0[3] * cs0[2]) * sc;
                        o1[0] = (v1[0] * cs1[0] - v1[1] * cs1[1]) * sc; o1[1] = (v1[0] * cs1[1] + v1[1] * cs1[0]) * sc;
                        o1[2] = (v1[2] * cs1[2] - v1[3] * cs1[3]) * sc; o1[3] = (v1[2] * cs1[3] + v1[3] * cs1[2]) * sc;
                        v0 = o0; v1 = o1;
                    } else if (mode == 5) { v0 = v0 * (0.08838834764831845f * LOG2E); v1 = v1 * (0.08838834764831845f * LOG2E); }
                    u32x4 w; w.x = pk2(v0[0], v0[1]); w.y = pk2(v0[2], v0[3]); w.z = pk2(v1[0], v1[1]); w.w = pk2(v1[2], v1[3]);
                    *(u32x4*)(rowp + bj * 128) = w;
                }
            }
        }
        return true;
    }
};
struct EpiPool {
    static constexpr bool PERM = true;
    const bf16_t* P; bf16_t* Y; const float* scale;
    __device__ __forceinline__ bool operator()(f32x4 (&acc)[2][2][4][2], const Unit& u, int wr, int wc, int fr, int fq) const {
        asm volatile("" : "+v"(fr), "+v"(fq));
        const int row0 = u.pm * 256 + wr * 64 + fr, col0 = u.pn * 256 + wc * 32 + 8 * fq;
        f32x4 sc[2][2];
#pragma unroll
        for (int bj = 0; bj < 2; ++bj) { sc[bj][0] = *(const f32x4*)(scale + col0 + bj * 128); sc[bj][1] = *(const f32x4*)(scale + col0 + bj * 128 + 4); }
#pragma unroll
        for (int ai = 0; ai < 2; ++ai) {
            u32x4 z[4][2];
#pragma unroll
            for (int m = 0; m < 4; ++m)
#pragma unroll
                for (int bj = 0; bj < 2; ++bj) z[m][bj] = *(const u32x4*)((const char*)P + (unsigned)(((row0 + ai * 128 + m * 16) * NP + COL_PZ + col0 + bj * 128) * 2));
            asm volatile("" : "+v"(z[0][0]), "+v"(z[0][1]), "+v"(z[1][0]), "+v"(z[1][1]), "+v"(z[2][0]), "+v"(z[2][1]), "+v"(z[3][0]), "+v"(z[3][1]));
#pragma unroll
            for (int m = 0; m < 4; ++m)
#pragma unroll
                for (int bj = 0; bj < 2; ++bj) {
                    const u32x4 zz = z[m][bj];
                    const f32x4 v0 = acc[ai][bj][m][0] * sc[bj][0], v1 = acc[ai][bj][m][1] * sc[bj][1];
                    u32x4 w; w.x = pk2(v0[0] * bflo(zz.x), v0[1] * bfhi(zz.x)); w.y = pk2(v0[2] * bflo(zz.y), v0[3] * bfhi(zz.y));
                    w.z = pk2(v1[0] * bflo(zz.z), v1[1] * bfhi(zz.z)); w.w = pk2(v1[2] * bflo(zz.w), v1[3] * bfhi(zz.w));
                    *(u32x4*)((char*)Y + (unsigned)(((row0 + ai * 128 + m * 16) * 3072 + 2048 + col0 + bj * 128) * 2)) = w;
                }
        }
        return true;
    }
};
struct EpiMerge {
    static constexpr bool PERM = true;
    const bf16_t* P; bf16_t* O;
    __device__ __forceinline__ bool operator()(f32x4 (&acc)[2][2][4][2], const Unit& u, int wr, int wc, int fr, int fq) const {
        asm volatile("" : "+v"(fr), "+v"(fq));
        const int row0 = u.pm * 256 + wr * 64 + fr, col0 = u.pn * 256 + wc * 32 + 8 * fq;
        const int br = u.aux;
        const int cnum = (br == 0) ? COL_GA : (br == 1) ? COL_GB : COL_GC;
        const int cden = (br == 0) ? COL_GB : COL_GC;
#pragma unroll
        for (int ai = 0; ai < 2; ++ai)
#pragma unroll
            for (int mp = 0; mp < 2; ++mp) {
                u32x4 gn[2][2], gd[2][2];
#pragma unroll
                for (int mm = 0; mm < 2; ++mm)
#pragma unroll
                    for (int bj = 0; bj < 2; ++bj) { const bf16_t* prow = P + (size_t)(row0 + ai * 128 + (2 * mp + mm) * 16) * NP + col0 + bj * 128;
                        gn[mm][bj] = *(const u32x4*)(prow + cnum); gd[mm][bj] = *(const u32x4*)(prow + cden); }
                asm volatile("" : "+v"(gn[0][0]), "+v"(gn[0][1]), "+v"(gn[1][0]), "+v"(gn[1][1]), "+v"(gd[0][0]), "+v"(gd[0][1]), "+v"(gd[1][0]), "+v"(gd[1][1]));
#pragma unroll
                for (int mm = 0; mm < 2; ++mm)
#pragma unroll
                    for (int bj = 0; bj < 2; ++bj) {
                        const int m = 2 * mp + mm; const u32x4 g = gn[mm][bj], d = gd[mm][bj];
                        f32x4 f0 = (f32x4){bflo(g.x), bfhi(g.x), bflo(g.y), bfhi(g.y)}, f1 = (f32x4){bflo(g.z), bfhi(g.z), bflo(g.w), bfhi(g.w)};
                        if (br < 2) {
                            f0[0] *= __builtin_amdgcn_rcpf(bflo(d.x)); f0[1] *= __builtin_amdgcn_rcpf(bfhi(d.x)); f0[2] *= __builtin_amdgcn_rcpf(bflo(d.y)); f0[3] *= __builtin_amdgcn_rcpf(bfhi(d.y));
                            f1[0] *= __builtin_amdgcn_rcpf(bflo(d.z)); f1[1] *= __builtin_amdgcn_rcpf(bfhi(d.z)); f1[2] *= __builtin_amdgcn_rcpf(bflo(d.w)); f1[3] *= __builtin_amdgcn_rcpf(bfhi(d.w));
                        }
                        acc[ai][bj][m][0] = acc[ai][bj][m][0] * f0; acc[ai][bj][m][1] = acc[ai][bj][m][1] * f1;
                        if (br == 2) {
                            const f32x4 v0 = acc[ai][bj][m][0], v1 = acc[ai][bj][m][1];
                            u32x4 w; w.x = pk2(v0[0], v0[1]); w.y = pk2(v0[2], v0[3]); w.z = pk2(v1[0], v1[1]); w.w = pk2(v1[2], v1[3]);
                            *(u32x4*)(O + (size_t)(row0 + ai * 128 + m * 16) * DM + col0 + bj * 128) = w;
                        }
                    }
            }
        return br == 2;
    }
};
struct EpiOut {
    static constexpr bool PERM = false;
    const float* xin; float* xout;
    __device__ __forceinline__ bool operator()(f32x4 (&acc)[2][2][4][2], const Unit& u, int wr, int wc, int fr, int fq) const {
        asm volatile("" : "+v"(fr), "+v"(fq));
        const int row0 = u.pm * 256 + wr * 64 + fr, col0 = u.pn * 256 + wc * 32 + 4 * fq;
#pragma unroll
        for (int ai = 0; ai < 2; ++ai)
#pragma unroll
            for (int mp = 0; mp < 2; ++mp) {
                f32x4 xo[2][2][2];
#pragma unroll
                for (int mm = 0; mm < 2; ++mm)
#pragma unroll
                    for (int bj = 0; bj < 2; ++bj)
#pragma unroll
                        for (int n = 0; n < 2; ++n) xo[mm][bj][n] = *(const f32x4*)(xin + (size_t)(row0 + ai * 128 + (2 * mp + mm) * 16) * DM + col0 + bj * 128 + n * 16);
                asm volatile("" : "+v"(xo[0][0][0]), "+v"(xo[0][0][1]), "+v"(xo[0][1][0]), "+v"(xo[0][1][1]), "+v"(xo[1][0][0]), "+v"(xo[1][0][1]), "+v"(xo[1][1][0]), "+v"(xo[1][1][1]));
#pragma unroll
                for (int mm = 0; mm < 2; ++mm)
#pragma unroll
                    for (int bj = 0; bj < 2; ++bj)
#pragma unroll
                        for (int n = 0; n < 2; ++n) *(f32x4*)(xout + (size_t)(row0 + ai * 128 + (2 * mp + mm) * 16) * DM + col0 + bj * 128 + n * 16) = xo[mm][bj][n] + acc[ai][bj][2 * mp + mm][n];
            }
        return true;
    }
};

struct Params {
    const float* x; const float* norm_g; const float* w_in; const float* ret_gn_g; const float* fox_b_f; const float* pool_w; const float* pool_scale;
    const float* w_ret; const float* w_fox; const float* w_pool; const float* w_out; const float* final_g;
    float* out; unsigned char* ws;
};

#define XB_TMO      128
#define XB_XCNT(j)  (256  + 64 * (j))
#define XB_XSUB(j)  (1280 + 64 * (j))
#define XB_XGEN(j)  (2304 + 64 * (j))
#define XB_TOP      3328
#define XB_TOPGEN   3392
#define XCD_BAR_WORDS 3456
#define XB_SPIN_CAP (1u << 18)

__device__ __forceinline__ unsigned xb_ld(unsigned* p)              { return __hip_atomic_load(p, __ATOMIC_RELAXED, __HIP_MEMORY_SCOPE_AGENT); }
__device__ __forceinline__ unsigned xb_add(unsigned* p, unsigned v) { return __hip_atomic_fetch_add(p, v, __ATOMIC_RELAXED, __HIP_MEMORY_SCOPE_AGENT); }
__device__ __forceinline__ unsigned xb_xcc_id() { return (unsigned)__builtin_amdgcn_s_getreg((3 << 11) | 20) & 0xFu; }
#define XB_SPIN(cond, bar) do { unsigned _sp = 0; while (cond) { __builtin_amdgcn_s_sleep(1); \
    if ((++_sp & 255u) == 0u) { if (xb_ld(&(bar)[XB_TMO])) break; if (_sp > XB_SPIN_CAP) { atomicAdd(&(bar)[XB_TMO], 1u); break; } } } } while (0)

struct XcdBarrier {
    unsigned* bar; unsigned x;
    volatile LAS unsigned* st;
};

__device__ __forceinline__ XcdBarrier xcd_barrier_post(unsigned* bar, volatile LAS unsigned* st) {
    XcdBarrier b; b.bar = bar; b.x = xb_xcc_id(); b.st = st;
    if (threadIdx.x == 0) (void)xb_add(&bar[XB_XCNT(b.x)], 1u);
    return b;
}
__device__ __forceinline__ void xcd_barrier_complete(unsigned* bar, unsigned x, unsigned& nloc, unsigned& nx) {
    const unsigned G = gridDim.x * gridDim.y * gridDim.z;
    unsigned sum, cnt, mine, sp = 0u;
    for (;;) {
        sum = 0u; cnt = 0u; mine = 0u;
#pragma unroll
        for (unsigned j = 0; j < 16; ++j) { const unsigned c = xb_ld(&bar[XB_XCNT(j)]); sum += c; cnt += (c > 0u) ? 1u : 0u; mine = (j == x) ? c : mine; }
        if (sum == G) break;
        __builtin_amdgcn_s_sleep(1);
        if ((++sp & 255u) == 0u) { if (xb_ld(&bar[XB_TMO])) break; if (sp > XB_SPIN_CAP) { atomicAdd(&bar[XB_TMO], 1u); break; } }
    }
    nloc = mine > 0u ? mine : 1u; nx = cnt > 0u ? cnt : 1u;
}

__device__ __forceinline__ void xcd_barrier(const XcdBarrier& b) {
    asm volatile("s_waitcnt vmcnt(0)" ::: "memory");
    __syncthreads();
    if (threadIdx.x == 0) {
        unsigned* bar = b.bar;
        __builtin_amdgcn_s_waitcnt(0);
        unsigned nloc = b.st[0], nx = b.st[1];
        if (nloc == 0u) { xcd_barrier_complete(bar, b.x, nloc, nx); b.st[0] = nloc; b.st[1] = nx; }
        const unsigned old = xb_add(&bar[XB_XSUB(b.x)], 1u);
        const unsigned gen = old / nloc;
        if (old + 1u == (gen + 1u) * nloc) {
            __builtin_amdgcn_fence(__ATOMIC_RELEASE, "agent");
            asm volatile("s_waitcnt vmcnt(0)" ::: "memory");
            const unsigned og = xb_add(&bar[XB_TOP], 1u);
            const unsigned tg = og / nx;
            if (og + 1u == (tg + 1u) * nx) xb_add(&bar[XB_TOPGEN], 1u);
            else XB_SPIN(xb_ld(&bar[XB_TOPGEN]) == tg, bar);
            __builtin_amdgcn_fence(__ATOMIC_ACQUIRE, "agent");
            xb_add(&bar[XB_XGEN(b.x)], 1u);
            asm volatile("s_waitcnt vmcnt(0)" ::: "memory");
        } else {
            XB_SPIN(xb_ld(&bar[XB_XGEN(b.x)]) == gen, bar);
            __builtin_amdgcn_fence(__ATOMIC_ACQUIRE, "agent");
            asm volatile("s_waitcnt vmcnt(0)" ::: "memory");
        }
    }
    __syncthreads();
}


typedef const Params __attribute__((address_space(4))) CParams;
__device__ __forceinline__ Params loadp() {
    const CParams* pp = (const CParams*)__builtin_amdgcn_kernarg_segment_ptr();
    asm volatile("" : "+s"(pp));
    Params p;
    p.x = pp->x; p.norm_g = pp->norm_g; p.w_in = pp->w_in; p.ret_gn_g = pp->ret_gn_g; p.fox_b_f = pp->fox_b_f; p.pool_w = pp->pool_w; p.pool_scale = pp->pool_scale;
    p.w_ret = pp->w_ret; p.w_fox = pp->w_fox; p.w_pool = pp->w_pool; p.w_out = pp->w_out; p.final_g = pp->final_g; p.out = pp->out; p.ws = pp->ws;
    return p;
}
__device__ __forceinline__ int launder_s(int v) { asm volatile("" : "+s"(v)); return v; }
__device__ __forceinline__ void geom(int& G, int& bx, int& vcu) { G = launder_s((int)gridDim.x); bx = launder_s((int)blockIdx.x); vcu = (G % 8 == 0) ? (bx % 8) * (G / 8) + bx / 8 : bx; }
__device__ __forceinline__ const float* sel_ptr(const float* a, const float* b, int useb) { const uintptr_t m = (uintptr_t)0 - (uintptr_t)(useb != 0); return (const float*)(((uintptr_t)a & ~m) | ((uintptr_t)b & m)); }

__device__ __forceinline__ int win_dest(int n) {
    if (n < 2048) { const int head = n >> 7, w = n & 127; return head * 128 + 2 * (w & 63) + (w >> 6); }
    if (n < 8192) return n;
    if (n < 8200) return -1;
    return n - 8;
}
struct TrItem { const float* W; bf16_t* WT; int ldw, ncols, K, item; bool winmap; };
__device__ __forceinline__ void tr_load(const TrItem& t, f32x4 (&ld)[8], int lane) {
    const int nblk = (t.ncols + 31) >> 5, kb = t.item / nblk, nb = t.item - kb * nblk, k0 = 64 * kb, n0 = 32 * nb;
    const int c4 = lane & 7, kr = lane >> 3; const bool okc = (n0 + 4 * c4) < t.ncols;
#pragma unroll
    for (int i = 0; i < 8; ++i) ld[i] = okc ? *(const f32x4*)(t.W + (size_t)(k0 + 8 * i + kr) * t.ldw + n0 + 4 * c4) : (f32x4){0.f, 0.f, 0.f, 0.f};
}
__device__ __forceinline__ void tr_finish(const TrItem& t, const f32x4 (&ld)[8], LAS float* scr, int lane) {
    const int nblk = (t.ncols + 31) >> 5, kb = t.item / nblk, nb = t.item - kb * nblk, k0 = 64 * kb, n0 = 32 * nb;
    const int c4 = lane & 7, kr = lane >> 3;
#pragma unroll
    for (int i = 0; i < 8; ++i) { LAS float* d = scr + (8 * i + kr) * 33 + 4 * c4; d[0] = ld[i].x; d[1] = ld[i].y; d[2] = ld[i].z; d[3] = ld[i].w; }
    LDS_WAIT(); asm volatile("" ::: "memory");
    const int c = lane & 7;
#pragma unroll
    for (int j = 0; j < 4; ++j) { const int n = (lane >> 3) + 8 * j; const int ns = n0 + n; const int dest = (ns < t.ncols) ? (t.winmap ? win_dest(ns) : ns) : -1;
        const LAS float* sp = scr + (8 * c) * 33 + n;
        u32x4 o; o.x = pk2(sp[0 * 33], sp[1 * 33]); o.y = pk2(sp[2 * 33], sp[3 * 33]); o.z = pk2(sp[4 * 33], sp[5 * 33]); o.w = pk2(sp[6 * 33], sp[7 * 33]);
        if (dest >= 0) *(u32x4*)(t.WT + (size_t)dest * t.K + k0 + 8 * c) = o; }
    LDS_WAIT(); asm volatile("" ::: "memory");
}

__device__ __forceinline__ void phase_a(LAS unsigned char* lds, int layer) {
    const Params p = loadp(); int G, bx, vcu; geom(G, bx, vcu); layer = launder_s(layer);
    const int tid = tid_l(), lane = tid & 63, wave = __builtin_amdgcn_readfirstlane(tid >> 6);
    unsigned char* ws = p.ws;
    const float* w_in = p.w_in + (size_t)layer * DM * CIN;
    LAS float* wff = (LAS float*)lds;
    for (int k = tid; k < DM; k += NTHREADS) {
        const float* src = w_in + (size_t)k * CIN + 8192;
        const f32x4 a = *(const f32x4*)src, b = *(const f32x4*)(src + 4);
        const int j = k >> 8, l = (k >> 2) & 63, i = k & 3;
        LAS float* d = wff + ((j * 4 + i) * 64 + l) * 8;
        *(LAS f32x4*)d = a; *(LAS f32x4*)(d + 4) = b;
    }
    __syncthreads();
    LAS float* scr = (LAS float*)(lds + 65536 + wave * 8448);
    const int gw = vcu * NWAVES + wave, NGW = G * NWAVES;
    constexpr int I_IN = 32 * 513, I_BR = 16 * 64, I_OUT = 32 * 64, I_PW = 4 * 8;
    constexpr int NITEMS = I_IN + 3 * I_BR + I_OUT + 4 * I_PW;
    auto decode = [&](int it) -> TrItem {
        TrItem t; int r = it; unsigned char* wsb = ws;
        if (r < I_IN) { t.W = w_in; t.WT = (bf16_t*)(wsb + WS_WIN); t.ldw = CIN; t.ncols = CIN; t.K = DM; t.item = r; t.winmap = true; return t; } r -= I_IN;
        t.winmap = false;
        if (r < 3 * I_BR) { const int q = r / I_BR; r -= q * I_BR; const float* wb = (q == 0) ? p.w_ret : (q == 1) ? p.w_fox : p.w_pool;
            t.W = wb + (size_t)layer * 1024 * DM; t.WT = (bf16_t*)(wsb + WS_WBR) + (size_t)q * 2048 * 1024; t.ldw = DM; t.ncols = DM; t.K = 1024; t.item = r; return t; } r -= 3 * I_BR;
        if (r < I_OUT) { t.W = p.w_out + (size_t)layer * DM * DM; t.WT = (bf16_t*)(wsb + WS_WOUT); t.ldw = DM; t.ncols = DM; t.K = DM; t.item = r; return t; } r -= I_OUT;
        { const int g = r / I_PW; t.W = p.pool_w + (size_t)layer * 4 * 65536 + (size_t)g * 65536; t.WT = (bf16_t*)(wsb + WS_WPOOL) + (size_t)g * 65536; t.ldw = 256; t.ncols = 256; t.K = 256; t.item = r - g * I_PW; return t; }
    };
    {
        int it = gw;
        if (it < NITEMS) {
            TrItem cur = decode(it); f32x4 lda[8], ldb[8];
            tr_load(cur, lda, lane);
            for (;;) {
                const int nit = it + NGW; const bool hn = nit < NITEMS;
                TrItem nxt = cur; if (hn) { nxt = decode(nit); tr_load(nxt, ldb, lane); }
                tr_finish(cur, lda, scr, lane);
                if (!hn) break;
#pragma unroll
                for (int i = 0; i < 8; ++i) lda[i] = ldb[i];
                cur = nxt; it = nit;
            }
        }
    }
    if (layer == 0) {
        float* rope = (float*)(ws + WS_ROPE);
        for (int idx = (vcu * NTHREADS + tid); idx < SEQ * 64; idx += G * NTHREADS) {
            const int pos = idx >> 6, j = idx & 63;
            const float inv = exp2f(-(float)j * (13.287712379549449f / 64.0f));
            const float ang = (float)pos * inv;
            double rev = (double)ang * 0.15915494309189535; rev -= floor(rev);
            const float rf = (float)rev;
            rope[2 * idx] = __builtin_amdgcn_cosf(rf); rope[2 * idx + 1] = __builtin_amdgcn_sinf(rf);
        }
    }
    const float* xin = sel_ptr(p.x, p.out, layer);
    const float* g = p.norm_g + (size_t)layer * DM;
    bf16_t* H = (bf16_t*)(ws + WS_H);
    float* lsig = (float*)(ws + WS_LSIG);
    const float* bf = p.fox_b_f + layer * 8;
    f32x4 gv[8];
#pragma unroll
    for (int j = 0; j < 8; ++j) gv[j] = *((const f32x4*)g + lane + 64 * j);
    f32x4 vn[8];
    if (gw < M) {
#pragma unroll
        for (int j = 0; j < 8; ++j) vn[j] = *((const f32x4*)(xin + (size_t)gw * DM) + lane + 64 * j);
    }
    for (int m = gw; m < M; m += NGW) {
        f32x4 v[8]; float ss = 0.f;
#pragma unroll
        for (int j = 0; j < 8; ++j) { v[j] = vn[j]; ss += (v[j].x * v[j].x + v[j].y * v[j].y) + (v[j].z * v[j].z + v[j].w * v[j].w); }
        if (m + NGW < M) {
#pragma unroll
            for (int j = 0; j < 8; ++j) vn[j] = *((const f32x4*)(xin + (size_t)(m + NGW) * DM) + lane + 64 * j);
        }
        const float rstd = 1.0f / sqrtf(wave_sum(ss) * (1.0f / DM) + EPS);
        float fa[8];
#pragma unroll
        for (int o = 0; o < 8; ++o) fa[o] = 0.f;
        u32x2* o8 = (u32x2*)(H + (size_t)m * DM) + lane;
#pragma unroll
        for (int j = 0; j < 8; ++j) {
            const f32x4 hv = v[j] * rstd * gv[j];
            u32x2 w; w.x = pk2(hv.x, hv.y); w.y = pk2(hv.z, hv.w); o8[64 * j] = w;
#pragma unroll
            for (int i = 0; i < 4; ++i) {
                const LAS float* wp = wff + ((j * 4 + i) * 64 + lane) * 8;
                const f32x4 wa = *(const LAS f32x4*)wp, wb = *(const LAS f32x4*)(wp + 4);
                const float hh = hv[i];
                fa[0] += hh * wa.x; fa[1] += hh * wa.y; fa[2] += hh * wa.z; fa[3] += hh * wa.w;
                fa[4] += hh * wb.x; fa[5] += hh * wb.y; fa[6] += hh * wb.z; fa[7] += hh * wb.w;
            }
            asm volatile("" ::: "memory");
        }
        float mine = 0.f;
#pragma unroll
        for (int o = 0; o < 8; ++o) { const float t = wave_sum(fa[o]); mine = (lane == o) ? t : mine; }
        if (lane < 8) { const float xl = mine + bf[lane]; lsig[(size_t)m * 8 + lane] = fminf(xl, 0.f) - log1pf(__expf(-fabsf(xl))); }
    }
    __syncthreads();
}

__device__ __forceinline__ int swap23(int t) { return (t & ~12) | ((t & 4) << 1) | ((t & 8) >> 1); }
__device__ __forceinline__ int tswz(int row) { return ((row >> 3) ^ (row & 7)) & 15; }
__device__ __forceinline__ int timg(int row, int pos) { return row * 256 + ((((pos >> 3) ^ tswz(row)) << 4) | ((pos & 7) << 1)); }

template <bool RET>
__device__ __forceinline__ void c1_chunk_unit(const Params& p, LAS unsigned char* lds, int layer, int unit) {
    const int tid = tid_l(), lane = tid & 63, wave = __builtin_amdgcn_readfirstlane(tid >> 6);
    const int bh = unit >> 4, c = unit & 15, b = bh >> 3, h = bh & 7;
    const bf16_t* PROJ = (const bf16_t*)(p.ws + WS_PROJ);
    const size_t tok0 = (size_t)b * SEQ + c * 128;
    LAS unsigned char* VtL = lds; LAS unsigned char* KtL = lds + 32768;
    const float lg2 = log1pf(-exp2f(-5.0f - (float)h)) * LOG2E;
    {
        const int T = tid >> 4, ch = tid & 15, pos0 = swap23(4 * T);
        const bf16_t* src = PROJ + (tok0 + 4 * T) * NP + h * 128 + ch * 8;
        u32x4 vv[4], kv[4];
#pragma unroll
        for (int j = 0; j < 4; ++j) { vv[j] = *(const u32x4*)(src + (size_t)j * NP + (RET ? COL_RV : COL_FV)); if (RET) kv[j] = *(const u32x4*)(src + (size_t)j * NP + COL_RK); }
#pragma unroll
        for (int e = 0; e < 4; ++e) {
            const unsigned w0 = vv[0][e], w1 = vv[1][e], w2 = vv[2][e], w3 = vv[3][e];
            u32x2 lo, hi; lo.x = (w0 & 0xffffu) | (w1 << 16); lo.y = (w2 & 0xffffu) | (w3 << 16); hi.x = (w0 >> 16) | (w1 & 0xffff0000u); hi.y = (w2 >> 16) | (w3 & 0xffff0000u);
            *(LAS u32x2*)(VtL + timg(ch * 8 + 2 * e, pos0)) = lo;
            *(LAS u32x2*)(VtL + timg(ch * 8 + 2 * e + 1, pos0)) = hi;
        }
        if (RET) {
            float z[4];
#pragma unroll
            for (int j = 0; j < 4; ++j) z[j] = __builtin_amdgcn_exp2f(lg2 * (float)(127 - (4 * T + j)));
#pragma unroll
            for (int e = 0; e < 4; ++e) {
                const unsigned w0 = kv[0][e], w1 = kv[1][e], w2 = kv[2][e], w3 = kv[3][e];
                u32x2 lo, hi; lo.x = pk2(bflo(w0) * z[0], bflo(w1) * z[1]); lo.y = pk2(bflo(w2) * z[2], bflo(w3) * z[3]);
                hi.x = pk2(bfhi(w0) * z[0], bfhi(w1) * z[1]); hi.y = pk2(bfhi(w2) * z[2], bfhi(w3) * z[3]);
                *(LAS u32x2*)(KtL + timg(ch * 8 + 2 * e, pos0)) = lo;
                *(LAS u32x2*)(KtL + timg(ch * 8 + 2 * e + 1, pos0)) = hi;
            }
        }
    }
    __syncthreads();
    bf16_t* VT = (bf16_t*)(p.ws + (RET ? WS_VTR : WS_VTF));
#pragma unroll
    for (int i = 0; i < 4; ++i) {
        const int pc = tid + 512 * i, d = pc >> 4, ch = pc & 15;
        const u32x4 w = *(const LAS u32x4*)(VtL + d * 256 + ((ch ^ tswz(d)) << 4));
        *(u32x4*)(VT + ((size_t)bh * 128 + d) * SEQ + c * 128 + ch * 8) = w;
    }
    if (RET) {
        const int l31 = lane & 31, hh = lane >> 5;
        const int bv = wave >> 1, bk0 = 2 * (wave & 1);
        f32x16 a0 = {}, a1 = {};
        const int rv = 32 * bv + l31, rk0 = 32 * bk0 + l31, rk1 = rk0 + 32;
#pragma unroll
        for (int s = 0; s < 8; ++s) {
            const int chunk = 2 * s + hh;
            const bf16x8 A = *(const LAS bf16x8*)(VtL + rv * 256 + ((chunk ^ tswz(rv)) << 4));
            const bf16x8 B0 = *(const LAS bf16x8*)(KtL + rk0 * 256 + ((chunk ^ tswz(rk0)) << 4));
            const bf16x8 B1 = *(const LAS bf16x8*)(KtL + rk1 * 256 + ((chunk ^ tswz(rk1)) << 4));
            a0 = __builtin_amdgcn_mfma_f32_32x32x16_bf16(A, B0, a0, 0, 0, 0);
            a1 = __builtin_amdgcn_mfma_f32_32x32x16_bf16(A, B1, a1, 0, 0, 0);
        }
        float* ST = (float*)(p.ws + WS_STATE) + (size_t)unit * 16384;
#pragma unroll
        for (int r = 0; r < 16; ++r) {
            const int dv = 32 * bv + (r & 3) + 8 * (r >> 2) + 4 * hh;
            ST[dv * 128 + 32 * bk0 + l31] = a0[r];
            ST[dv * 128 + 32 * bk0 + 32 + l31] = a1[r];
        }
    }
    __syncthreads();
}

template <int W>
__device__ __forceinline__ void pooled_rows(const bf16_t* PROJ, bf16_t* PO, int r0, int col) {
    constexpr int NL = 8 + W - 1;
    const int t0 = r0 & (SEQ - 1);
    u32x4 L[NL];
#pragma unroll
    for (int j = 0; j < NL; ++j) { const int dt = j - (W - 1); L[j] = (t0 + dt >= 0) ? *(const u32x4*)(PROJ + (size_t)(r0 + dt) * NP + COL_PU + col) : (u32x4){0u, 0u, 0u, 0u}; }
    float s[8];
#pragma unroll
    for (int e = 0; e < 8; ++e) s[e] = 0.f;
#pragma unroll
    for (int j = 0; j < W - 1; ++j) { s[0] += bflo(L[j].x); s[1] += bfhi(L[j].x); s[2] += bflo(L[j].y); s[3] += bfhi(L[j].y); s[4] += bflo(L[j].z); s[5] += bfhi(L[j].z); s[6] += bflo(L[j].w); s[7] += bfhi(L[j].w); }
#pragma unroll
    for (int k = 0; k < 8; ++k) {
        const u32x4 nw = L[k + W - 1];
        s[0] += bflo(nw.x); s[1] += bfhi(nw.x); s[2] += bflo(nw.y); s[3] += bfhi(nw.y); s[4] += bflo(nw.z); s[5] += bfhi(nw.z); s[6] += bflo(nw.w); s[7] += bfhi(nw.w);
        const int n = (t0 + k + 1 < W) ? (t0 + k + 1) : W;
        const float inv = 1.0f / (float)n;
        u32x4 o;
        o.x = pk2(s[0] * inv - bflo(nw.x), s[1] * inv - bfhi(nw.x)); o.y = pk2(s[2] * inv - bflo(nw.y), s[3] * inv - bfhi(nw.y));
        o.z = pk2(s[4] * inv - bflo(nw.z), s[5] * inv - bfhi(nw.z)); o.w = pk2(s[6] * inv - bflo(nw.w), s[7] * inv - bfhi(nw.w));
        *(u32x4*)(PO + (size_t)(r0 + k) * 1024 + col) = o;
        const u32x4 od = L[k];
        s[0] -= bflo(od.x); s[1] -= bfhi(od.x); s[2] -= bflo(od.y); s[3] -= bfhi(od.y); s[4] -= bflo(od.z); s[5] -= bfhi(od.z); s[6] -= bflo(od.w); s[7] -= bfhi(od.w);
    }
}
__device__ __forceinline__ void c1_pooled_unit(const Params& p, int unit) {
    const int tid = tid_l(), lane = tid & 63, w8 = __builtin_amdgcn_readfirstlane(tid >> 6);
    const bf16_t* PROJ = (const bf16_t*)(p.ws + WS_PROJ);
    bf16_t* PO = (bf16_t*)(p.ws + WS_POOLED);
    const int g = w8 & 3, col = g * 256 + (lane & 31) * 8;
    const int strip = (w8 >> 2) * 2 + (lane >> 5);
#pragma unroll 1
    for (int pass = 0; pass < 2; ++pass) {
        const int r0 = unit * 64 + strip * 16 + pass * 8;
        if (g == 0) pooled_rows<2>(PROJ, PO, r0, col);
        else if (g == 1) pooled_rows<4>(PROJ, PO, r0, col);
        else if (g == 2) pooled_rows<8>(PROJ, PO, r0, col);
        else pooled_rows<16>(PROJ, PO, r0, col);
    }
}

__device__ __forceinline__ void c1_cumsum_unit(const Params& p, int b) {
    const int tid = tid_l(), lane = tid & 63, h = tid >> 6;
    const float* lsig = (const float*)(p.ws + WS_LSIG) + ((size_t)b * SEQ + lane) * 8 + h;
    float* cum = (float*)(p.ws + WS_CUM) + (size_t)(b * 8 + h) * SEQ + lane;
    float v[32];
#pragma unroll
    for (int i = 0; i < 32; ++i) v[i] = lsig[(size_t)i * 64 * 8];
    float carry = 0.f;
#pragma unroll
    for (int i = 0; i < 32; ++i) {
        float inc = v[i];
#pragma unroll
        for (int o = 1; o < 64; o <<= 1) { const float t = __shfl_up(inc, o); if (lane >= o) inc += t; }
        inc += carry;
        cum[i * 64] = inc * LOG2E;
        carry = __shfl(inc, 63);
    }
}

__device__ __forceinline__ void phase_c1(LAS unsigned char* lds, int layer) {
    const Params p = loadp(); int G, bx, vcu; geom(G, bx, vcu); layer = launder_s(layer);
    constexpr int NU = 1024 + 1024 + 256 + 8;
    for (int u = vcu; u < NU; u += G) {
        if (u < 1024) c1_chunk_unit<true>(p, lds, layer, u);
        else if (u < 2048) c1_chunk_unit<false>(p, lds, layer, u - 1024);
        else if (u < 2304) c1_pooled_unit(p, u - 2048);
        else c1_cumsum_unit(p, u - 2304);
    }
}

__device__ __forceinline__ void phase_c1b() {
    const Params p = loadp(); int G, bx, vcu; geom(G, bx, vcu);
    const float* ST = (const float*)(p.ws + WS_STATE);
    bf16_t* SC = (bf16_t*)(p.ws + WS_STATEC);
    for (int idx = vcu * NTHREADS + tid_l(); idx < 64 * 4096; idx += G * NTHREADS) {
        const int bh = idx >> 12, e4 = idx & 4095, h = bh & 7;
        const float gch = exp2f(log1pf(-exp2f(-5.0f - (float)h)) * LOG2E * 128.0f);
        const size_t off0 = (size_t)bh * 16 * 16384 + e4 * 4;
        f32x4 sv[15];
#pragma unroll
        for (int c = 0; c < 15; ++c) sv[c] = *(const f32x4*)(ST + off0 + (size_t)c * 16384);
        f32x4 run = (f32x4){0.f, 0.f, 0.f, 0.f};
#pragma unroll
        for (int c = 1; c < 16; ++c) {
            run = run * gch + sv[c - 1];
            u32x2 w; w.x = pk2(run.x, run.y); w.y = pk2(run.z, run.w);
            *(u32x2*)(SC + off0 + (size_t)c * 16384) = w;
        }
    }
}

__device__ __forceinline__ bf16x8 pack8(const f32x16& v, int base) {
    u32x4 w; w.x = pk2(v[base + 0], v[base + 1]); w.y = pk2(v[base + 2], v[base + 3]); w.z = pk2(v[base + 4], v[base + 5]); w.w = pk2(v[base + 6], v[base + 7]);
    return __builtin_bit_cast(bf16x8, w);
}

__device__ __forceinline__ void attn_block(const Params& p, LAS unsigned char* lds, int bh, int qb) {
    const int tid = tid_l(), lane = tid & 63, w = __builtin_amdgcn_readfirstlane(tid >> 6), l31 = lane & 31, hh = lane >> 5;
    const int b = bh >> 3, h = bh & 7;
    const bf16_t* PROJ = (const bf16_t*)(p.ws + WS_PROJ);
    const bf16_t* VTF = (const bf16_t*)(p.ws + WS_VTF) + (size_t)bh * 128 * SEQ;
    const float* cum = (const float*)(p.ws + WS_CUM) + (size_t)bh * SEQ;
    bf16_t* Y = (bf16_t*)(p.ws + WS_Y);
    const size_t rowbase = (size_t)b * SEQ;
    const int qrow = 256 * qb + 32 * w + l31;
    bf16x8 Qf[8];
    { const bf16_t* qp = PROJ + (rowbase + qrow) * NP + COL_FQ + h * 128 + 8 * hh;
#pragma unroll
      for (int ks = 0; ks < 8; ++ks) Qf[ks] = *(const bf16x8*)(qp + 16 * ks); }
    bf16x8 Qone;
    { u32x4 o; o.x = hh ? 0u : 0x3F803F80u; o.y = hh ? 0u : 0x00003F80u; o.z = 0u; o.w = 0u; Qone = __builtin_bit_cast(bf16x8, o); }
    const int ntiles = 4 * (qb + 1), wlast = 4 * qb + (w >> 1);
    const bf16_t* ksrc[2]; const bf16_t* vsrc[2];
#pragma unroll
    for (int i = 0; i < 2; ++i) {
        const int krow = (w + 8 * i) * 4 + (lane >> 4), kch = (lane & 15) ^ (krow & 15);
        ksrc[i] = PROJ + (rowbase + krow) * NP + COL_FK + h * 128 + kch * 8;
        const int vrow = (w + 8 * i) * 8 + (lane >> 3), vch = (lane & 7) ^ ((vrow >> 1) & 7);
        vsrc[i] = VTF + (size_t)vrow * SEQ + vch * 8;
    }
#define ATT_ISSUE(tile, bufoff) do { LAS unsigned char* b_ = lds + (bufoff) + w * 1024; \
        _Pragma("unroll") for (int i_ = 0; i_ < 2; ++i_) { \
            __builtin_amdgcn_global_load_lds((const unsigned*)(ksrc[i_] + (size_t)(tile) * 64 * NP), (LAS unsigned*)(b_ + i_ * 8192), 16, 0, 0); \
            __builtin_amdgcn_global_load_lds((const unsigned*)(vsrc[i_] + (tile) * 64), (LAS unsigned*)(b_ + 16384 + i_ * 8192), 16, 0, 0); } } while (0)
    int kaddr[4], vaddr[4];
#pragma unroll
    for (int q = 0; q < 4; ++q) { kaddr[q] = l31 * 256 + (((2 * q + hh) ^ (l31 & 15)) << 4); vaddr[q] = l31 * 128 + (((2 * q + hh) ^ ((l31 >> 1) & 7)) << 4); }
    f32x16 O0 = {}, O1 = {}, O2 = {}, O3 = {};
    float mrun = -1e30f, lrun = 0.f;
    LAS float* cumL = (LAS float*)(lds + 98304);
    *(LAS f32x4*)(cumL + 4 * tid) = *(const f32x4*)(cum + 4 * tid);
    ATT_ISSUE(ntiles - 1, 0);
    if (ntiles > 1) ATT_ISSUE(ntiles - 2, 32768);
    __syncthreads();
    int bcur = 0, bnext2 = 65536;
    for (int it = 0; it < ntiles; ++it) {
        const int kt = ntiles - 1 - it;
        if (it + 1 < ntiles) asm volatile("s_waitcnt vmcnt(4)" ::: "memory"); else asm volatile("s_waitcnt vmcnt(0)" ::: "memory");
        __builtin_amdgcn_s_barrier(); asm volatile("" ::: "memory");
        if (it + 2 < ntiles) ATT_ISSUE(kt - 2, bnext2);
        LAS unsigned char* buf = lds + bcur;
        if (kt <= wlast) {
            const float cb0 = -cumL[64 * kt + l31], cb1 = -cumL[64 * kt + 32 + l31];
            f32x16 S0 = {}, S1 = {};
#pragma unroll
            for (int ks = 0; ks < 4; ++ks) {
                LAS unsigned char* kp_ = buf + kaddr[ks]; LAS unsigned char* kq_ = buf + (kaddr[ks] ^ 128);
                const bf16x8 A0 = *(const LAS bf16x8*)(kp_);
                const bf16x8 A1 = *(const LAS bf16x8*)(kp_ + 8192);
                const bf16x8 A2 = *(const LAS bf16x8*)(kq_);
                const bf16x8 A3 = *(const LAS bf16x8*)(kq_ + 8192);
                S0 = __builtin_amdgcn_mfma_f32_32x32x16_bf16(A0, Qf[ks], S0, 0, 0, 0);
                S1 = __builtin_amdgcn_mfma_f32_32x32x16_bf16(A1, Qf[ks], S1, 0, 0, 0);
                S0 = __builtin_amdgcn_mfma_f32_32x32x16_bf16(A2, Qf[ks + 4], S0, 0, 0, 0);
                S1 = __builtin_amdgcn_mfma_f32_32x32x16_bf16(A3, Qf[ks + 4], S1, 0, 0, 0);
            }
            {
                const unsigned h0 = f2bf(cb0); const float r0f = cb0 - bflo(h0); const unsigned m0 = f2bf(r0f); const unsigned l0 = f2bf(r0f - bflo(m0));
                const unsigned h1 = f2bf(cb1); const float r1f = cb1 - bflo(h1); const unsigned m1 = f2bf(r1f); const unsigned l1 = f2bf(r1f - bflo(m1));
                u32x4 a0 = {hh ? 0u : (h0 | (m0 << 16)), hh ? 0u : l0, 0u, 0u}, a1 = {hh ? 0u : (h1 | (m1 << 16)), hh ? 0u : l1, 0u, 0u};
                S0 = __builtin_amdgcn_mfma_f32_32x32x16_bf16(__builtin_bit_cast(bf16x8, a0), Qone, S0, 0, 0, 0);
                S1 = __builtin_amdgcn_mfma_f32_32x32x16_bf16(__builtin_bit_cast(bf16x8, a1), Qone, S1, 0, 0, 0);
            }
            if (kt == wlast) {
                const float NEG = -__builtin_inff();
                const int kb = 64 * kt + 4 * hh;
#pragma unroll
                for (int r = 0; r < 16; ++r) { const int key = kb + (r & 3) + 8 * (r >> 2); if (key > qrow) S0[r] = NEG; if (key + 32 > qrow) S1[r] = NEG; }
            }
            float mx = S0[0];
#pragma unroll
            for (int r = 1; r < 16; ++r) mx = fmaxf(mx, S0[r]);
#pragma unroll
            for (int r = 0; r < 16; ++r) mx = fmaxf(mx, S1[r]);
            mx = fmaxf(mx, __shfl_xor(mx, 32));
            if (!__all(mx - mrun < -160.0f)) {
                if (!__all(mx <= mrun)) {
                    const float mnew = fmaxf(mrun, mx);
                    const float alpha = __builtin_amdgcn_exp2f(mrun - mnew);
                    mrun = mnew; lrun *= alpha;
                    O0 = O0 * alpha; O1 = O1 * alpha; O2 = O2 * alpha; O3 = O3 * alpha;
                }
                float ps = 0.f;
#pragma unroll
                for (int r = 0; r < 16; ++r) { S0[r] = __builtin_amdgcn_exp2f(S0[r] - mrun); S1[r] = __builtin_amdgcn_exp2f(S1[r] - mrun); ps += S0[r] + S1[r]; }
                lrun += ps;
                const bf16x8 P00 = pack8(S0, 0), P01 = pack8(S0, 8), P10 = pack8(S1, 0), P11 = pack8(S1, 8);
                LAS unsigned char* vb = buf + 16384;
#define ATT_PVQ(q, PX) do { \
                const bf16x8 V0_ = *(const LAS bf16x8*)(vb + vaddr[q]), V1_ = *(const LAS bf16x8*)(vb + vaddr[q] + 4096), V2_ = *(const LAS bf16x8*)(vb + vaddr[q] + 8192), V3_ = *(const LAS bf16x8*)(vb + vaddr[q] + 12288); \
                O0 = __builtin_amdgcn_mfma_f32_32x32x16_bf16(V0_, PX, O0, 0, 0, 0); O1 = __builtin_amdgcn_mfma_f32_32x32x16_bf16(V1_, PX, O1, 0, 0, 0); \
                O2 = __builtin_amdgcn_mfma_f32_32x32x16_bf16(V2_, PX, O2, 0, 0, 0); O3 = __builtin_amdgcn_mfma_f32_32x32x16_bf16(V3_, PX, O3, 0, 0, 0); } while (0)
                ATT_PVQ(0, P00); ATT_PVQ(1, P01); ATT_PVQ(2, P10); ATT_PVQ(3, P11);
#undef ATT_PVQ
            }
        }
        bnext2 = bcur; bcur = (bcur == 65536) ? 0 : bcur + 32768;
    }
#undef ATT_ISSUE
    const float ltot = lrun + __shfl_xor(lrun, 32);
    const float inv = __builtin_amdgcn_rcpf(ltot);
    const size_t grow = rowbase + qrow;
    const bf16_t* zp = PROJ + grow * NP + COL_FZ + h * 128 + 4 * hh;
    bf16_t* yp = Y + grow * 3072 + 1024 + h * 128 + 4 * hh;
    u32x2 zz[16];
#pragma unroll
    for (int i = 0; i < 16; ++i) zz[i] = *(const u32x2*)(zp + 32 * (i >> 2) + 8 * (i & 3));
    asm volatile("" : "+v"(zz[0]), "+v"(zz[1]), "+v"(zz[2]), "+v"(zz[3]), "+v"(zz[4]), "+v"(zz[5]), "+v"(zz[6]), "+v"(zz[7]));
    asm volatile("" : "+v"(zz[8]), "+v"(zz[9]), "+v"(zz[10]), "+v"(zz[11]), "+v"(zz[12]), "+v"(zz[13]), "+v"(zz[14]), "+v"(zz[15]));
#define ATT_ST(OX, db) do { _Pragma("unroll") for (int g = 0; g < 4; ++g) { const u32x2 z = zz[4 * (db) + g]; u32x2 o; \
        o.x = pk2(OX[4 * g + 0] * inv * bflo(z.x), OX[4 * g + 1] * inv * bfhi(z.x)); o.y = pk2(OX[4 * g + 2] * inv * bflo(z.y), OX[4 * g + 3] * inv * bfhi(z.y)); \
        *(u32x2*)(yp + 32 * (db) + 8 * g) = o; } } while (0)
    ATT_ST(O0, 0); ATT_ST(O1, 1); ATT_ST(O2, 2); ATT_ST(O3, 3);
#undef ATT_ST
    __syncthreads();
}

__device__ __forceinline__ void ret_out_unit(const Params& p, int layer, int unit, int gq) {
    const int lane = tid_l() & 63, l31 = lane & 31, hh = lane >> 5;
    const int bh = unit >> 4, c = unit & 15, b = bh >> 3, h = bh & 7;
    const bf16_t* PROJ = (const bf16_t*)(p.ws + WS_PROJ);
    const bf16_t* VTR = (const bf16_t*)(p.ws + WS_VTR) + (size_t)bh * 128 * SEQ + c * 128;
    const bf16_t* SC = (const bf16_t*)(p.ws + WS_STATEC) + (size_t)unit * 16384;
    bf16_t* Y = (bf16_t*)(p.ws + WS_Y);
    const size_t tok0 = (size_t)b * SEQ + c * 128;
    const int ql = 32 * gq + l31;
    const float lg2 = log1pf(-exp2f(-5.0f - (float)h)) * LOG2E;
    bf16x8 Qf[8];
    { const bf16_t* qp = PROJ + (tok0 + ql) * NP + COL_RQ + h * 128 + 8 * hh;
#pragma unroll
      for (int ks = 0; ks < 8; ++ks) Qf[ks] = *(const bf16x8*)(qp + 16 * ks); }
    f32x16 O0 = {}, O1 = {}, O2 = {}, O3 = {};
#define PIN8(X) asm volatile("" : "+v"(X[0]), "+v"(X[1]), "+v"(X[2]), "+v"(X[3]), "+v"(X[4]), "+v"(X[5]), "+v"(X[6]), "+v"(X[7]))
    if (c > 0) {
        const bf16_t* sp = SC + (size_t)l31 * 128 + 8 * hh;
#pragma unroll
        for (int kh = 0; kh < 2; ++kh) {
            bf16x8 Fa[8], Fb[8];
#pragma unroll
            for (int k4 = 0; k4 < 4; ++k4) { const int ks = 4 * kh + k4;
                Fa[2 * k4] = *(const bf16x8*)(sp + 0 * 4096 + 16 * ks); Fa[2 * k4 + 1] = *(const bf16x8*)(sp + 1 * 4096 + 16 * ks);
                Fb[2 * k4] = *(const bf16x8*)(sp + 2 * 4096 + 16 * ks); Fb[2 * k4 + 1] = *(const bf16x8*)(sp + 3 * 4096 + 16 * ks); }
            PIN8(Fa); PIN8(Fb);
#pragma unroll
            for (int k4 = 0; k4 < 4; ++k4) { const int ks = 4 * kh + k4;
                O0 = __builtin_amdgcn_mfma_f32_32x32x16_bf16(Fa[2 * k4], Qf[ks], O0, 0, 0, 0);
                O1 = __builtin_amdgcn_mfma_f32_32x32x16_bf16(Fa[2 * k4 + 1], Qf[ks], O1, 0, 0, 0);
                O2 = __builtin_amdgcn_mfma_f32_32x32x16_bf16(Fb[2 * k4], Qf[ks], O2, 0, 0, 0);
                O3 = __builtin_amdgcn_mfma_f32_32x32x16_bf16(Fb[2 * k4 + 1], Qf[ks], O3, 0, 0, 0); }
        }
        const float xi = __builtin_amdgcn_exp2f(lg2 * (float)(ql + 1));
        O0 = O0 * xi; O1 = O1 * xi; O2 = O2 * xi; O3 = O3 * xi;
    }
    for (int kb = 0; kb <= gq; ++kb) {
        const bf16_t* kp = PROJ + (tok0 + 32 * kb + l31) * NP + COL_RK + h * 128 + 8 * hh;
        const bf16_t* vp = VTR + (size_t)l31 * SEQ + 32 * kb + 8 * hh;
        bf16x8 Kf[8], Vf[8];
#pragma unroll
        for (int ks = 0; ks < 8; ++ks) Kf[ks] = *(const bf16x8*)(kp + 16 * ks);
#pragma unroll
        for (int db = 0; db < 4; ++db) { Vf[2 * db] = *(const bf16x8*)(vp + (size_t)(32 * db) * SEQ); Vf[2 * db + 1] = *(const bf16x8*)(vp + (size_t)(32 * db) * SEQ + 16); }
        PIN8(Kf);
        f32x16 S = {};
#pragma unroll
        for (int ks = 0; ks < 8; ++ks) S = __builtin_amdgcn_mfma_f32_32x32x16_bf16(Kf[ks], Qf[ks], S, 0, 0, 0);
#pragma unroll
        for (int r = 0; r < 16; ++r) { const int key = 32 * kb + (r & 3) + 8 * (r >> 2) + 4 * hh; const int d = ql - key; S[r] = (d >= 0) ? S[r] * __builtin_amdgcn_exp2f(lg2 * (float)d) : 0.f; }
        const bf16x8 P0 = pack8(S, 0), P1 = pack8(S, 8);
        PIN8(Vf);
        O0 = __builtin_amdgcn_mfma_f32_32x32x16_bf16(Vf[0], P0, O0, 0, 0, 0); O1 = __builtin_amdgcn_mfma_f32_32x32x16_bf16(Vf[2], P0, O1, 0, 0, 0);
        O2 = __builtin_amdgcn_mfma_f32_32x32x16_bf16(Vf[4], P0, O2, 0, 0, 0); O3 = __builtin_amdgcn_mfma_f32_32x32x16_bf16(Vf[6], P0, O3, 0, 0, 0);
        O0 = __builtin_amdgcn_mfma_f32_32x32x16_bf16(Vf[1], P1, O0, 0, 0, 0); O1 = __builtin_amdgcn_mfma_f32_32x32x16_bf16(Vf[3], P1, O1, 0, 0, 0);
        O2 = __builtin_amdgcn_mfma_f32_32x32x16_bf16(Vf[5], P1, O2, 0, 0, 0); O3 = __builtin_amdgcn_mfma_f32_32x32x16_bf16(Vf[7], P1, O3, 0, 0, 0);
    }
#undef PIN8
    float s1 = 0.f;
#pragma unroll
    for (int r = 0; r < 16; ++r) s1 += (O0[r] + O1[r]) + (O2[r] + O3[r]);
    s1 += __shfl_xor(s1, 32);
    const float mean = s1 * (1.0f / 128.0f);
    float s2 = 0.f;
#pragma unroll
    for (int r = 0; r < 16; ++r) { const float a = O0[r] - mean, bq = O1[r] - mean, cq = O2[r] - mean, dq = O3[r] - mean; s2 += (a * a + bq * bq) + (cq * cq + dq * dq); }
    s2 += __shfl_xor(s2, 32);
    const float rstd = 1.0f / sqrtf(s2 * (1.0f / 128.0f) + EPS);
    const float* gn = p.ret_gn_g + (size_t)layer * 1024 + h * 128 + 4 * hh;
    const size_t grow = tok0 + ql;
    const bf16_t* zp = PROJ + grow * NP + COL_RZ + h * 128 + 4 * hh;
    bf16_t* yp = Y + grow * 3072 + h * 128 + 4 * hh;
    u32x2 zz[16];
#pragma unroll
    for (int i = 0; i < 16; ++i) zz[i] = *(const u32x2*)(zp + 32 * (i >> 2) + 8 * (i & 3));
    f32x4 gg[8];
#pragma unroll
    for (int i = 0; i < 8; ++i) gg[i] = *(const f32x4*)(gn + 32 * (i >> 2) + 8 * (i & 3));
    asm volatile("" : "+v"(zz[0]), "+v"(zz[1]), "+v"(zz[2]), "+v"(zz[3]), "+v"(zz[4]), "+v"(zz[5]), "+v"(zz[6]), "+v"(zz[7]));
    asm volatile("" : "+v"(zz[8]), "+v"(zz[9]), "+v"(zz[10]), "+v"(zz[11]), "+v"(zz[12]), "+v"(zz[13]), "+v"(zz[14]), "+v"(zz[15]));
    asm volatile("" : "+v"(gg[0]), "+v"(gg[1]), "+v"(gg[2]), "+v"(gg[3]), "+v"(gg[4]), "+v"(gg[5]), "+v"(gg[6]), "+v"(gg[7]));
#define RET_ST(OX, db, GG) do { _Pragma("unroll") for (int g = 0; g < 4; ++g) { const u32x2 z = zz[4 * (db) + g]; const f32x4 gq_ = GG[4 * ((db) & 1) + g]; u32x2 o; \
        o.x = pk2((OX[4 * g + 0] - mean) * rstd * gq_.x * bflo(z.x), (OX[4 * g + 1] - mean) * rstd * gq_.y * bfhi(z.x)); \
        o.y = pk2((OX[4 * g + 2] - mean) * rstd * gq_.z * bflo(z.y), (OX[4 * g + 3] - mean) * rstd * gq_.w * bfhi(z.y)); \
        *(u32x2*)(yp + 32 * (db) + 8 * g) = o; } } while (0)
    RET_ST(O0, 0, gg); RET_ST(O1, 1, gg);
#pragma unroll
    for (int i = 0; i < 8; ++i) gg[i] = *(const f32x4*)(gn + 64 + 32 * (i >> 2) + 8 * (i & 3));
    asm volatile("" : "+v"(gg[0]), "+v"(gg[1]), "+v"(gg[2]), "+v"(gg[3]), "+v"(gg[4]), "+v"(gg[5]), "+v"(gg[6]), "+v"(gg[7]));
    RET_ST(O2, 2, gg); RET_ST(O3, 3, gg);
#undef RET_ST
}

__device__ __forceinline__ void phase_c2(LAS unsigned char* lds, int layer) {
#if PHC2 & 1
    { const Params p = loadp(); int G, bx, vcu; geom(G, bx, vcu);
      for (int it = vcu; it < 256; it += G) { const int bh = it >> 2, i = it & 3; for (int k2 = 0; k2 < 2; ++k2) attn_block(p, lds, bh, k2 ? i : 7 - i); } }
#endif
#if PHC2 & 2
    { const Params p = loadp(); int G, bx, vcu; geom(G, bx, vcu); const int ly = launder_s(layer);
      const int wave = __builtin_amdgcn_readfirstlane(tid_l() >> 6);
      int rnd = 0;
      for (int it = vcu; it < 512; it += G, ++rnd) ret_out_unit(p, ly, 2 * it + (wave >> 2), (rnd & 1) ? 3 - (wave & 3) : (wave & 3)); }
#endif
    __syncthreads();
#if PHC2 & 4
    { const Params p = loadp(); int G, bx, vcu; geom(G, bx, vcu); const int ly = launder_s(layer);
      SchedPool S{(const bf16_t*)(p.ws + WS_POOLED), (const bf16_t*)(p.ws + WS_WPOOL), G, bx};
      EpiPool E{(const bf16_t*)(p.ws + WS_PROJ), (bf16_t*)(p.ws + WS_Y), p.pool_scale + (size_t)ly * 1024};
      pg8::gemm_phase<EpiPool, SchedPool>(lds, launder_s(256), 1024, 256, S, E); }
#endif
}

__device__ __forceinline__ void phase_final() {
    const Params p = loadp(); int G, bx, vcu; geom(G, bx, vcu);
    const int tid = tid_l(), lane = tid & 63, wave = tid >> 6;
    const int gw = vcu * NWAVES + wave, NGW = G * NWAVES;
    f32x4 gfin[8];
#pragma unroll
    for (int j = 0; j < 8; ++j) gfin[j] = *((const f32x4*)p.final_g + lane + 64 * j);
    f32x4 vn[8];
    if (gw < M) {
#pragma unroll
        for (int j = 0; j < 8; ++j) vn[j] = *((const f32x4*)(p.out + (size_t)gw * DM) + lane + 64 * j);
    }
    for (int m = gw; m < M; m += NGW) {
        f32x4* xr = (f32x4*)(p.out + (size_t)m * DM) + lane;
        f32x4 v[8]; float ss = 0.f;
#pragma unroll
        for (int j = 0; j < 8; ++j) { v[j] = vn[j]; ss += (v[j].x * v[j].x + v[j].y * v[j].y) + (v[j].z * v[j].z + v[j].w * v[j].w); }
        if (m + NGW < M) {
#pragma unroll
            for (int j = 0; j < 8; ++j) vn[j] = *((const f32x4*)(p.out + (size_t)(m + NGW) * DM) + lane + 64 * j);
        }
        const float rstd = 1.0f / sqrtf(wave_sum(ss) * (1.0f / DM) + EPS);
#pragma unroll
        for (int j = 0; j < 8; ++j) xr[64 * j] = v[j] * rstd * gfin[j];
    }
}

__global__ void __launch_bounds__(NTHREADS, 2) hybrid_fwd(Params p_unused) {
    extern __shared__ __attribute__((aligned(16))) unsigned char lds_raw[];
    LAS unsigned char* lds = (LAS unsigned char*)lds_raw;
    cg::grid_group grid = cg::this_grid();
    if (gridDim.y == 0x7fffffffu) grid.sync();
    if (threadIdx.x < 16) ((volatile LAS unsigned*)(lds + LDS_BARST))[threadIdx.x] = 0u;
    __syncthreads();
    (void)xcd_barrier_post((unsigned*)(loadp().ws + WS_BAR), (volatile LAS unsigned*)(lds + LDS_BARST));
#define GSYNC() do { XcdBarrier b_; b_.bar = (unsigned*)(loadp().ws + WS_BAR); b_.x = xb_xcc_id(); b_.st = (volatile LAS unsigned*)(lds + LDS_BARST); xcd_barrier(b_); } while (0)
#pragma unroll 1
    for (int layer = 0; layer < DEPTH; ++layer) {
#if PHM & 1
        phase_a(lds, layer);
#if REPM & 1
        GSYNC(); phase_a(lds, layer);
#endif
#endif
        GSYNC();
#if PHM & 2
        {
            const Params p = loadp(); int G, bx, vcu; geom(G, bx, vcu);
            SchedProj S{(const bf16_t*)(p.ws + WS_H), (const bf16_t*)(p.ws + WS_WIN), DM, DM, 64, 64, G, bx};
            EpiProj E{(bf16_t*)(p.ws + WS_PROJ), (const float*)(p.ws + WS_ROPE)};
            pg8::gemm_phase<EpiProj, SchedProj>(lds, DM, DM, DM, S, E);
        }
#endif
        GSYNC();
#if PHM & 4
        phase_c1(lds, layer);
#if REPM & 4
        GSYNC(); phase_c1(lds, layer);
#endif
#endif
        GSYNC();
#if PHM & 8
        phase_c1b();
#endif
        GSYNC();
#if PHM & 16
        phase_c2(lds, layer);
#if REPM & 16
        GSYNC(); phase_c2(lds, layer);
#endif
#endif
        GSYNC();
#if PHM & 32
        {
            const Params p = loadp(); int G, bx, vcu; geom(G, bx, vcu);
            SchedMerge S{(const bf16_t*)(p.ws + WS_Y), (const bf16_t*)(p.ws + WS_WBR), G, bx};
            EpiMerge E{(const bf16_t*)(p.ws + WS_PROJ), (bf16_t*)(p.ws + WS_H)};
            pg8::gemm_phase<EpiMerge, SchedMerge>(lds, 1024, 3072, 1024, S, E);
        }
#endif
        GSYNC();
#if PHM & 64
        {
            const Params p = loadp(); int G, bx, vcu; geom(G, bx, vcu); const int ly = launder_s(layer);
            SchedPlain S{(const bf16_t*)(p.ws + WS_H), (const bf16_t*)(p.ws + WS_WOUT), DM, DM, 64, 8, G, bx};
            EpiOut E{sel_ptr(p.x, p.out, ly), p.out};
            pg8::gemm_phase<EpiOut, SchedPlain>(lds, DM, DM, DM, S, E);
        }
#endif
        GSYNC();
    }
#if PHM & 128
    phase_final();
#endif
}

extern "C" void kernel_launch(void* const* d_in, const int* in_sizes, int n_in, void* d_out, int out_size, void* d_ws, size_t ws_size, hipStream_t stream) {
    static int grid_blocks = 0;
    if (!grid_blocks) {
        int dev = 0, cus = 0, per_cu = 0;
        hipGetDevice(&dev);
        hipDeviceGetAttribute(&cus, hipDeviceAttributeMultiprocessorCount, dev);
        hipFuncSetAttribute((const void*)hybrid_fwd, hipFuncAttributeMaxDynamicSharedMemorySize, LDS_BYTES);
        hipOccupancyMaxActiveBlocksPerMultiprocessor(&per_cu, (const void*)hybrid_fwd, NTHREADS, LDS_BYTES);
        if (per_cu < 1) per_cu = 1;
        grid_blocks = cus * 1;
        if (ws_size < WS_END) fprintf(stderr, "kernel_launch: workspace too small: %zu < %zu\n", ws_size, (size_t)WS_END);
    }
    Params p{};
    p.x = (const float*)d_in[0]; p.norm_g = (const float*)d_in[1]; p.w_in = (const float*)d_in[2]; p.ret_gn_g = (const float*)d_in[3]; p.fox_b_f = (const float*)d_in[4];
    p.pool_w = (const float*)d_in[5]; p.pool_scale = (const float*)d_in[6]; p.w_ret = (const float*)d_in[7]; p.w_fox = (const float*)d_in[8]; p.w_pool = (const float*)d_in[9];
    p.w_out = (const float*)d_in[10]; p.final_g = (const float*)d_in[11];
    p.out = (float*)d_out; p.ws = (unsigned char*)d_ws;
    (void)hipMemsetAsync((char*)d_ws + WS_BAR, 0, XCD_BAR_WORDS * sizeof(unsigned), stream);
    void* args[] = {&p};
    hipError_t e = hipLaunchCooperativeKernel((const void*)hybrid_fwd, dim3(grid_blocks), dim3(NTHREADS), args, LDS_BYTES, stream);
    if (e != hipSuccess) fprintf(stderr, "cooperative launch failed: %s (grid %d)\n", hipGetErrorString(e), grid_blocks);
}
```

```cpp
#include <hip/hip_runtime.h>
#include <hip/hip_cooperative_groups.h>
#include <cstdio>
#include <cstdint>
namespace cg = cooperative_groups;
#ifndef PHM
#define PHM 255
#endif
#ifndef PHC2
#define PHC2 7
#endif
#ifndef REPM
#define REPM 0
#endif

#define LAS __attribute__((address_space(3)))
typedef unsigned short bf16_t;
typedef short bf16x8 __attribute__((ext_vector_type(8)));
typedef float f32x4 __attribute__((ext_vector_type(4)));
typedef float f32x16 __attribute__((ext_vector_type(16)));
typedef unsigned u32x4 __attribute__((ext_vector_type(4)));
typedef unsigned u32x2 __attribute__((ext_vector_type(2)));

constexpr int BATCH = 8, SEQ = 2048, DM = 2048, M = BATCH * SEQ, NH = 8, CIN = 16392, NP = 16384, DEPTH = 2;
constexpr int COL_RQ = 0, COL_RK = 1024, COL_RV = 2048, COL_RZ = 3072, COL_FQ = 4096, COL_FK = 5120, COL_FV = 6144, COL_FZ = 7168,
              COL_PU = 8192, COL_PZ = 9216, COL_GA = 10240, COL_GB = 12288, COL_GC = 14336;
constexpr float EPS = 1e-6f, LOG2E = 1.4426950408889634f;
constexpr int NWAVES = 8, NTHREADS = 512;
constexpr int LDS_BYTES = 147456;
constexpr int LDS_BARST = LDS_BYTES - 64;

constexpr size_t MiB = 1u << 20;
constexpr size_t WS_LSIG = 0;
constexpr size_t WS_CUM = MiB / 2;
constexpr size_t WS_ROPE = 1 * MiB;
constexpr size_t WS_WPOOL = 2 * MiB;
constexpr size_t WS_BAR = 3 * MiB;
constexpr size_t WS_WOUT = 4 * MiB;
constexpr size_t WS_WBR = 12 * MiB;
constexpr size_t WS_WIN = 24 * MiB;
constexpr size_t WS_H = 88 * MiB;
constexpr size_t WS_PROJ = 152 * MiB;
constexpr size_t WS_Y = 664 * MiB;
constexpr size_t WS_STATE = 760 * MiB;
constexpr size_t WS_STATEC = 824 * MiB;
constexpr size_t WS_POOLED = 856 * MiB;
constexpr size_t WS_VTF = 888 * MiB;
constexpr size_t WS_VTR = 920 * MiB;
constexpr size_t WS_END = 952 * MiB;

__device__ __forceinline__ unsigned f2bf(float f) { unsigned u = __builtin_bit_cast(unsigned, f); return (u + 0x7fffu + ((u >> 16) & 1u)) >> 16; }
typedef float f32x2 __attribute__((ext_vector_type(2)));
typedef __bf16 hwbf16x2 __attribute__((ext_vector_type(2)));
__device__ __forceinline__ unsigned pk2(float lo, float hi) { const f32x2 v = {lo, hi}; const hwbf16x2 b = __builtin_convertvector(v, hwbf16x2); return __builtin_bit_cast(unsigned, b); }
__device__ __forceinline__ float bflo(unsigned w) { return __builtin_bit_cast(float, w << 16); }
__device__ __forceinline__ float bfhi(unsigned w) { return __builtin_bit_cast(float, w & 0xffff0000u); }
__device__ __forceinline__ float wave_sum(float v) {
#pragma unroll
    for (int o = 1; o < 64; o <<= 1) v += __shfl_xor(v, o);
    return v;
}
__device__ __forceinline__ float fast_sigmoid(float x) { return __builtin_amdgcn_rcpf(1.0f + __builtin_amdgcn_exp2f(-x * LOG2E)); }
__device__ __forceinline__ float fast_silu(float x) { return x * fast_sigmoid(x); }
#define LDS_WAIT() asm volatile("s_waitcnt lgkmcnt(0)" ::: "memory")
__device__ __forceinline__ int tid_l() { int t = threadIdx.x; asm volatile("" : "+v"(t)); return t; }

namespace pg8 {
constexpr int BM = 256, BK = 64, HALF = 128, HTB = HALF * BK * 2, STAGE_BYTES = 8 * HTB, NXCD = 8, WGM = 8;
__device__ __forceinline__ int lds_byte(int r, int c) { const int st = (r >> 4) * 2 + (c >> 5), rr = r & 15, cc = c & 31, ob = rr * 64 + cc * 2; return st * 1024 + (ob ^ (((ob >> 9) & 1) << 5)); }
__device__ __forceinline__ void stage_rc(int b, int& R, int& C) { const int st = b / 1024, sb = b % 1024, swz = sb ^ (((sb >> 9) & 1) << 5); R = (st >> 1) * 16 + swz / 64; C = (st & 1) * 32 + (swz % 64) / 2; }
__device__ __forceinline__ int perm32(int rho) { const int n = rho >> 4, i = rho & 15; return 8 * (i >> 2) + 4 * n + (i & 3); }

struct Unit { int pm, pn, aux; };

__device__ __forceinline__ void tile_of(int L, int nM, int nN, int& pm, int& pn) {
    const int nwg = nM * nN; int wgid = L;
    { const int q = nwg / NXCD, r = nwg % NXCD, xcd = wgid % NXCD, off = wgid / NXCD; wgid = (xcd < r ? xcd * (q + 1) : r * (q + 1) + (xcd - r) * q) + off; }
    const int nig = WGM * nN, gid = wgid / nig, fm = gid * WGM, gsz = (nM - fm) < WGM ? (nM - fm) : WGM;
    pm = fm + ((wgid % nig) % gsz); pn = (wgid % nig) / gsz;
}

template <class Epi, class Sched>
__device__ __forceinline__ void gemm_phase(LAS unsigned char* lds, const int K, const int lda, const int ldb, const Sched& S, const Epi& E) {
    const int tid = tid_l(), wid = __builtin_amdgcn_readfirstlane(tid >> 6), lane = tid & 63, wr = wid >> 2, wc = wid & 3, fr = lane & 15, fq = lane >> 4;
    const int nt = K / BK;
    unsigned voffA[2], voffB[2];
#pragma unroll
    for (int i = 0; i < 2; ++i) { int R, C; stage_rc(tid * 16 + i * 8192, R, C); const int Rb = Epi::PERM ? ((R & ~31) + perm32(R & 31)) : R;
        voffA[i] = (unsigned)(R * lda + C) * 2u; voffB[i] = (unsigned)(Rb * ldb + C) * 2u; }
    const size_t kstep = (size_t)(BK * 2);
    const size_t hstepA = (size_t)HALF * lda * 2, hstepB = (size_t)HALF * ldb * 2;
    const unsigned ldsw = (unsigned)wid * 1024u;
    const int aoff = lds_byte(wr * 64 + fr, fq * 8), boff = lds_byte(wc * 32 + fr, fq * 8);
#define PG8_SA(b, h) (((b) * 2 + (h)) * HTB)
#define PG8_SB(b, h) ((4 + (b) * 2 + (h)) * HTB)
#define PG8_STAGE(bufoff, gbase, voff) do { _Pragma("unroll") for (int _i = 0; _i < 2; ++_i) \
        __builtin_amdgcn_global_load_lds((const unsigned*)((const char*)(gbase) + (voff)[_i]), (LAS unsigned*)(lds + (bufoff) + ldsw + _i * 8192), 16, 0, 0); } while (0)
#define PG8_LDA(dst, b, h) do { _Pragma("unroll") for (int m = 0; m < 4; ++m) _Pragma("unroll") for (int k = 0; k < 2; ++k) dst[m][k] = *(const LAS bf16x8*)(lds + PG8_SA(b, h) + aoff + m * 2048 + k * 1024); } while (0)
#define PG8_LDB(dst, b, h) do { _Pragma("unroll") for (int n = 0; n < 2; ++n) _Pragma("unroll") for (int k = 0; k < 2; ++k) dst[n][k] = *(const LAS bf16x8*)(lds + PG8_SB(b, h) + boff + n * 2048 + k * 1024); } while (0)
#define PG8_MMA(ai, bj, At, Bt) do { __builtin_amdgcn_s_setprio(1); _Pragma("unroll") for (int m = 0; m < 4; ++m) _Pragma("unroll") for (int n = 0; n < 2; ++n) _Pragma("unroll") for (int k = 0; k < 2; ++k) \
        acc[ai][bj][m][n] = __builtin_amdgcn_mfma_f32_16x16x32_bf16(Bt[n][k], At[m][k], acc[ai][bj][m][n], 0, 0, 0); __builtin_amdgcn_s_setprio(0); } while (0)
#define PG8_WAIT_V(n) asm volatile("s_waitcnt vmcnt(" #n ")" ::: "memory")
#define PG8_WAIT_L(n) asm volatile("s_waitcnt lgkmcnt(" #n ")" ::: "memory")
#define PG8_BAR __builtin_amdgcn_s_barrier()
#define PG8_SCHED __builtin_amdgcn_sched_barrier(0)
    Unit cur, nxt; int ui = 0;
    if (!S.next(0, cur)) return;
    f32x4 acc[2][2][4][2];
#pragma unroll
    for (int a = 0; a < 2; ++a)
#pragma unroll
        for (int b = 0; b < 2; ++b)
#pragma unroll
            for (int m = 0; m < 4; ++m)
#pragma unroll
                for (int n = 0; n < 2; ++n) acc[a][b][m][n] = (f32x4){0.f, 0.f, 0.f, 0.f};
    bf16x8 At[4][2], B0[2][2], B1[2][2];
    const char* cA = S.a_ptr(cur); const char* cB = S.b_ptr(cur);
    PG8_STAGE(PG8_SB(0, 0), cB, voffB); PG8_STAGE(PG8_SB(0, 1), cB + hstepB, voffB); PG8_STAGE(PG8_SA(0, 0), cA, voffA); PG8_STAGE(PG8_SA(0, 1), cA + hstepA, voffA);
    if (wr == 1) PG8_BAR;
    PG8_WAIT_V(2); PG8_BAR;
    PG8_STAGE(PG8_SB(1, 0), cB + kstep, voffB); PG8_STAGE(PG8_SA(1, 0), cA + kstep, voffA); PG8_STAGE(PG8_SB(1, 1), cB + hstepB + kstep, voffB);
    PG8_WAIT_V(6); PG8_BAR;
    for (;;) {
        const bool has_next = S.next(ui + 1, nxt);
        const char* nA = has_next ? S.a_ptr(nxt) : cA; const char* nB = has_next ? S.b_ptr(nxt) : cB;
        for (int t = 0; t < nt; t += 2) {
            const bool last = (t == nt - 2);
            const char* a1 = cA + (size_t)(t + 1) * kstep;
            const char* a2 = last ? nA : cA + (size_t)(t + 2) * kstep; const char* b2 = last ? nB : cB + (size_t)(t + 2) * kstep;
            const char* a3 = a2 + kstep; const char* b3 = b2 + kstep;
            PG8_LDB(B0, 0, 0); PG8_LDB(B1, 0, 1); PG8_SCHED; PG8_LDA(At, 0, 0); PG8_STAGE(PG8_SA(1, 1), a1 + hstepA, voffA);
            PG8_WAIT_V(8); PG8_WAIT_L(0); PG8_BAR; PG8_MMA(0, 0, At, B0); PG8_MMA(0, 1, At, B1); PG8_BAR; PG8_SCHED;
            PG8_LDA(At, 0, 1); PG8_STAGE(PG8_SB(0, 0), b2, voffB); PG8_STAGE(PG8_SB(0, 1), b2 + hstepB, voffB); PG8_STAGE(PG8_SA(0, 0), a2, voffA);
            PG8_WAIT_V(8); PG8_WAIT_L(0); PG8_BAR; PG8_MMA(1, 0, At, B0); PG8_MMA(1, 1, At, B1); PG8_BAR; PG8_SCHED;
            PG8_LDB(B0, 1, 0); PG8_LDB(B1, 1, 1); PG8_SCHED; PG8_LDA(At, 1, 0); PG8_STAGE(PG8_SA(0, 1), a2 + hstepA, voffA);
            PG8_WAIT_V(8); PG8_WAIT_L(0); PG8_BAR; PG8_MMA(0, 0, At, B0); PG8_MMA(0, 1, At, B1); PG8_BAR; PG8_SCHED;
            PG8_LDA(At, 1, 1); PG8_STAGE(PG8_SB(1, 0), b3, voffB); PG8_STAGE(PG8_SB(1, 1), b3 + hstepB, voffB); PG8_STAGE(PG8_SA(1, 0), a3, voffA);
            PG8_WAIT_V(8); PG8_WAIT_L(0); PG8_BAR; PG8_MMA(1, 0, At, B0); PG8_MMA(1, 1, At, B1); PG8_BAR; PG8_SCHED;
        }
        if (wr == 0) PG8_BAR;
        const bool zero = E(acc, cur, wr, wc, fr, fq);
        if (!has_next) break;
        if (zero) {
#pragma unroll
            for (int a = 0; a < 2; ++a)
#pragma unroll
                for (int b = 0; b < 2; ++b)
#pragma unroll
                    for (int m = 0; m < 4; ++m)
#pragma unroll
                        for (int n = 0; n < 2; ++n) acc[a][b][m][n] = (f32x4){0.f, 0.f, 0.f, 0.f};
        }
        cur = nxt; cA = nA; cB = nB; ++ui;
        if (wr == 1) PG8_BAR;
    }
    PG8_WAIT_V(0);
    PG8_BAR;
#undef PG8_SA
#undef PG8_SB
#undef PG8_STAGE
#undef PG8_LDA
#undef PG8_LDB
#undef PG8_MMA
#undef PG8_WAIT_V
#undef PG8_WAIT_L
#undef PG8_BAR
#undef PG8_SCHED
}
}
using pg8::Unit;

struct SchedPlain {
    const bf16_t* A; const bf16_t* Bt; int lda, ldb, nM, nN, G, c;
    __device__ __forceinline__ bool next(int i, Unit& u) const { const int L = i * G + c; if (L >= nM * nN) return false; pg8::tile_of(L, nM, nN, u.pm, u.pn); u.aux = 0; return true; }
    __device__ __forceinline__ const char* a_ptr(const Unit& u) const { return (const char*)(A + (size_t)u.pm * 256 * lda); }
    __device__ __forceinline__ const char* b_ptr(const Unit& u) const { return (const char*)(Bt + (size_t)u.pn * 256 * ldb); }
};
struct SchedProj {
    const bf16_t* A; const bf16_t* Bt; int lda, ldb, nM, nN, G, c;
    __device__ __forceinline__ bool next(int i, Unit& u) const {
        if (G != 256) { const int L = i * G + c; if (L >= nM * nN) return false; pg8::tile_of(L, nM, nN, u.pm, u.pn); u.aux = 0; return true; }
        if (i >= 16) return false;
        const int x = c & 7; u.pm = 8 * x + ((c >> 3) & 7); u.pn = 4 * ((i + 2 * x) & 15) + (c >> 6); u.aux = 0; return true; }
    __device__ __forceinline__ const char* a_ptr(const Unit& u) const { return (const char*)(A + (size_t)u.pm * 256 * lda); }
    __device__ __forceinline__ const char* b_ptr(const Unit& u) const { return (const char*)(Bt + (size_t)u.pn * 256 * ldb); }
};
struct SchedMerge {
    const bf16_t* Y; const bf16_t* W; int G, c;
    __device__ __forceinline__ bool next(int i, Unit& u) const { const int j = i / 3, br = i - 3 * j; const int L = j * G + c; if (L >= 512) return false; pg8::tile_of(L, 64, 8, u.pm, u.pn); u.aux = br; return true; }
    __device__ __forceinline__ const char* a_ptr(const Unit& u) const { return (const char*)(Y + (size_t)u.pm * 256 * 3072 + u.aux * 1024); }
    __device__ __forceinline__ const char* b_ptr(const Unit& u) const { return (const char*)(W + (size_t)u.aux * 2048 * 1024 + (size_t)u.pn * 256 * 1024); }
};
struct SchedPool {
    const bf16_t* P; const bf16_t* W; int G, c;
    __device__ __forceinline__ bool next(int i, Unit& u) const { const int L = i * G + c; if (L >= 256) return false; u.pm = L >> 2; u.pn = L & 3; u.aux = 0; return true; }
    __device__ __forceinline__ const char* a_ptr(const Unit& u) const { return (const char*)(P + (size_t)u.pm * 256 * 1024 + u.pn * 256); }
    __device__ __forceinline__ const char* b_ptr(const Unit& u) const { return (const char*)(W + (size_t)u.pn * 65536); }
};

struct EpiProj {
    static constexpr bool PERM = true;
    bf16_t* P; const float* rope;
    __device__ __forceinline__ bool operator()(f32x4 (&acc)[2][2][4][2], const Unit& u, int wr, int wc, int fr, int fq) const {
        asm volatile("" : "+v"(fr), "+v"(fq));
        const int row0 = u.pm * 256 + wr * 64 + fr, col0 = u.pn * 256 + wc * 32 + 8 * fq;
        const int pn = u.pn;
        int mode;
        if (pn < 4) mode = 3; else if (pn < 8) mode = 4; else if (pn < 12) mode = 0; else if (pn < 16) mode = 1; else if (pn < 20) mode = 5; else if (pn < 28) mode = 0;
        else if (pn < 32) mode = 1; else if (pn < 36) mode = 0; else if (pn < 40) mode = 1; else mode = 2;
        const int j0 = wc * 16 + 4 * fq;
#pragma unroll
        for (int ai = 0; ai < 2; ++ai) {
            f32x4 csa[4], csb[4];
#pragma unroll
            for (int m = 0; m < 4; ++m) { csa[m] = (f32x4){1.f, 0.f, 1.f, 0.f}; csb[m] = csa[m]; }
            if (mode == 3 || mode == 4) {
#pragma unroll
                for (int m = 0; m < 4; ++m) { const float* tp = rope + ((size_t)((row0 + ai * 128 + m * 16) & (SEQ - 1)) * 64 + j0) * 2; csa[m] = *(const f32x4*)tp; csb[m] = *(const f32x4*)(tp + 4); }
                asm volatile("" : "+v"(csa[0]), "+v"(csa[1]), "+v"(csa[2]), "+v"(csa[3]), "+v"(csb[0]), "+v"(csb[1]), "+v"(csb[2]), "+v"(csb[3]));
            }
#pragma unroll
            for (int m = 0; m < 4; ++m) {
                const int row = row0 + ai * 128 + m * 16;
                bf16_t* rowp = P + (size_t)row * NP + col0;
                const f32x4 cs0 = csa[m], cs1 = csb[m];
#pragma unroll
                for (int bj = 0; bj < 2; ++bj) {
                    f32x4 v0 = acc[ai][bj][m][0], v1 = acc[ai][bj][m][1];
                    if (mode == 1) {
#pragma unroll
                        for (int j = 0; j < 4; ++j) { v0[j] = fast_silu(v0[j]); v1[j] = fast_silu(v1[j]); }
                    } else if (mode == 2) {
#pragma unroll
                        for (int j = 0; j < 4; ++j) { v0[j] = fast_sigmoid(fminf(fmaxf(v0[j], -60.f), 60.f)); v1[j] = fast_sigmoid(fminf(fmaxf(v1[j], -60.f), 60.f)); }
                    } else if (mode == 3 || mode == 4) {
                        const float sc = (mode == 4) ? 0.08838834764831845f : 1.0f;
                        f32x4 o0, o1;
                        o0[0] = (v0[0] * cs0[0] - v0[1] * cs0[1]) * sc; o0[1] = (v0[0] * cs0[1] + v0[1] * cs0[0]) * sc;
                        o0[2] = (v0[2] * cs0[2] - v0[3] * cs0[3]) * sc; o0[3] = (v0[2] * cs0[3] + v0[3] * cs0[2]) * sc;
                        o1[0] = (v1[0] * cs1[0] - v1[1] * cs1[1]) * sc; o1[1] = (v1[0] * cs1[1] + v1[1] * cs1[0]) * sc;
                        o1[2] = (v1[2] * cs1[2] - v1[3] * cs1[3]) * sc; o1[3] = (v1[2] * cs1[3] + v1[3] * cs1[2]) * sc;
                        v0 = o0; v1 = o1;
                    } else if (mode == 5) { v0 = v0 * (0.08838834764831845f * LOG2E); v1 = v1 * (0.08838834764831845f * LOG2E); }
                    u32x4 w; w.x = pk2(v0[0], v0[1]); w.y = pk2(v0[2], v0[3]); w.z = pk2(v1[0], v1[1]); w.w = pk2(v1[2], v1[3]);
                    *(u32x4*)(rowp + bj * 128) = w;
                }
            }
        }
        return true;
    }
};
struct EpiPool {
    static constexpr bool PERM = true;
    const bf16_t* P; bf16_t* Y; const float* scale;
    __device__ __forceinline__ bool operator()(f32x4 (&acc)[2][2][4][2], const Unit& u, int wr, int wc, int fr, int fq) const {
        asm volatile("" : "+v"(fr), "+v"(fq));
        const int row0 = u.pm * 256 + wr * 64 + fr, col0 = u.pn * 256 + wc * 32 + 8 * fq;
        f32x4 sc[2][2];
#pragma unroll
        for (int bj = 0; bj < 2; ++bj) { sc[bj][0] = *(const f32x4*)(scale + col0 + bj * 128); sc[bj][1] = *(const f32x4*)(scale + col0 + bj * 128 + 4); }
#pragma unroll
        for (int ai = 0; ai < 2; ++ai) {
            u32x4 z[4][2];
#pragma unroll
            for (int m = 0; m < 4; ++m)
#pragma unroll
                for (int bj = 0; bj < 2; ++bj) z[m][bj] = *(const u32x4*)((const char*)P + (unsigned)(((row0 + ai * 128 + m * 16) * NP + COL_PZ + col0 + bj * 128) * 2));
            asm volatile("" : "+v"(z[0][0]), "+v"(z[0][1]), "+v"(z[1][0]), "+v"(z[1][1]), "+v"(z[2][0]), "+v"(z[2][1]), "+v"(z[3][0]), "+v"(z[3][1]));
#pragma unroll
            for (int m = 0; m < 4; ++m)
#pragma unroll
                for (int bj = 0; bj < 2; ++bj) {
                    const u32x4 zz = z[m][bj];
                    const f32x4 v0 = acc[ai][bj][m][0] * sc[bj][0], v1 = acc[ai][bj][m][1] * sc[bj][1];
                    u32x4 w; w.x = pk2(v0[0] * bflo(zz.x), v0[1] * bfhi(zz.x)); w.y = pk2(v0[2] * bflo(zz.y), v0[3] * bfhi(zz.y));
                    w.z = pk2(v1[0] * bflo(zz.z), v1[1] * bfhi(zz.z)); w.w = pk2(v1[2] * bflo(zz.w), v1[3] * bfhi(zz.w));
                    *(u32x4*)((char*)Y + (unsigned)(((row0 + ai * 128 + m * 16) * 3072 + 2048 + col0 + bj * 128) * 2)) = w;
                }
        }
        return true;
    }
};
struct EpiMerge {
    static constexpr bool PERM = true;
    const bf16_t* P; bf16_t* O;
    __device__ __forceinline__ bool operator()(f32x4 (&acc)[2][2][4][2], const Unit& u, int wr, int wc, int fr, int fq) const {
        asm volatile("" : "+v"(fr), "+v"(fq));
        const int row0 = u.pm * 256 + wr * 64 + fr, col0 = u.pn * 256 + wc * 32 + 8 * fq;
        const int br = u.aux;
        const int cnum = (br == 0) ? COL_GA : (br == 1) ? COL_GB : COL_GC;
        const int cden = (br == 0) ? COL_GB : COL_GC;
#pragma unroll
        for (int ai = 0; ai < 2; ++ai)
#pragma unroll
            for (int mp = 0; mp < 2; ++mp) {
                u32x4 gn[2][2], gd[2][2];
#pragma unroll
                for (int mm = 0; mm < 2; ++mm)
#pragma unroll
                    for (int bj = 0; bj < 2; ++bj) { const bf16_t* prow = P + (size_t)(row0 + ai * 128 + (2 * mp + mm) * 16) * NP + col0 + bj * 128;
                        gn[mm][bj] = *(const u32x4*)(prow + cnum); gd[mm][bj] = *(const u32x4*)(prow + cden); }
                asm volatile("" : "+v"(gn[0][0]), "+v"(gn[0][1]), "+v"(gn[1][0]), "+v"(gn[1][1]), "+v"(gd[0][0]), "+v"(gd[0][1]), "+v"(gd[1][0]), "+v"(gd[1][1]));
#pragma unroll
                for (int mm = 0; mm < 2; ++mm)
#pragma unroll
                    for (int bj = 0; bj < 2; ++bj) {
                        const int m = 2 * mp + mm; const u32x4 g = gn[mm][bj], d = gd[mm][bj];
                        f32x4 f0 = (f32x4){bflo(g.x), bfhi(g.x), bflo(g.y), bfhi(g.y)}, f1 = (f32x4){bflo(g.z), bfhi(g.z), bflo(g.w), bfhi(g.w)};
                        if (br < 2) {
                            f0[0] *= __builtin_amdgcn_rcpf(bflo(d.x)); f0[1] *= __builtin_amdgcn_rcpf(bfhi(d.x)); f0[2] *= __builtin_amdgcn_rcpf(bflo(d.y)); f0[3] *= __builtin_amdgcn_rcpf(bfhi(d.y));
                            f1[0] *= __builtin_amdgcn_rcpf(bflo(d.z)); f1[1] *= __builtin_amdgcn_rcpf(bfhi(d.z)); f1[2] *= __builtin_amdgcn_rcpf(bflo(d.w)); f1[3] *= __builtin_amdgcn_rcpf(bfhi(d.w));
                        }
                        acc[ai][bj][m][0] = acc[ai][bj][m][0] * f0; acc[ai][bj][m][1] = acc[ai][bj][m][1] * f1;
                        if (br == 2) {
                            const f32x4 v0 = acc[ai][bj][m][0], v1 = acc[ai][bj][m][1];
                            u32x4 w; w.x = pk2(v0[0], v0[1]); w.y = pk2(v0[2], v0[3]); w.z = pk2(v1[0], v1[1]); w.w = pk2(v1[2], v1[3]);
                            *(u32x4*)(O + (size_t)(row0 + ai * 128 + m * 16) * DM + col0 + bj * 128) = w;
                        }
                    }
            }
        return br == 2;
    }
};
struct EpiOut {
    static constexpr bool PERM = false;
    const float* xin; float* xout;
    __device__ __forceinline__ bool operator()(f32x4 (&acc)[2][2][4][2], const Unit& u, int wr, int wc, int fr, int fq) const {
        asm volatile("" : "+v"(fr), "+v"(fq));
        const int row0 = u.pm * 256 + wr * 64 + fr, col0 = u.pn * 256 + wc * 32 + 4 * fq;
#pragma unroll
        for (int ai = 0; ai < 2; ++ai)
#pragma unroll
            for (int mp = 0; mp < 2; ++mp) {
                f32x4 xo[2][2][2];
#pragma unroll
                for (int mm = 0; mm < 2; ++mm)
#pragma unroll
                    for (int bj = 0; bj < 2; ++bj)
#pragma unroll
                        for (int n = 0; n < 2; ++n) xo[mm][bj][n] = *(const f32x4*)(xin + (size_t)(row0 + ai * 128 + (2 * mp + mm) * 16) * DM + col0 + bj * 128 + n * 16);
                asm volatile("" : "+v"(xo[0][0][0]), "+v"(xo[0][0][1]), "+v"(xo[0][1][0]), "+v"(xo[0][1][1]), "+v"(xo[1][0][0]), "+v"(xo[1][0][1]), "+v"(xo[1][1][0]), "+v"(xo[1][1][1]));
#pragma unroll
                for (int mm = 0; mm < 2; ++mm)
#pragma unroll
                    for (int bj = 0; bj < 2; ++bj)
#pragma unroll
                        for (int n = 0; n < 2; ++n) *(f32x4*)(xout + (size_t)(row0 + ai * 128 + (2 * mp + mm) * 16) * DM + col0 + bj * 128 + n * 16) = xo[mm][bj][n] + acc[ai][bj][2 * mp + mm][n];
            }
        return true;
    }
};

struct Params {
    const float* x; const float* norm_g; const float* w_in; const float* ret_gn_g; const float* fox_b_f; const float* pool_w; const float* pool_scale;
    const float* w_ret; const float* w_fox; const float* w_pool; const float* w_out; const float* final_g;
    float* out; unsigned char* ws;
};

#define XB_TMO      128
#define XB_XCNT(j)  (256  + 64 * (j))
#define XB_XSUB(j)  (1280 + 64 * (j))
#define XB_XGEN(j)  (2304 + 64 * (j))
#define XB_TOP      3328
#define XB_TOPGEN   3392
#define XCD_BAR_WORDS 3456
#define XB_SPIN_CAP (1u << 18)

__device__ __forceinline__ unsigned xb_ld(unsigned* p)              { return __hip_atomic_load(p, __ATOMIC_RELAXED, __HIP_MEMORY_SCOPE_AGENT); }
__device__ __forceinline__ unsigned xb_add(unsigned* p, unsigned v) { return __hip_atomic_fetch_add(p, v, __ATOMIC_RELAXED, __HIP_MEMORY_SCOPE_AGENT); }
__device__ __forceinline__ unsigned xb_xcc_id() { return (unsigned)__builtin_amdgcn_s_getreg((3 << 11) | 20) & 0xFu; }
#define XB_SPIN(cond, bar) do { unsigned _sp = 0; while (cond) { __builtin_amdgcn_s_sleep(1); \
    if ((++_sp & 255u) == 0u) { if (xb_ld(&(bar)[XB_TMO])) break; if (_sp > XB_SPIN_CAP) { atomicAdd(&(bar)[XB_TMO], 1u); break; } } } } while (0)

struct XcdBarrier {
    unsigned* bar; unsigned x;
    volatile LAS unsigned* st;
};

__device__ __forceinline__ XcdBarrier xcd_barrier_post(unsigned* bar, volatile LAS unsigned* st) {
    XcdBarrier b; b.bar = bar; b.x = xb_xcc_id(); b.st = st;
    if (threadIdx.x == 0) (void)xb_add(&bar[XB_XCNT(b.x)], 1u);
    return b;
}
__device__ __forceinline__ void xcd_barrier_complete(unsigned* bar, unsigned x, unsigned& nloc, unsigned& nx) {
    const unsigned G = gridDim.x * gridDim.y * gridDim.z;
    unsigned sum, cnt, mine, sp = 0u;
    for (;;) {
        sum = 0u; cnt = 0u; mine = 0u;
#pragma unroll
        for (unsigned j = 0; j < 16; ++j) { const unsigned c = xb_ld(&bar[XB_XCNT(j)]); sum += c; cnt += (c > 0u) ? 1u : 0u; mine = (j == x) ? c : mine; }
        if (sum == G) break;
        __builtin_amdgcn_s_sleep(1);
        if ((++sp & 255u) == 0u) { if (xb_ld(&bar[XB_TMO])) break; if (sp > XB_SPIN_CAP) { atomicAdd(&bar[XB_TMO], 1u); break; } }
    }
    nloc = mine > 0u ? mine : 1u; nx = cnt > 0u ? cnt : 1u;
}

__device__ __forceinline__ void xcd_barrier(const XcdBarrier& b) {
    asm volatile("s_waitcnt vmcnt(0)" ::: "memory");
    __syncthreads();
    if (threadIdx.x == 0) {
        unsigned* bar = b.bar;
        __builtin_amdgcn_s_waitcnt(0);
        unsigned nloc = b.st[0], nx = b.st[1];
        if (nloc == 0u) { xcd_barrier_complete(bar, b.x, nloc, nx); b.st[0] = nloc; b.st[1] = nx; }
        const unsigned old = xb_add(&bar[XB_XSUB(b.x)], 1u);
        const unsigned gen = old / nloc;
        if (old + 1u == (gen + 1u) * nloc) {
            __builtin_amdgcn_fence(__ATOMIC_RELEASE, "agent");
            asm volatile("s_waitcnt vmcnt(0)" ::: "memory");
            const unsigned og = xb_add(&bar[XB_TOP], 1u);
            const unsigned tg = og / nx;
            if (og + 1u == (tg + 1u) * nx) xb_add(&bar[XB_TOPGEN], 1u);
            else XB_SPIN(xb_ld(&bar[XB_TOPGEN]) == tg, bar);
            __builtin_amdgcn_fence(__ATOMIC_ACQUIRE, "agent");
            xb_add(&bar[XB_XGEN(b.x)], 1u);
            asm volatile("s_waitcnt vmcnt(0)" ::: "memory");
        } else {
            XB_SPIN(xb_ld(&bar[XB_XGEN(b.x)]) == gen, bar);
            __builtin_amdgcn_fence(__ATOMIC_ACQUIRE, "agent");
            asm volatile("s_waitcnt vmcnt(0)" ::: "memory");
        }
    }
    __syncthreads();
}


typedef const Params __attribute__((address_space(4))) CParams;
__device__ __forceinline__ Params loadp() {
    const CParams* pp = (const CParams*)__builtin_amdgcn_kernarg_segment_ptr();
    asm volatile("" : "+s"(pp));
    Params p;
    p.x = pp->x; p.norm_g = pp->norm_g; p.w_in = pp->w_in; p.ret_gn_g = pp->ret_gn_g; p.fox_b_f = pp->fox_b_f; p.pool_w = pp->pool_w; p.pool_scale = pp->pool_scale;
    p.w_ret = pp->w_ret; p.w_fox = pp->w_fox; p.w_pool = pp->w_pool; p.w_out = pp->w_out; p.final_g = pp->final_g; p.out = pp->out; p.ws = pp->ws;
    return p;
}
__device__ __forceinline__ int launder_s(int v) { asm volatile("" : "+s"(v)); return v; }
__device__ __forceinline__ void geom(int& G, int& bx, int& vcu) { G = launder_s((int)gridDim.x); bx = launder_s((int)blockIdx.x); vcu = (G % 8 == 0) ? (bx % 8) * (G / 8) + bx / 8 : bx; }
__device__ __forceinline__ const float* sel_ptr(const float* a, const float* b, int useb) { const uintptr_t m = (uintptr_t)0 - (uintptr_t)(useb != 0); return (const float*)(((uintptr_t)a & ~m) | ((uintptr_t)b & m)); }

__device__ __forceinline__ int win_dest(int n) {
    if (n < 2048) { const int head = n >> 7, w = n & 127; return head * 128 + 2 * (w & 63) + (w >> 6); }
    if (n < 8192) return n;
    if (n < 8200) return -1;
    return n - 8;
}
struct TrItem { const float* W; bf16_t* WT; int ldw, ncols, K, item; bool winmap; };
__device__ __forceinline__ void tr_load(const TrItem& t, f32x4 (&ld)[8], int lane) {
    const int nblk = (t.ncols + 31) >> 5, kb = t.item / nblk, nb = t.item - kb * nblk, k0 = 64 * kb, n0 = 32 * nb;
    const int c4 = lane & 7, kr = lane >> 3; const bool okc = (n0 + 4 * c4) < t.ncols;
#pragma unroll
    for (int i = 0; i < 8; ++i) ld[i] = okc ? *(const f32x4*)(t.W + (size_t)(k0 + 8 * i + kr) * t.ldw + n0 + 4 * c4) : (f32x4){0.f, 0.f, 0.f, 0.f};
}
__device__ __forceinline__ void tr_finish(const TrItem& t, const f32x4 (&ld)[8], LAS float* scr, int lane) {
    const int nblk = (t.ncols + 31) >> 5, kb = t.item / nblk, nb = t.item - kb * nblk, k0 = 64 * kb, n0 = 32 * nb;
    const int c4 = lane & 7, kr = lane >> 3;
#pragma unroll
    for (int i = 0; i < 8; ++i) { LAS float* d = scr + (8 * i + kr) * 33 + 4 * c4; d[0] = ld[i].x; d[1] = ld[i].y; d[2] = ld[i].z; d[3] = ld[i].w; }
    LDS_WAIT(); asm volatile("" ::: "memory");
    const int c = lane & 7;
#pragma unroll
    for (int j = 0; j < 4; ++j) { const int n = (lane >> 3) + 8 * j; const int ns = n0 + n; const int dest = (ns < t.ncols) ? (t.winmap ? win_dest(ns) : ns) : -1;
        const LAS float* sp = scr + (8 * c) * 33 + n;
        u32x4 o; o.x = pk2(sp[0 * 33], sp[1 * 33]); o.y = pk2(sp[2 * 33], sp[3 * 33]); o.z = pk2(sp[4 * 33], sp[5 * 33]); o.w = pk2(sp[6 * 33], sp[7 * 33]);
        if (dest >= 0) *(u32x4*)(t.WT + (size_t)dest * t.K + k0 + 8 * c) = o; }
    LDS_WAIT(); asm volatile("" ::: "memory");
}

__device__ __forceinline__ void phase_a(LAS unsigned char* lds, int layer) {
    const Params p = loadp(); int G, bx, vcu; geom(G, bx, vcu); layer = launder_s(layer);
    const int tid = tid_l(), lane = tid & 63, wave = __builtin_amdgcn_readfirstlane(tid >> 6);
    unsigned char* ws = p.ws;
    const float* w_in = p.w_in + (size_t)layer * DM * CIN;
    LAS float* wff = (LAS float*)lds;
    for (int k = tid; k < DM; k += NTHREADS) {
        const float* src = w_in + (size_t)k * CIN + 8192;
        const f32x4 a = *(const f32x4*)src, b = *(const f32x4*)(src + 4);
        const int j = k >> 8, l = (k >> 2) & 63, i = k & 3;
        LAS float* d = wff + ((j * 4 + i) * 64 + l) * 8;
        *(LAS f32x4*)d = a; *(LAS f32x4*)(d + 4) = b;
    }
    __syncthreads();
    LAS float* scr = (LAS float*)(lds + 65536 + wave * 8448);
    const int gw = vcu * NWAVES + wave, NGW = G * NWAVES;
    constexpr int I_IN = 32 * 513, I_BR = 16 * 64, I_OUT = 32 * 64, I_PW = 4 * 8;
    constexpr int NITEMS = I_IN + 3 * I_BR + I_OUT + 4 * I_PW;
    auto decode = [&](int it) -> TrItem {
        TrItem t; int r = it; unsigned char* wsb = ws;
        if (r < I_IN) { t.W = w_in; t.WT = (bf16_t*)(wsb + WS_WIN); t.ldw = CIN; t.ncols = CIN; t.K = DM; t.item = r; t.winmap = true; return t; } r -= I_IN;
        t.winmap = false;
        if (r < 3 * I_BR) { const int q = r / I_BR; r -= q * I_BR; const float* wb = (q == 0) ? p.w_ret : (q == 1) ? p.w_fox : p.w_pool;
            t.W = wb + (size_t)layer * 1024 * DM; t.WT = (bf16_t*)(wsb + WS_WBR) + (size_t)q * 2048 * 1024; t.ldw = DM; t.ncols = DM; t.K = 1024; t.item = r; return t; } r -= 3 * I_BR;
        if (r < I_OUT) { t.W = p.w_out + (size_t)layer * DM * DM; t.WT = (bf16_t*)(wsb + WS_WOUT); t.ldw = DM; t.ncols = DM; t.K = DM; t.item = r; return t; } r -= I_OUT;
        { const int g = r / I_PW; t.W = p.pool_w + (size_t)layer * 4 * 65536 + (size_t)g * 65536; t.WT = (bf16_t*)(wsb + WS_WPOOL) + (size_t)g * 65536; t.ldw = 256; t.ncols = 256; t.K = 256; t.item = r - g * I_PW; return t; }
    };
    {
        int it = gw;
        if (it < NITEMS) {
            TrItem cur = decode(it); f32x4 lda[8], ldb[8];
            tr_load(cur, lda, lane);
            for (;;) {
                const int nit = it + NGW; const bool hn = nit < NITEMS;
                TrItem nxt = cur; if (hn) { nxt = decode(nit); tr_load(nxt, ldb, lane); }
                tr_finish(cur, lda, scr, lane);
                if (!hn) break;
#pragma unroll
                for (int i = 0; i < 8; ++i) lda[i] = ldb[i];
                cur = nxt; it = nit;
            }
        }
    }
    if (layer == 0) {
        float* rope = (float*)(ws + WS_ROPE);
        for (int idx = (vcu * NTHREADS + tid); idx < SEQ * 64; idx += G * NTHREADS) {
            const int pos = idx >> 6, j = idx & 63;
            const float inv = exp2f(-(float)j * (13.287712379549449f / 64.0f));
            const float ang = (float)pos * inv;
            double rev = (double)ang * 0.15915494309189535; rev -= floor(rev);
            const float rf = (float)rev;
            rope[2 * idx] = __builtin_amdgcn_cosf(rf); rope[2 * idx + 1] = __builtin_amdgcn_sinf(rf);
        }
    }
    const float* xin = sel_ptr(p.x, p.out, layer);
    const float* g = p.norm_g + (size_t)layer * DM;
    bf16_t* H = (bf16_t*)(ws + WS_H);
    float* lsig = (float*)(ws + WS_LSIG);
    const float* bf = p.fox_b_f + layer * 8;
    f32x4 gv[8];
#pragma unroll
    for (int j = 0; j < 8; ++j) gv[j] = *((const f32x4*)g + lane + 64 * j);
    f32x4 vn[8];
    if (gw < M) {
#pragma unroll
        for (int j = 0; j < 8; ++j) vn[j] = *((const f32x4*)(xin + (size_t)gw * DM) + lane + 64 * j);
    }
    for (int m = gw; m < M; m += NGW) {
        f32x4 v[8]; float ss = 0.f;
#pragma unroll
        for (int j = 0; j < 8; ++j) { v[j] = vn[j]; ss += (v[j].x * v[j].x + v[j].y * v[j].y) + (v[j].z * v[j].z + v[j].w * v[j].w); }
        if (m + NGW < M) {
#pragma unroll
            for (int j = 0; j < 8; ++j) vn[j] = *((const f32x4*)(xin + (size_t)(m + NGW) * DM) + lane + 64 * j);
        }
        const float rstd = 1.0f / sqrtf(wave_sum(ss) * (1.0f / DM) + EPS);
        float fa[8];
#pragma unroll
        for (int o = 0; o < 8; ++o) fa[o] = 0.f;
        u32x2* o8 = (u32x2*)(H + (size_t)m * DM) + lane;
#pragma unroll
        for (int j = 0; j < 8; ++j) {
            const f32x4 hv = v[j] * rstd * gv[j];
            u32x2 w; w.x = pk2(hv.x, hv.y); w.y = pk2(hv.z, hv.w); o8[64 * j] = w;
#pragma unroll
            for (int i = 0; i < 4; ++i) {
                const LAS float* wp = wff + ((j * 4 + i) * 64 + lane) * 8;
                const f32x4 wa = *(const LAS f32x4*)wp, wb = *(const LAS f32x4*)(wp + 4);
                const float hh = hv[i];
                fa[0] += hh * wa.x; fa[1] += hh * wa.y; fa[2] += hh * wa.z; fa[3] += hh * wa.w;
                fa[4] += hh * wb.x; fa[5] += hh * wb.y; fa[6] += hh * wb.z; fa[7] += hh * wb.w;
            }
            asm volatile("" ::: "memory");
        }
        float mine = 0.f;
#pragma unroll
        for (int o = 0; o < 8; ++o) { const float t = wave_sum(fa[o]); mine = (lane == o) ? t : mine; }
        if (lane < 8) { const float xl = mine + bf[lane]; lsig[(size_t)m * 8 + lane] = fminf(xl, 0.f) - log1pf(__expf(-fabsf(xl))); }
    }
    __syncthreads();
}

__device__ __forceinline__ int swap23(int t) { return (t & ~12) | ((t & 4) << 1) | ((t & 8) >> 1); }
__device__ __forceinline__ int tswz(int row) { return ((row >> 3) ^ (row & 7)) & 15; }
__device__ __forceinline__ int timg(int row, int pos) { return row * 256 + ((((pos >> 3) ^ tswz(row)) << 4) | ((pos & 7) << 1)); }

template <bool RET>
__device__ __forceinline__ void c1_chunk_unit(const Params& p, LAS unsigned char* lds, int layer, int unit) {
    const int tid = tid_l(), lane = tid & 63, wave = __builtin_amdgcn_readfirstlane(tid >> 6);
    const int bh = unit >> 4, c = unit & 15, b = bh >> 3, h = bh & 7;
    const bf16_t* PROJ = (const bf16_t*)(p.ws + WS_PROJ);
    const size_t tok0 = (size_t)b * SEQ + c * 128;
    LAS unsigned char* VtL = lds; LAS unsigned char* KtL = lds + 32768;
    const float lg2 = log1pf(-exp2f(-5.0f - (float)h)) * LOG2E;
    {
        const int T = tid >> 4, ch = tid & 15, pos0 = swap23(4 * T);
        const bf16_t* src = PROJ + (tok0 + 4 * T) * NP + h * 128 + ch * 8;
        u32x4 vv[4], kv[4];
#pragma unroll
        for (int j = 0; j < 4; ++j) { vv[j] = *(const u32x4*)(src + (size_t)j * NP + (RET ? COL_RV : COL_FV)); if (RET) kv[j] = *(const u32x4*)(src + (size_t)j * NP + COL_RK); }
#pragma unroll
        for (int e = 0; e < 4; ++e) {
            const unsigned w0 = vv[0][e], w1 = vv[1][e], w2 = vv[2][e], w3 = vv[3][e];
            u32x2 lo, hi; lo.x = (w0 & 0xffffu) | (w1 << 16); lo.y = (w2 & 0xffffu) | (w3 << 16); hi.x = (w0 >> 16) | (w1 & 0xffff0000u); hi.y = (w2 >> 16) | (w3 & 0xffff0000u);
            *(LAS u32x2*)(VtL + timg(ch * 8 + 2 * e, pos0)) = lo;
            *(LAS u32x2*)(VtL + timg(ch * 8 + 2 * e + 1, pos0)) = hi;
        }
        if (RET) {
            float z[4];
#pragma unroll
            for (int j = 0; j < 4; ++j) z[j] = __builtin_amdgcn_exp2f(lg2 * (float)(127 - (4 * T + j)));
#pragma unroll
            for (int e = 0; e < 4; ++e) {
                const unsigned w0 = kv[0][e], w1 = kv[1][e], w2 = kv[2][e], w3 = kv[3][e];
                u32x2 lo, hi; lo.x = pk2(bflo(w0) * z[0], bflo(w1) * z[1]); lo.y = pk2(bflo(w2) * z[2], bflo(w3) * z[3]);
                hi.x = pk2(bfhi(w0) * z[0], bfhi(w1) * z[1]); hi.y = pk2(bfhi(w2) * z[2], bfhi(w3) * z[3]);
                *(LAS u32x2*)(KtL + timg(ch * 8 + 2 * e, pos0)) = lo;
                *(LAS u32x2*)(KtL + timg(ch * 8 + 2 * e + 1, pos0)) = hi;
            }
        }
    }
    __syncthreads();
    bf16_t* VT = (bf16_t*)(p.ws + (RET ? WS_VTR : WS_VTF));
#pragma unroll
    for (int i = 0; i < 4; ++i) {
        const int pc = tid + 512 * i, d = pc >> 4, ch = pc & 15;
        const u32x4 w = *(const LAS u32x4*)(VtL + d * 256 + ((ch ^ tswz(d)) << 4));
        *(u32x4*)(VT + ((size_t)bh * 128 + d) * SEQ + c * 128 + ch * 8) = w;
    }
    if (RET) {
        const int l31 = lane & 31, hh = lane >> 5;
        const int bv = wave >> 1, bk0 = 2 * (wave & 1);
        f32x16 a0 = {}, a1 = {};
        const int rv = 32 * bv + l31, rk0 = 32 * bk0 + l31, rk1 = rk0 + 32;
#pragma unroll
        for (int s = 0; s < 8; ++s) {
            const int chunk = 2 * s + hh;
            const bf16x8 A = *(const LAS bf16x8*)(VtL + rv * 256 + ((chunk ^ tswz(rv)) << 4));
            const bf16x8 B0 = *(const LAS bf16x8*)(KtL + rk0 * 256 + ((chunk ^ tswz(rk0)) << 4));
            const bf16x8 B1 = *(const LAS bf16x8*)(KtL + rk1 * 256 + ((chunk ^ tswz(rk1)) << 4));
            a0 = __builtin_amdgcn_mfma_f32_32x32x16_bf16(A, B0, a0, 0, 0, 0);
            a1 = __builtin_amdgcn_mfma_f32_32x32x16_bf16(A, B1, a1, 0, 0, 0);
        }
        float* ST = (float*)(p.ws + WS_STATE) + (size_t)unit * 16384;
#pragma unroll
        for (int r = 0; r < 16; ++r) {
            const int dv = 32 * bv + (r & 3) + 8 * (r >> 2) + 4 * hh;
            ST[dv * 128 + 32 * bk0 + l31] = a0[r];
            ST[dv * 128 + 32 * bk0 + 32 + l31] = a1[r];
        }
    }
    __syncthreads();
}

template <int W>
__device__ __forceinline__ void pooled_rows(const bf16_t* PROJ, bf16_t* PO, int r0, int col) {
    constexpr int NL = 8 + W - 1;
    const int t0 = r0 & (SEQ - 1);
    u32x4 L[NL];
#pragma unroll
    for (int j = 0; j < NL; ++j) { const int dt = j - (W - 1); L[j] = (t0 + dt >= 0) ? *(const u32x4*)(PROJ + (size_t)(r0 + dt) * NP + COL_PU + col) : (u32x4){0u, 0u, 0u, 0u}; }
    float s[8];
#pragma unroll
    for (int e = 0; e < 8; ++e) s[e] = 0.f;
#pragma unroll
    for (int j = 0; j < W - 1; ++j) { s[0] += bflo(L[j].x); s[1] += bfhi(L[j].x); s[2] += bflo(L[j].y); s[3] += bfhi(L[j].y); s[4] += bflo(L[j].z); s[5] += bfhi(L[j].z); s[6] += bflo(L[j].w); s[7] += bfhi(L[j].w); }
#pragma unroll
    for (int k = 0; k < 8; ++k) {
        const u32x4 nw = L[k + W - 1];
        s[0] += bflo(nw.x); s[1] += bfhi(nw.x); s[2] += bflo(nw.y); s[3] += bfhi(nw.y); s[4] += bflo(nw.z); s[5] += bfhi(nw.z); s[6] += bflo(nw.w); s[7] += bfhi(nw.w);
        const int n = (t0 + k + 1 < W) ? (t0 + k + 1) : W;
        const float inv = 1.0f / (float)n;
        u32x4 o;
        o.x = pk2(s[0] * inv - bflo(nw.x), s[1] * inv - bfhi(nw.x)); o.y = pk2(s[2] * inv - bflo(nw.y), s[3] * inv - bfhi(nw.y));
        o.z = pk2(s[4] * inv - bflo(nw.z), s[5] * inv - bfhi(nw.z)); o.w = pk2(s[6] * inv - bflo(nw.w), s[7] * inv - bfhi(nw.w));
        *(u32x4*)(PO + (size_t)(r0 + k) * 1024 + col) = o;
        const u32x4 od = L[k];
        s[0] -= bflo(od.x); s[1] -= bfhi(od.x); s[2] -= bflo(od.y); s[3] -= bfhi(od.y); s[4] -= bflo(od.z); s[5] -= bfhi(od.z); s[6] -= bflo(od.w); s[7] -= bfhi(od.w);
    }
}
__device__ __forceinline__ void c1_pooled_unit(const Params& p, int unit) {
    const int tid = tid_l(), lane = tid & 63, w8 = __builtin_amdgcn_readfirstlane(tid >> 6);
    const bf16_t* PROJ = (const bf16_t*)(p.ws + WS_PROJ);
    bf16_t* PO = (bf16_t*)(p.ws + WS_POOLED);
    const int g = w8 & 3, col = g * 256 + (lane & 31) * 8;
    const int strip = (w8 >> 2) * 2 + (lane >> 5);
#pragma unroll 1
    for (int pass = 0; pass < 2; ++pass) {
        const int r0 = unit * 64 + strip * 16 + pass * 8;
        if (g == 0) pooled_rows<2>(PROJ, PO, r0, col);
        else if (g == 1) pooled_rows<4>(PROJ, PO, r0, col);
        else if (g == 2) pooled_rows<8>(PROJ, PO, r0, col);
        else pooled_rows<16>(PROJ, PO, r0, col);
    }
}

__device__ __forceinline__ void c1_cumsum_unit(const Params& p, int b) {
    const int tid = tid_l(), lane = tid & 63, h = tid >> 6;
    const float* lsig = (const float*)(p.ws + WS_LSIG) + ((size_t)b * SEQ + lane) * 8 + h;
    float* cum = (float*)(p.ws + WS_CUM) + (size_t)(b * 8 + h) * SEQ + lane;
    float v[32];
#pragma unroll
    for (int i = 0; i < 32; ++i) v[i] = lsig[(size_t)i * 64 * 8];
    float carry = 0.f;
#pragma unroll
    for (int i = 0; i < 32; ++i) {
        float inc = v[i];
#pragma unroll
        for (int o = 1; o < 64; o <<= 1) { const float t = __shfl_up(inc, o); if (lane >= o) inc += t; }
        inc += carry;
        cum[i * 64] = inc * LOG2E;
        carry = __shfl(inc, 63);
    }
}

__device__ __forceinline__ void phase_c1(LAS unsigned char* lds, int layer) {
    const Params p = loadp(); int G, bx, vcu; geom(G, bx, vcu); layer = launder_s(layer);
    constexpr int NU = 1024 + 1024 + 256 + 8;
    for (int u = vcu; u < NU; u += G) {
        if (u < 1024) c1_chunk_unit<true>(p, lds, layer, u);
        else if (u < 2048) c1_chunk_unit<false>(p, lds, layer, u - 1024);
        else if (u < 2304) c1_pooled_unit(p, u - 2048);
        else c1_cumsum_unit(p, u - 2304);
    }
}

__device__ __forceinline__ void phase_c1b() {
    const Params p = loadp(); int G, bx, vcu; geom(G, bx, vcu);
    const float* ST = (const float*)(p.ws + WS_STATE);
    bf16_t* SC = (bf16_t*)(p.ws + WS_STATEC);
    for (int idx = vcu * NTHREADS + tid_l(); idx < 64 * 4096; idx += G * NTHREADS) {
        const int bh = idx >> 12, e4 = idx & 4095, h = bh & 7;
        const float gch = exp2f(log1pf(-exp2f(-5.0f - (float)h)) * LOG2E * 128.0f);
        const size_t off0 = (size_t)bh * 16 * 16384 + e4 * 4;
        f32x4 sv[15];
#pragma unroll
        for (int c = 0; c < 15; ++c) sv[c] = *(const f32x4*)(ST + off0 + (size_t)c * 16384);
        f32x4 run = (f32x4){0.f, 0.f, 0.f, 0.f};
#pragma unroll
        for (int c = 1; c < 16; ++c) {
            run = run * gch + sv[c - 1];
            u32x2 w; w.x = pk2(run.x, run.y); w.y = pk2(run.z, run.w);
            *(u32x2*)(SC + off0 + (size_t)c * 16384) = w;
        }
    }
}

__device__ __forceinline__ bf16x8 pack8(const f32x16& v, int base) {
    u32x4 w; w.x = pk2(v[base + 0], v[base + 1]); w.y = pk2(v[base + 2], v[base + 3]); w.z = pk2(v[base + 4], v[base + 5]); w.w = pk2(v[base + 6], v[base + 7]);
    return __builtin_bit_cast(bf16x8, w);
}

__device__ __forceinline__ void attn_block(const Params& p, LAS unsigned char* lds, int bh, int qb) {
    const int tid = tid_l(), lane = tid & 63, w = __builtin_amdgcn_readfirstlane(tid >> 6), l31 = lane & 31, hh = lane >> 5;
    const int b = bh >> 3, h = bh & 7;
    const bf16_t* PROJ = (const bf16_t*)(p.ws + WS_PROJ);
    const bf16_t* VTF = (const bf16_t*)(p.ws + WS_VTF) + (size_t)bh * 128 * SEQ;
    const float* cum = (const float*)(p.ws + WS_CUM) + (size_t)bh * SEQ;
    bf16_t* Y = (bf16_t*)(p.ws + WS_Y);
    const size_t rowbase = (size_t)b * SEQ;
    const int qrow = 256 * qb + 32 * w + l31;
    bf16x8 Qf[8];
    { const bf16_t* qp = PROJ + (rowbase + qrow) * NP + COL_FQ + h * 128 + 8 * hh;
#pragma unroll
      for (int ks = 0; ks < 8; ++ks) Qf[ks] = *(const bf16x8*)(qp + 16 * ks); }
    bf16x8 Qone;
    { u32x4 o; o.x = hh ? 0u : 0x3F803F80u; o.y = hh ? 0u : 0x00003F80u; o.z = 0u; o.w = 0u; Qone = __builtin_bit_cast(bf16x8, o); }
    const int ntiles = 4 * (qb + 1), wlast = 4 * qb + (w >> 1);
    const bf16_t* ksrc[2]; const bf16_t* vsrc[2];
#pragma unroll
    for (int i = 0; i < 2; ++i) {
        const int krow = (w + 8 * i) * 4 + (lane >> 4), kch = (lane & 15) ^ (krow & 15);
        ksrc[i] = PROJ + (rowbase + krow) * NP + COL_FK + h * 128 + kch * 8;
        const int vrow = (w + 8 * i) * 8 + (lane >> 3), vch = (lane & 7) ^ ((vrow >> 1) & 7);
        vsrc[i] = VTF + (size_t)vrow * SEQ + vch * 8;
    }
#define ATT_ISSUE(tile, bufoff) do { LAS unsigned char* b_ = lds + (bufoff) + w * 1024; \
        _Pragma("unroll") for (int i_ = 0; i_ < 2; ++i_) { \
            __builtin_amdgcn_global_load_lds((const unsigned*)(ksrc[i_] + (size_t)(tile) * 64 * NP), (LAS unsigned*)(b_ + i_ * 8192), 16, 0, 0); \
            __builtin_amdgcn_global_load_lds((const unsigned*)(vsrc[i_] + (tile) * 64), (LAS unsigned*)(b_ + 16384 + i_ * 8192), 16, 0, 0); } } while (0)
    int kaddr[4], vaddr[4];
#pragma unroll
    for (int q = 0; q < 4; ++q) { kaddr[q] = l31 * 256 + (((2 * q + hh) ^ (l31 & 15)) << 4); vaddr[q] = l31 * 128 + (((2 * q + hh) ^ ((l31 >> 1) & 7)) << 4); }
    f32x16 O0 = {}, O1 = {}, O2 = {}, O3 = {};
    float mrun = -1e30f, lrun = 0.f;
    LAS float* cumL = (LAS float*)(lds + 98304);
    *(LAS f32x4*)(cumL + 4 * tid) = *(const f32x4*)(cum + 4 * tid);
    ATT_ISSUE(ntiles - 1, 0);
    if (ntiles > 1) ATT_ISSUE(ntiles - 2, 32768);
    __syncthreads();
    int bcur = 0, bnext2 = 65536;
    for (int it = 0; it < ntiles; ++it) {
        const int kt = ntiles - 1 - it;
        if (it + 1 < ntiles) asm volatile("s_waitcnt vmcnt(4)" ::: "memory"); else asm volatile("s_waitcnt vmcnt(0)" ::: "memory");
        __builtin_amdgcn_s_barrier(); asm volatile("" ::: "memory");
        if (it + 2 < ntiles) ATT_ISSUE(kt - 2, bnext2);
        LAS unsigned char* buf = lds + bcur;
        if (kt <= wlast) {
            const float cb0 = -cumL[64 * kt + l31], cb1 = -cumL[64 * kt + 32 + l31];
            f32x16 S0 = {}, S1 = {};
#pragma unroll
            for (int ks = 0; ks < 4; ++ks) {
                LAS unsigned char* kp_ = buf + kaddr[ks]; LAS unsigned char* kq_ = buf + (kaddr[ks] ^ 128);
                const bf16x8 A0 = *(const LAS bf16x8*)(kp_);
                const bf16x8 A1 = *(const LAS bf16x8*)(kp_ + 8192);
                const bf16x8 A2 = *(const LAS bf16x8*)(kq_);
                const bf16x8 A3 = *(const LAS bf16x8*)(kq_ + 8192);
                S0 = __builtin_amdgcn_mfma_f32_32x32x16_bf16(A0, Qf[ks], S0, 0, 0, 0);
                S1 = __builtin_amdgcn_mfma_f32_32x32x16_bf16(A1, Qf[ks], S1, 0, 0, 0);
                S0 = __builtin_amdgcn_mfma_f32_32x32x16_bf16(A2, Qf[ks + 4], S0, 0, 0, 0);
                S1 = __builtin_amdgcn_mfma_f32_32x32x16_bf16(A3, Qf[ks + 4], S1, 0, 0, 0);
            }
            {
                const unsigned h0 = f2bf(cb0); const float r0f = cb0 - bflo(h0); const unsigned m0 = f2bf(r0f); const unsigned l0 = f2bf(r0f - bflo(m0));
                const unsigned h1 = f2bf(cb1); const float r1f = cb1 - bflo(h1); const unsigned m1 = f2bf(r1f); const unsigned l1 = f2bf(r1f - bflo(m1));
                u32x4 a0 = {hh ? 0u : (h0 | (m0 << 16)), hh ? 0u : l0, 0u, 0u}, a1 = {hh ? 0u : (h1 | (m1 << 16)), hh ? 0u : l1, 0u, 0u};
                S0 = __builtin_amdgcn_mfma_f32_32x32x16_bf16(__builtin_bit_cast(bf16x8, a0), Qone, S0, 0, 0, 0);
                S1 = __builtin_amdgcn_mfma_f32_32x32x16_bf16(__builtin_bit_cast(bf16x8, a1), Qone, S1, 0, 0, 0);
            }
            if (kt == wlast) {
                const float NEG = -__builtin_inff();
                const int kb = 64 * kt + 4 * hh;
#pragma unroll
                for (int r = 0; r < 16; ++r) { const int key = kb + (r & 3) + 8 * (r >> 2); if (key > qrow) S0[r] = NEG; if (key + 32 > qrow) S1[r] = NEG; }
            }
            float mx = S0[0];
#pragma unroll
            for (int r = 1; r < 16; ++r) mx = fmaxf(mx, S0[r]);
#pragma unroll
            for (int r = 0; r < 16; ++r) mx = fmaxf(mx, S1[r]);
            mx = fmaxf(mx, __shfl_xor(mx, 32));
            if (!__all(mx - mrun < -160.0f)) {
                if (!__all(mx <= mrun)) {
                    const float mnew = fmaxf(mrun, mx);
                    const float alpha = __builtin_amdgcn_exp2f(mrun - mnew);
                    mrun = mnew; lrun *= alpha;
                    O0 = O0 * alpha; O1 = O1 * alpha; O2 = O2 * alpha; O3 = O3 * alpha;
                }
                float ps = 0.f;
#pragma unroll
                for (int r = 0; r < 16; ++r) { S0[r] = __builtin_amdgcn_exp2f(S0[r] - mrun); S1[r] = __builtin_amdgcn_exp2f(S1[r] - mrun); ps += S0[r] + S1[r]; }
                lrun += ps;
                const bf16x8 P00 = pack8(S0, 0), P01 = pack8(S0, 8), P10 = pack8(S1, 0), P11 = pack8(S1, 8);
                LAS unsigned char* vb = buf + 16384;
#define ATT_PVQ(q, PX) do { \
                const bf16x8 V0_ = *(const LAS bf16x8*)(vb + vaddr[q]), V1_ = *(const LAS bf16x8*)(vb + vaddr[q] + 4096), V2_ = *(const LAS bf16x8*)(vb + vaddr[q] + 8192), V3_ = *(const LAS bf16x8*)(vb + vaddr[q] + 12288); \
                O0 = __builtin_amdgcn_mfma_f32_32x32x16_bf16(V0_, PX, O0, 0, 0, 0); O1 = __builtin_amdgcn_mfma_f32_32x32x16_bf16(V1_, PX, O1, 0, 0, 0); \
                O2 = __builtin_amdgcn_mfma_f32_32x32x16_bf16(V2_, PX, O2, 0, 0, 0); O3 = __builtin_amdgcn_mfma_f32_32x32x16_bf16(V3_, PX, O3, 0, 0, 0); } while (0)
                ATT_PVQ(0, P00); ATT_PVQ(1, P01); ATT_PVQ(2, P10); ATT_PVQ(3, P11);
#undef ATT_PVQ
            }
        }
        bnext2 = bcur; bcur = (bcur == 65536) ? 0 : bcur + 32768;
    }
#undef ATT_ISSUE
    const float ltot = lrun + __shfl_xor(lrun, 32);
    const float inv = __builtin_amdgcn_rcpf(ltot);
    const size_t grow = rowbase + qrow;
    const bf16_t* zp = PROJ + grow * NP + COL_FZ + h * 128 + 4 * hh;
    bf16_t* yp = Y + grow * 3072 + 1024 + h * 128 + 4 * hh;
    u32x2 zz[16];
#pragma unroll
    for (int i = 0; i < 16; ++i) zz[i] = *(const u32x2*)(zp + 32 * (i >> 2) + 8 * (i & 3));
    asm volatile("" : "+v"(zz[0]), "+v"(zz[1]), "+v"(zz[2]), "+v"(zz[3]), "+v"(zz[4]), "+v"(zz[5]), "+v"(zz[6]), "+v"(zz[7]));
    asm volatile("" : "+v"(zz[8]), "+v"(zz[9]), "+v"(zz[10]), "+v"(zz[11]), "+v"(zz[12]), "+v"(zz[13]), "+v"(zz[14]), "+v"(zz[15]));
#define ATT_ST(OX, db) do { _Pragma("unroll") for (int g = 0; g < 4; ++g) { const u32x2 z = zz[4 * (db) + g]; u32x2 o; \
        o.x = pk2(OX[4 * g + 0] * inv * bflo(z.x), OX[4 * g + 1] * inv * bfhi(z.x)); o.y = pk2(OX[4 * g + 2] * inv * bflo(z.y), OX[4 * g + 3] * inv * bfhi(z.y)); \
        *(u32x2*)(yp + 32 * (db) + 8 * g) = o; } } while (0)
    ATT_ST(O0, 0); ATT_ST(O1, 1); ATT_ST(O2, 2); ATT_ST(O3, 3);
#undef ATT_ST
    __syncthreads();
}

__device__ __forceinline__ void ret_out_unit(const Params& p, int layer, int unit, int gq) {
    const int lane = tid_l() & 63, l31 = lane & 31, hh = lane >> 5;
    const int bh = unit >> 4, c = unit & 15, b = bh >> 3, h = bh & 7;
    const bf16_t* PROJ = (const bf16_t*)(p.ws + WS_PROJ);
    const bf16_t* VTR = (const bf16_t*)(p.ws + WS_VTR) + (size_t)bh * 128 * SEQ + c * 128;
    const bf16_t* SC = (const bf16_t*)(p.ws + WS_STATEC) + (size_t)unit * 16384;
    bf16_t* Y = (bf16_t*)(p.ws + WS_Y);
    const size_t tok0 = (size_t)b * SEQ + c * 128;
    const int ql = 32 * gq + l31;
    const float lg2 = log1pf(-exp2f(-5.0f - (float)h)) * LOG2E;
    bf16x8 Qf[8];
    { const bf16_t* qp = PROJ + (tok0 + ql) * NP + COL_RQ + h * 128 + 8 * hh;
#pragma unroll
      for (int ks = 0; ks < 8; ++ks) Qf[ks] = *(const bf16x8*)(qp + 16 * ks); }
    f32x16 O0 = {}, O1 = {}, O2 = {}, O3 = {};
#define PIN8(X) asm volatile("" : "+v"(X[0]), "+v"(X[1]), "+v"(X[2]), "+v"(X[3]), "+v"(X[4]), "+v"(X[5]), "+v"(X[6]), "+v"(X[7]))
    if (c > 0) {
        const bf16_t* sp = SC + (size_t)l31 * 128 + 8 * hh;
#pragma unroll
        for (int kh = 0; kh < 2; ++kh) {
            bf16x8 Fa[8], Fb[8];
#pragma unroll
            for (int k4 = 0; k4 < 4; ++k4) { const int ks = 4 * kh + k4;
                Fa[2 * k4] = *(const bf16x8*)(sp + 0 * 4096 + 16 * ks); Fa[2 * k4 + 1] = *(const bf16x8*)(sp + 1 * 4096 + 16 * ks);
                Fb[2 * k4] = *(const bf16x8*)(sp + 2 * 4096 + 16 * ks); Fb[2 * k4 + 1] = *(const bf16x8*)(sp + 3 * 4096 + 16 * ks); }
            PIN8(Fa); PIN8(Fb);
#pragma unroll
            for (int k4 = 0; k4 < 4; ++k4) { const int ks = 4 * kh + k4;
                O0 = __builtin_amdgcn_mfma_f32_32x32x16_bf16(Fa[2 * k4], Qf[ks], O0, 0, 0, 0);
                O1 = __builtin_amdgcn_mfma_f32_32x32x16_bf16(Fa[2 * k4 + 1], Qf[ks], O1, 0, 0, 0);
                O2 = __builtin_amdgcn_mfma_f32_32x32x16_bf16(Fb[2 * k4], Qf[ks], O2, 0, 0, 0);
                O3 = __builtin_amdgcn_mfma_f32_32x32x16_bf16(Fb[2 * k4 + 1], Qf[ks], O3, 0, 0, 0); }
        }
        const float xi = __builtin_amdgcn_exp2f(lg2 * (float)(ql + 1));
        O0 = O0 * xi; O1 = O1 * xi; O2 = O2 * xi; O3 = O3 * xi;
    }
    for (int kb = 0; kb <= gq; ++kb) {
        const bf16_t* kp = PROJ + (tok0 + 32 * kb + l31) * NP + COL_RK + h * 128 + 8 * hh;
        const bf16_t* vp = VTR + (size_t)l31 * SEQ + 32 * kb + 8 * hh;
        bf16x8 Kf[8], Vf[8];
#pragma unroll
        for (int ks = 0; ks < 8; ++ks) Kf[ks] = *(const bf16x8*)(kp + 16 * ks);
#pragma unroll
        for (int db = 0; db < 4; ++db) { Vf[2 * db] = *(const bf16x8*)(vp + (size_t)(32 * db) * SEQ); Vf[2 * db + 1] = *(const bf16x8*)(vp + (size_t)(32 * db) * SEQ + 16); }
        PIN8(Kf);
        f32x16 S = {};
#pragma unroll
        for (int ks = 0; ks < 8; ++ks) S = __builtin_amdgcn_mfma_f32_32x32x16_bf16(Kf[ks], Qf[ks], S, 0, 0, 0);
#pragma unroll
        for (int r = 0; r < 16; ++r) { const int key = 32 * kb + (r & 3) + 8 * (r >> 2) + 4 * hh; const int d = ql - key; S[r] = (d >= 0) ? S[r] * __builtin_amdgcn_exp2f(lg2 * (float)d) : 0.f; }
        const bf16x8 P0 = pack8(S, 0), P1 = pack8(S, 8);
        PIN8(Vf);
        O0 = __builtin_amdgcn_mfma_f32_32x32x16_bf16(Vf[0], P0, O0, 0, 0, 0); O1 = __builtin_amdgcn_mfma_f32_32x32x16_bf16(Vf[2], P0, O1, 0, 0, 0);
        O2 = __builtin_amdgcn_mfma_f32_32x32x16_bf16(Vf[4], P0, O2, 0, 0, 0); O3 = __builtin_amdgcn_mfma_f32_32x32x16_bf16(Vf[6], P0, O3, 0, 0, 0);
        O0 = __builtin_amdgcn_mfma_f32_32x32x16_bf16(Vf[1], P1, O0, 0, 0, 0); O1 = __builtin_amdgcn_mfma_f32_32x32x16_bf16(Vf[3], P1, O1, 0, 0, 0);
        O2 = __builtin_amdgcn_mfma_f32_32x32x16_bf16(Vf[5], P1, O2, 0, 0, 0); O3 = __builtin_amdgcn_mfma_f32_32x32x16_bf16(Vf[7], P1, O3, 0, 0, 0);
    }
#undef PIN8
    float s1 = 0.f;
#pragma unroll
    for (int r = 0; r < 16; ++r) s1 += (O0[r] + O1[r]) + (O2[r] + O3[r]);
    s1 += __shfl_xor(s1, 32);
    const float mean = s1 * (1.0f / 128.0f);
    float s2 = 0.f;
#pragma unroll
    for (int r = 0; r < 16; ++r) { const float a = O0[r] - mean, bq = O1[r] - mean, cq = O2[r] - mean, dq = O3[r] - mean; s2 += (a * a + bq * bq) + (cq * cq + dq * dq); }
    s2 += __shfl_xor(s2, 32);
    const float rstd = 1.0f / sqrtf(s2 * (1.0f / 128.0f) + EPS);
    const float* gn = p.ret_gn_g + (size_t)layer * 1024 + h * 128 + 4 * hh;
    const size_t grow = tok0 + ql;
    const bf16_t* zp = PROJ + grow * NP + COL_RZ + h * 128 + 4 * hh;
    bf16_t* yp = Y + grow * 3072 + h * 128 + 4 * hh;
    u32x2 zz[16];
#pragma unroll
    for (int i = 0; i < 16; ++i) zz[i] = *(const u32x2*)(zp + 32 * (i >> 2) + 8 * (i & 3));
    f32x4 gg[8];
#pragma unroll
    for (int i = 0; i < 8; ++i) gg[i] = *(const f32x4*)(gn + 32 * (i >> 2) + 8 * (i & 3));
    asm volatile("" : "+v"(zz[0]), "+v"(zz[1]), "+v"(zz[2]), "+v"(zz[3]), "+v"(zz[4]), "+v"(zz[5]), "+v"(zz[6]), "+v"(zz[7]));
    asm volatile("" : "+v"(zz[8]), "+v"(zz[9]), "+v"(zz[10]), "+v"(zz[11]), "+v"(zz[12]), "+v"(zz[13]), "+v"(zz[14]), "+v"(zz[15]));
    asm volatile("" : "+v"(gg[0]), "+v"(gg[1]), "+v"(gg[2]), "+v"(gg[3]), "+v"(gg[4]), "+v"(gg[5]), "+v"(gg[6]), "+v"(gg[7]));
#define RET_ST(OX, db, GG) do { _Pragma("unroll") for (int g = 0; g < 4; ++g) { const u32x2 z = zz[4 * (db) + g]; const f32x4 gq_ = GG[4 * ((db) & 1) + g]; u32x2 o; \
        o.x = pk2((OX[4 * g + 0] - mean) * rstd * gq_.x * bflo(z.x), (OX[4 * g + 1] - mean) * rstd * gq_.y * bfhi(z.x)); \
        o.y = pk2((OX[4 * g + 2] - mean) * rstd * gq_.z * bflo(z.y), (OX[4 * g + 3] - mean) * rstd * gq_.w * bfhi(z.y)); \
        *(u32x2*)(yp + 32 * (db) + 8 * g) = o; } } while (0)
    RET_ST(O0, 0, gg); RET_ST(O1, 1, gg);
#pragma unroll
    for (int i = 0; i < 8; ++i) gg[i] = *(const f32x4*)(gn + 64 + 32 * (i >> 2) + 8 * (i & 3));
    asm volatile("" : "+v"(gg[0]), "+v"(gg[1]), "+v"(gg[2]), "+v"(gg[3]), "+v"(gg[4]), "+v"(gg[5]), "+v"(gg[6]), "+v"(gg[7]));
    RET_ST(O2, 2, gg); RET_ST(O3, 3, gg);
#undef RET_ST
}

__device__ __forceinline__ void ret_out_phase(const Params& p, LAS unsigned char* lds, int layer, int vcu, int G) {
    const int tid = tid_l(), lane = tid & 63, w = __builtin_amdgcn_readfirstlane(tid >> 6), l31 = lane & 31, hh = lane >> 5;
    const int gq = w & 3, half = w >> 2;
    const bf16_t* PROJ = (const bf16_t*)(p.ws + WS_PROJ);
    bf16_t* Y = (bf16_t*)(p.ws + WS_Y);
    LAS float* X = (LAS float*)(lds + 131072);
#define RO_ISSUE(unit_, boff_) do { const int bh_ = (unit_) >> 4, c_ = (unit_) & 15; const size_t t0_ = (size_t)(bh_ >> 3) * SEQ + c_ * 128; \
        _Pragma("unroll") for (int i_ = 0; i_ < 4; ++i_) { const int pc_ = w + 8 * i_, s_ = pc_ * 64 + lane, row_ = s_ >> 4, ch_ = (s_ & 15) ^ (row_ & 15); \
            __builtin_amdgcn_global_load_lds((const unsigned*)(PROJ + (t0_ + row_) * NP + COL_RK + (bh_ & 7) * 128 + ch_ * 8), (LAS unsigned*)(lds + (boff_) + pc_ * 1024), 16, 0, 0); \
            __builtin_amdgcn_global_load_lds((const unsigned*)((const bf16_t*)(p.ws + WS_VTR) + ((size_t)bh_ * 128 + row_) * SEQ + c_ * 128 + ch_ * 8), (LAS unsigned*)(lds + (boff_) + 32768 + pc_ * 1024), 16, 0, 0); } } while (0)
#define PIN8(X_) asm volatile("" : "+v"(X_[0]), "+v"(X_[1]), "+v"(X_[2]), "+v"(X_[3]), "+v"(X_[4]), "+v"(X_[5]), "+v"(X_[6]), "+v"(X_[7]))
    int kaddr[8];
#pragma unroll
    for (int ks = 0; ks < 8; ++ks) kaddr[ks] = l31 * 256 + (((2 * ks + hh) ^ (l31 & 15)) << 4);
    int unit = vcu, boff = 0;
    if (unit < 1024) RO_ISSUE(unit, 0);
    asm volatile("s_waitcnt vmcnt(0)" ::: "memory");
    for (; unit < 1024; unit += G) {
        __builtin_amdgcn_s_barrier(); asm volatile("" ::: "memory");
        if (unit + G < 1024) RO_ISSUE(unit + G, boff ^ 65536);
        const int bh = unit >> 4, c = unit & 15, b = bh >> 3, h = bh & 7;
        const size_t tok0 = (size_t)b * SEQ + c * 128;
        const int ql = 32 * gq + l31;
        const float lg2 = log1pf(-exp2f(-5.0f - (float)h)) * LOG2E;
        bf16x8 Qf[8];
        { const bf16_t* qp = PROJ + (tok0 + ql) * NP + COL_RQ + h * 128 + 8 * hh;
#pragma unroll
          for (int ks = 0; ks < 8; ++ks) Qf[ks] = *(const bf16x8*)(qp + 16 * ks); }
        f32x16 O0 = {}, O1 = {};
        if (c > 0) {
            const bf16_t* sp = (const bf16_t*)(p.ws + WS_STATEC) + (size_t)unit * 16384 + (size_t)(64 * half + l31) * 128 + 8 * hh;
            bf16x8 Fa[8], Fb[8];
#pragma unroll
            for (int ks = 0; ks < 8; ++ks) { Fa[ks] = *(const bf16x8*)(sp + 16 * ks); Fb[ks] = *(const bf16x8*)(sp + 4096 + 16 * ks); }
            PIN8(Fa); PIN8(Fb);
#pragma unroll
            for (int ks = 0; ks < 8; ++ks) { O0 = __builtin_amdgcn_mfma_f32_32x32x16_bf16(Fa[ks], Qf[ks], O0, 0, 0, 0); O1 = __builtin_amdgcn_mfma_f32_32x32x16_bf16(Fb[ks], Qf[ks], O1, 0, 0, 0); }
            const float xi = __builtin_amdgcn_exp2f(lg2 * (float)(ql + 1));
            O0 = O0 * xi; O1 = O1 * xi;
        }
        LAS unsigned char* kb_ = lds + boff; LAS unsigned char* vb_ = lds + boff + 32768 + (64 * half + l31) * 256;
        for (int kb = 0; kb <= gq; ++kb) {
            bf16x8 Kf[8];
#pragma unroll
            for (int ks = 0; ks < 8; ++ks) Kf[ks] = *(const LAS bf16x8*)(kb_ + kb * 8192 + kaddr[ks]);
            bf16x8 Vf[4];
#pragma unroll
            for (int q = 0; q < 4; ++q) Vf[q] = *(const LAS bf16x8*)(vb_ + (q >> 1) * 8192 + (((4 * kb + 2 * (q & 1) + hh) ^ (l31 & 15)) << 4));
            PIN8(Kf);
            f32x16 S = {};
#pragma unroll
            for (int ks = 0; ks < 8; ++ks) S = __builtin_amdgcn_mfma_f32_32x32x16_bf16(Kf[ks], Qf[ks], S, 0, 0, 0);
#pragma unroll
            for (int r = 0; r < 16; ++r) { const int key = 32 * kb + (r & 3) + 8 * (r >> 2) + 4 * hh; const int d = ql - key; S[r] = (d >= 0) ? S[r] * __builtin_amdgcn_exp2f(lg2 * (float)d) : 0.f; }
            const bf16x8 P0 = pack8(S, 0), P1 = pack8(S, 8);
            asm volatile("" : "+v"(Vf[0]), "+v"(Vf[1]), "+v"(Vf[2]), "+v"(Vf[3]));
            O0 = __builtin_amdgcn_mfma_f32_32x32x16_bf16(Vf[0], P0, O0, 0, 0, 0); O1 = __builtin_amdgcn_mfma_f32_32x32x16_bf16(Vf[2], P0, O1, 0, 0, 0);
            O0 = __builtin_amdgcn_mfma_f32_32x32x16_bf16(Vf[1], P1, O0, 0, 0, 0); O1 = __builtin_amdgcn_mfma_f32_32x32x16_bf16(Vf[3], P1, O1, 0, 0, 0);
        }
        float s1 = 0.f, s2 = 0.f;
#pragma unroll
        for (int r = 0; r < 16; ++r) { s1 += O0[r] + O1[r]; s2 += O0[r] * O0[r] + O1[r] * O1[r]; }
        s1 += __shfl_xor(s1, 32); s2 += __shfl_xor(s2, 32);
        if (hh == 0) { X[(w * 32 + l31) * 2] = s1; X[(w * 32 + l31) * 2 + 1] = s2; }
        const size_t grow = tok0 + ql;
        const bf16_t* zp = PROJ + grow * NP + COL_RZ + h * 128 + 64 * half + 4 * hh;
        const float* gn = p.ret_gn_g + (size_t)layer * 1024 + h * 128 + 64 * half + 4 * hh;
        u32x2 zz[8]; f32x4 gg[8];
#pragma unroll
        for (int i = 0; i < 8; ++i) { zz[i] = *(const u32x2*)(zp + 32 * (i >> 2) + 8 * (i & 3)); gg[i] = *(const f32x4*)(gn + 32 * (i >> 2) + 8 * (i & 3)); }
        asm volatile("s_waitcnt lgkmcnt(0)" ::: "memory");
        __builtin_amdgcn_s_barrier(); asm volatile("" ::: "memory");
        const float t1 = s1 + X[((w ^ 4) * 32 + l31) * 2], t2 = s2 + X[((w ^ 4) * 32 + l31) * 2 + 1];
        const float mean = t1 * (1.0f / 128.0f);
        const float var = fmaxf(t2 * (1.0f / 128.0f) - mean * mean, 0.f);
        const float rstd = 1.0f / sqrtf(var + EPS);
        PIN8(zz); PIN8(gg);
        bf16_t* yp = Y + grow * 3072 + h * 128 + 64 * half + 4 * hh;
#define RO_ST(OX, d2) do { _Pragma("unroll") for (int g = 0; g < 4; ++g) { const u32x2 z = zz[4 * (d2) + g]; const f32x4 gq_ = gg[4 * (d2) + g]; u32x2 o; \
            o.x = pk2((OX[4 * g + 0] - mean) * rstd * gq_.x * bflo(z.x), (OX[4 * g + 1] - mean) * rstd * gq_.y * bfhi(z.x)); \
            o.y = pk2((OX[4 * g + 2] - mean) * rstd * gq_.z * bflo(z.y), (OX[4 * g + 3] - mean) * rstd * gq_.w * bfhi(z.y)); \
            *(u32x2*)(yp + 32 * (d2) + 8 * g) = o; } } while (0)
        RO_ST(O0, 0); RO_ST(O1, 1);
#undef RO_ST
        asm volatile("s_waitcnt vmcnt(0)" ::: "memory");
        boff ^= 65536;
    }
#undef RO_ISSUE
#undef PIN8
}

__device__ __forceinline__ void phase_c2(LAS unsigned char* lds, int layer) {
#if PHC2 & 1
    { const Params p = loadp(); int G, bx, vcu; geom(G, bx, vcu);
      for (int it = vcu; it < 256; it += G) { const int bh = it >> 2, i = it & 3; for (int k2 = 0; k2 < 2; ++k2) attn_block(p, lds, bh, k2 ? i : 7 - i); } }
#endif
#if PHC2 & 2
    { const Params p = loadp(); int G, bx, vcu; geom(G, bx, vcu); const int ly = launder_s(layer);
      ret_out_phase(p, lds, ly, vcu, G); }
#endif
    __syncthreads();
#if PHC2 & 4
    { const Params p = loadp(); int G, bx, vcu; geom(G, bx, vcu); const int ly = launder_s(layer);
      SchedPool S{(const bf16_t*)(p.ws + WS_POOLED), (const bf16_t*)(p.ws + WS_WPOOL), G, bx};
      EpiPool E{(const bf16_t*)(p.ws + WS_PROJ), (bf16_t*)(p.ws + WS_Y), p.pool_scale + (size_t)ly * 1024};
      pg8::gemm_phase<EpiPool, SchedPool>(lds, launder_s(256), 1024, 256, S, E); }
#endif
}

__device__ __forceinline__ void phase_final() {
    const Params p = loadp(); int G, bx, vcu; geom(G, bx, vcu);
    const int tid = tid_l(), lane = tid & 63, wave = tid >> 6;
    const int gw = vcu * NWAVES + wave, NGW = G * NWAVES;
    f32x4 gfin[8];
#pragma unroll
    for (int j = 0; j < 8; ++j) gfin[j] = *((const f32x4*)p.final_g + lane + 64 * j);
    f32x4 vn[8];
    if (gw < M) {
#pragma unroll
        for (int j = 0; j < 8; ++j) vn[j] = *((const f32x4*)(p.out + (size_t)gw * DM) + lane + 64 * j);
    }
    for (int m = gw; m < M; m += NGW) {
        f32x4* xr = (f32x4*)(p.out + (size_t)m * DM) + lane;
        f32x4 v[8]; float ss = 0.f;
#pragma unroll
        for (int j = 0; j < 8; ++j) { v[j] = vn[j]; ss += (v[j].x * v[j].x + v[j].y * v[j].y) + (v[j].z * v[j].z + v[j].w * v[j].w); }
        if (m + NGW < M) {
#pragma unroll
            for (int j = 0; j < 8; ++j) vn[j] = *((const f32x4*)(p.out + (size_t)(m + NGW) * DM) + lane + 64 * j);
        }
        const float rstd = 1.0f / sqrtf(wave_sum(ss) * (1.0f / DM) + EPS);
#pragma unroll
        for (int j = 0; j < 8; ++j) xr[64 * j] = v[j] * rstd * gfin[j];
    }
}

__global__ void __launch_bounds__(NTHREADS, 2) hybrid_fwd(Params p_unused) {
    extern __shared__ __attribute__((aligned(16))) unsigned char lds_raw[];
    LAS unsigned char* lds = (LAS unsigned char*)lds_raw;
    cg::grid_group grid = cg::this_grid();
    if (gridDim.y == 0x7fffffffu) grid.sync();
    if (threadIdx.x < 16) ((volatile LAS unsigned*)(lds + LDS_BARST))[threadIdx.x] = 0u;
    __syncthreads();
    (void)xcd_barrier_post((unsigned*)(loadp().ws + WS_BAR), (volatile LAS unsigned*)(lds + LDS_BARST));
#define GSYNC() do { XcdBarrier b_; b_.bar = (unsigned*)(loadp().ws + WS_BAR); b_.x = xb_xcc_id(); b_.st = (volatile LAS unsigned*)(lds + LDS_BARST); xcd_barrier(b_); } while (0)
#pragma unroll 1
    for (int layer = 0; layer < DEPTH; ++layer) {
#if PHM & 1
        phase_a(lds, layer);
#if REPM & 1
        GSYNC(); phase_a(lds, layer);
#endif
#endif
        GSYNC();
#if PHM & 2
        {
            const Params p = loadp(); int G, bx, vcu; geom(G, bx, vcu);
            SchedProj S{(const bf16_t*)(p.ws + WS_H), (const bf16_t*)(p.ws + WS_WIN), DM, DM, 64, 64, G, bx};
            EpiProj E{(bf16_t*)(p.ws + WS_PROJ), (const float*)(p.ws + WS_ROPE)};
            pg8::gemm_phase<EpiProj, SchedProj>(lds, DM, DM, DM, S, E);
        }
#endif
        GSYNC();
#if PHM & 4
        phase_c1(lds, layer);
#if REPM & 4
        GSYNC(); phase_c1(lds, layer);
#endif
#endif
        GSYNC();
#if PHM & 8
        phase_c1b();
#endif
        GSYNC();
#if PHM & 16
        phase_c2(lds, layer);
#if REPM & 16
        GSYNC(); phase_c2(lds, layer);
#endif
#endif
        GSYNC();
#if PHM & 32
        {
            const Params p = loadp(); int G, bx, vcu; geom(G, bx, vcu);
            SchedMerge S{(const bf16_t*)(p.ws + WS_Y), (const bf16_t*)(p.ws + WS_WBR), G, bx};
            EpiMerge E{(const bf16_t*)(p.ws + WS_PROJ), (bf16_t*)(p.ws + WS_H)};
            pg8::gemm_phase<EpiMerge, SchedMerge>(lds, 1024, 3072, 1024, S, E);
        }
#endif
        GSYNC();
#if PHM & 64
        {
            const Params p = loadp(); int G, bx, vcu; geom(G, bx, vcu); const int ly = launder_s(layer);
            SchedPlain S{(const bf16_t*)(p.ws + WS_H), (const bf16_t*)(p.ws + WS_WOUT), DM, DM, 64, 8, G, bx};
            EpiOut E{sel_ptr(p.x, p.out, ly), p.out};
            pg8::gemm_phase<EpiOut, SchedPlain>(lds, DM, DM, DM, S, E);
        }
#endif
        GSYNC();
    }
#if PHM & 128
    phase_final();
#endif
}

extern "C" void kernel_launch(void* const* d_in, const int* in_sizes, int n_in, void* d_out, int out_size, void* d_ws, size_t ws_size, hipStream_t stream) {
    static int grid_blocks = 0;
    if (!grid_blocks) {
        int dev = 0, cus = 0, per_cu = 0;
        hipGetDevice(&dev);
        hipDeviceGetAttribute(&cus, hipDeviceAttributeMultiprocessorCount, dev);
        hipFuncSetAttribute((const void*)hybrid_fwd, hipFuncAttributeMaxDynamicSharedMemorySize, LDS_BYTES);
        hipOccupancyMaxActiveBlocksPerMultiprocessor(&per_cu, (const void*)hybrid_fwd, NTHREADS, LDS_BYTES);
        if (per_cu < 1) per_cu = 1;
        grid_blocks = cus * 1;
        if (ws_size < WS_END) fprintf(stderr, "kernel_launch: workspace too small: %zu < %zu\n", ws_size, (size_t)WS_END);
    }
    Params p{};
    p.x = (const float*)d_in[0]; p.norm_g = (const float*)d_in[1]; p.w_in = (const float*)d_in[2]; p.ret_gn_g = (const float*)d_in[3]; p.fox_b_f = (const float*)d_in[4];
    p.pool_w = (const float*)d_in[5]; p.pool_scale = (const float*)d_in[6]; p.w_ret = (const float*)d_in[7]; p.w_fox = (const float*)d_in[8]; p.w_pool = (const float*)d_in[9];
    p.w_out = (const float*)d_in[10]; p.final_g = (const float*)d_in[11];
    p.out = (float*)d_out; p.ws = (unsigned char*)d_ws;
    (void)hipMemsetAsync((char*)d_ws + WS_BAR, 0, XCD_BAR_WORDS * sizeof(unsigned), stream);
    void* args[] = {&p};
    hipError_t e = hipLaunchCooperativeKernel((const void*)hybrid_fwd, dim3(grid_blocks), dim3(NTHREADS), args, LDS_BYTES, stream);
    if (e != hipSuccess) fprintf(stderr, "cooperative launch failed: %s (grid %d)\n", hipGetErrorString(e), grid_blocks);
}
```
